# Optimizing an MI355X kernel written in HIP

```python
import jax
import jax.numpy as jnp
from jax import lax
import numpy as np

D_MODEL = 1024
BATCH = 8
SEQ = 2048
DEPTH = 4

GRID_W = 64
CTX_LEN = 256
QBLK = 128
ROPE_THETA = 10000.0
NORM_EPS = 1e-6
N_BRANCH = 4
BRANCH_W = D_MODEL // 4
SGU_CHUNK = 128
SGU_GROUPS = 4
MLA_HEADS = 4
MLA_Q_RANK = D_MODEL // 4
MLA_KV_RANK = D_MODEL // 8
MLA_NOPE = 64
MLA_ROPE = 32
MLA_V = BRANCH_W // MLA_HEADS
CONV_W = 3
GQA_HEADS = 4
GQA_KV_HEADS = 2
GQA_HEAD_DIM = BRANCH_W // GQA_HEADS
N_GROUPS = 4
EXPERTS_PER_GROUP = 8
N_EXPERTS = N_GROUPS * EXPERTS_PER_GROUP
TOP_K = 2
D_EXPERT = D_MODEL // 4
MOE_BLK = 128
SPLIT_SIZES = (BRANCH_W, BRANCH_W,
               MLA_Q_RANK, MLA_KV_RANK, MLA_ROPE,
               BRANCH_W, BRANCH_W, BRANCH_W,
               GQA_HEADS * GQA_HEAD_DIM, GQA_KV_HEADS * GQA_HEAD_DIM, GQA_KV_HEADS * GQA_HEAD_DIM)
D_IN = sum(SPLIT_SIZES)

kernel_name = 'hybrid_gated_mixers_hmoe_dit'


def _rmsnorm(x, gain=None):
    xf = x.astype(jnp.float32)
    y = xf * lax.rsqrt(jnp.mean(xf * xf, axis=-1, keepdims=True) + NORM_EPS)
    if gain is not None:
        y = y * gain.astype(jnp.float32)
    return y.astype(x.dtype)


def _split_cols(z, sizes):
    out, o = [], 0
    for s in sizes:
        out.append(z[..., o:o + s])
        o += s
    return out


def _axial_rope_tables(n_ctx, rows, rot_dim):
    n_freq = rot_dim // 4
    freqs = ROPE_THETA ** (-jnp.arange(n_freq, dtype=jnp.float32) / n_freq)
    row = jnp.repeat(jnp.arange(rows, dtype=jnp.float32), GRID_W)
    col = (jnp.arange(rows * GRID_W) % GRID_W).astype(jnp.float32)
    ang = jnp.concatenate([row[:, None] * freqs, col[:, None] * freqs], axis=-1)
    ang = jnp.concatenate([jnp.zeros((n_ctx, rot_dim // 2), jnp.float32), ang], axis=0)
    return jnp.cos(ang), jnp.sin(ang)


def _rope(x, cos, sin):
    half = x.shape[-1] // 2
    xf = x.astype(jnp.float32)
    x1, x2 = xf[..., :half], xf[..., half:]
    cc, ss = cos[None, :, None, :], sin[None, :, None, :]
    return jnp.concatenate([x1 * cc - x2 * ss, x1 * ss + x2 * cc], axis=-1).astype(x.dtype)


def _sdpa(q, k, v):
    b, tq, h, dk = q.shape
    hk = k.shape[2]
    qg = q.reshape(b, tq, hk, h // hk, dk)
    s = jnp.einsum('bqgrd,bkgd->bgrqk', qg, k).astype(jnp.float32) * (dk ** -0.5)
    p = jax.nn.softmax(s, axis=-1).astype(v.dtype)
    o = jnp.einsum('bgrqk,bkgd->bqgrd', p, v)
    return o.reshape(b, tq, h, v.shape[-1])


def _attention(q, k, v, n_ctx):
    b, n, h, dk = q.shape
    n_lat = n - n_ctx
    o_ctx = _sdpa(q[:, :n_ctx], k[:, :n_ctx], v[:, :n_ctx])
    qb = q[:, n_ctx:].reshape(b, n_lat // QBLK, QBLK, h, dk).transpose(1, 0, 2, 3, 4)
    o_lat = lax.map(lambda qq: _sdpa(qq, k, v), qb)
    o_lat = o_lat.transpose(1, 0, 2, 3, 4).reshape(b, n_lat, h, v.shape[-1])
    return jnp.concatenate([o_ctx, o_lat], axis=1)


def _per_seq(fn, z, n_ctx):
    return jnp.concatenate([fn(z[:, :n_ctx]), fn(z[:, n_ctx:])], axis=1)


def _chunk_mix(v, w_s, b_s):
    b, t, w = v.shape
    vc = v.reshape(b, t // SGU_CHUNK, SGU_CHUNK, SGU_GROUPS, w // SGU_GROUPS)
    m = jnp.einsum('gpq,bnqgc->bnpgc', w_s, vc) + b_s.T[None, None, :, :, None]
    return m.reshape(b, t, w)


def _dwconv(z, w):
    return lax.conv_general_dilated(z, w[:, None, :], (1,), ((CONV_W // 2, CONV_W // 2),),
                                    dimension_numbers=('NWC', 'WIO', 'NWC'),
                                    feature_group_count=z.shape[-1])


def _modulate(xn, shift_c, scale_c, shift_l, scale_l, n_ctx):
    hc = xn[:, :n_ctx] * (1 + scale_c) + shift_c
    hl = xn[:, n_ctx:] * (1 + scale_l[:, None]) + shift_l[:, None]
    return jnp.concatenate([hc, hl], axis=1)


def _gated(y, gate_c, gate_l, n_ctx):
    return jnp.concatenate([y[:, :n_ctx] * gate_c, y[:, n_ctx:] * gate_l[:, None]], axis=1)


def _mixer(h, n_ctx, rope_mla, rope_gqa, w_in, sgu_gain, w_sgu, b_sgu, mla_q_gain, w_uq,
           mla_kv_gain, w_ukv, w_conv, gqa_q_gain, gqa_k_gain, w_gate, b_gate, w_branch, w_out):
    b, n, _ = h.shape
    (a_u, a_v, m_q, m_kv, m_kpe, c_b, c_c, c_x, g_q, g_k, g_v) = _split_cols(h @ w_in, SPLIT_SIZES)

    a_v = _rmsnorm(jax.nn.gelu(a_v), sgu_gain)
    y_a = jax.nn.gelu(a_u) * _per_seq(lambda s: _chunk_mix(s, w_sgu, b_sgu), a_v, n_ctx)

    cos_m, sin_m = rope_mla
    q = (_rmsnorm(m_q, mla_q_gain) @ w_uq).reshape(b, n, MLA_HEADS, MLA_NOPE + MLA_ROPE)
    q = jnp.concatenate([q[..., :MLA_NOPE], _rope(q[..., MLA_NOPE:], cos_m, sin_m)], axis=-1)
    kv = (_rmsnorm(m_kv, mla_kv_gain) @ w_ukv).reshape(b, n, MLA_HEADS, MLA_NOPE + MLA_V)
    k_pe = _rope(m_kpe[:, :, None, :], cos_m, sin_m)
    k = jnp.concatenate([kv[..., :MLA_NOPE],
                         jnp.broadcast_to(k_pe, (b, n, MLA_HEADS, MLA_ROPE))], axis=-1)
    y_b = _attention(q, k, kv[..., MLA_NOPE:], n_ctx).reshape(b, n, BRANCH_W)

    y_c = c_b * _per_seq(lambda s: _dwconv(s, w_conv), c_c * c_x, n_ctx)

    cos_g, sin_g = rope_gqa
    qd = _rope(_rmsnorm(g_q.reshape(b, n, GQA_HEADS, GQA_HEAD_DIM), gqa_q_gain), cos_g, sin_g)
    kd = _rope(_rmsnorm(g_k.reshape(b, n, GQA_KV_HEADS, GQA_HEAD_DIM), gqa_k_gain), cos_g, sin_g)
    vd = g_v.reshape(b, n, GQA_KV_HEADS, GQA_HEAD_DIM)
    y_d = _attention(qd, kd, vd, n_ctx).reshape(b, n, BRANCH_W)

    merged = None
    for i, y in enumerate((y_a, y_b, y_c, y_d)):
        term = jax.nn.sigmoid(h @ w_gate[i] + b_gate[i]) * (y @ w_branch[i])
        merged = term if merged is None else merged + term
    return merged @ w_out


def _moe(h, w_gr, b_gr, w_er, b_er, w_gu, w_dn):
    shp = h.shape
    t = h.reshape(-1, shp[-1])
    n = t.shape[0]
    pg = jax.nn.softmax((t @ w_gr).astype(jnp.float32) + b_gr.astype(jnp.float32), axis=-1)
    pg_top, g_sel = lax.top_k(pg, 1)
    le = ((t @ w_er).astype(jnp.float32) + b_er.astype(jnp.float32)).reshape(n, N_GROUPS, EXPERTS_PER_GROUP)
    le = le[jnp.arange(n), g_sel[:, 0]]
    pe_top, e_sel = lax.top_k(jax.nn.softmax(le, axis=-1), TOP_K)
    wts = pg_top * pe_top / jnp.sum(pe_top, axis=-1, keepdims=True)
    eid = g_sel * EXPERTS_PER_GROUP + e_sel

    a = n * TOP_K
    flat_e = eid.reshape(-1)
    flat_t = jnp.repeat(jnp.arange(n, dtype=jnp.int32), TOP_K)
    flat_w = wts.reshape(-1)
    order = jnp.argsort(flat_e)
    e_s, t_s, w_s = flat_e[order], flat_t[order], flat_w[order]
    counts = jnp.bincount(flat_e, length=N_EXPERTS)
    start = jnp.cumsum(counts) - counts
    padded = (counts + MOE_BLK - 1) // MOE_BLK * MOE_BLK
    pend = jnp.cumsum(padded)
    pstart = pend - padded
    dest = pstart[e_s] + jnp.arange(a, dtype=jnp.int32) - start[e_s]
    cap = -(-a // MOE_BLK) * MOE_BLK + N_EXPERTS * MOE_BLK
    nblk = cap // MOE_BLK
    tok_buf = jnp.zeros((cap,), jnp.int32).at[dest].set(t_s)
    w_buf = jnp.zeros((cap,), t.dtype).at[dest].set(w_s.astype(t.dtype))
    blk_e = jnp.minimum(jnp.searchsorted(pend, jnp.arange(nblk, dtype=jnp.int32) * MOE_BLK, side='right'),
                        N_EXPERTS - 1)
    xb = t[tok_buf].reshape(nblk, MOE_BLK, shp[-1])

    def expert_block(args):
        xe, e = args
        gu = xe @ w_gu[e]
        return (jax.nn.silu(gu[:, :D_EXPERT]) * gu[:, D_EXPERT:]) @ w_dn[e]

    yb = lax.map(expert_block, (xb, blk_e)).reshape(cap, shp[-1])
    out = jnp.zeros_like(t).at[tok_buf].add(yb * w_buf[:, None])
    return out.reshape(shp)


def setup_inputs(seed: int = 0) -> dict:
    key = jax.random.key(seed)
    ks = iter(jax.random.split(key, 40))
    D = D_MODEL
    L = DEPTH

    def nrm(shape, scale):
        return jax.random.normal(next(ks), shape, jnp.float32) * scale

    def gain(shape):
        return 1.0 + nrm(shape, 0.02)

    return {
        'x': nrm((BATCH, SEQ, D), 1.0),
        'c': nrm((BATCH, D), 1.0),
        'ctx': nrm((BATCH, CTX_LEN, D), 1.0),
        'c_ctx': nrm((D,), 1.0),
        'w_ada': nrm((L, D, 6 * D), 0.5 * D ** -0.5),
        'b_ada': nrm((L, 6 * D), 0.02),
        'w_in': nrm((L, D, D_IN), D ** -0.5),
        'sgu_gain': gain((L, BRANCH_W)),
        'w_sgu': nrm((L, SGU_GROUPS, SGU_CHUNK, SGU_CHUNK), SGU_CHUNK ** -0.5),
        'b_sgu': gain((L, SGU_GROUPS, SGU_CHUNK)),
        'mla_q_gain': gain((L, MLA_Q_RANK)),
        'w_uq': nrm((L, MLA_Q_RANK, MLA_HEADS * (MLA_NOPE + MLA_ROPE)), MLA_Q_RANK ** -0.5),
        'mla_kv_gain': gain((L, MLA_KV_RANK)),
        'w_ukv': nrm((L, MLA_KV_RANK, MLA_HEADS * (MLA_NOPE + MLA_V)), MLA_KV_RANK ** -0.5),
        'w_conv': nrm((L, CONV_W, BRANCH_W), CONV_W ** -0.5),
        'gqa_q_gain': gain((L, GQA_HEAD_DIM)),
        'gqa_k_gain': gain((L, GQA_HEAD_DIM)),
        'w_gate': nrm((L, N_BRANCH, D, D), D ** -0.5),
        'b_gate': nrm((L, N_BRANCH, D), 0.02),
        'w_branch': nrm((L, N_BRANCH, BRANCH_W, D), BRANCH_W ** -0.5),
        'w_out': nrm((L, D, D), D ** -0.5),
        'w_group_router': nrm((L, D, N_GROUPS), D ** -0.5),
        'b_group_router': nrm((L, N_GROUPS), 0.01),
        'w_expert_router': nrm((L, D, N_EXPERTS), D ** -0.5),
        'b_expert_router': nrm((L, N_EXPERTS), 0.01),
        'w_expert_gate_up': nrm((L, N_EXPERTS, D, 2 * D_EXPERT), D ** -0.5),
        'w_expert_down': nrm((L, N_EXPERTS, D_EXPERT, D), D_EXPERT ** -0.5),
        'final_gain': gain((D,)),
    }


def reference(x, c, ctx, c_ctx, w_ada, b_ada, w_in, sgu_gain, w_sgu, b_sgu, mla_q_gain, w_uq,
              mla_kv_gain, w_ukv, w_conv, gqa_q_gain, gqa_k_gain, w_gate, b_gate, w_branch, w_out,
              w_group_router, b_group_router, w_expert_router, b_expert_router,
              w_expert_gate_up, w_expert_down, final_gain):
    seq = x.shape[1]
    n_ctx = ctx.shape[1]
    rows = seq // GRID_W
    rope_mla = _axial_rope_tables(n_ctx, rows, MLA_ROPE)
    rope_gqa = _axial_rope_tables(n_ctx, rows, GQA_HEAD_DIM)
    s_lat = jax.nn.silu(c)
    s_ctx = jax.nn.silu(c_ctx)
    hs = jnp.concatenate([ctx, x], axis=1)
    for l in range(DEPTH):
        ml = jnp.split(s_lat @ w_ada[l] + b_ada[l], 6, axis=-1)
        mc = jnp.split(s_ctx @ w_ada[l] + b_ada[l], 6, axis=-1)
        hn = _modulate(_rmsnorm(hs), mc[0], mc[1], ml[0], ml[1], n_ctx)
        y = _mixer(hn, n_ctx, rope_mla, rope_gqa, w_in[l], sgu_gain[l], w_sgu[l], b_sgu[l],
                   mla_q_gain[l], w_uq[l], mla_kv_gain[l], w_ukv[l], w_conv[l], gqa_q_gain[l],
                   gqa_k_gain[l], w_gate[l], b_gate[l], w_branch[l], w_out[l])
        hs = hs + _gated(y, mc[2], ml[2], n_ctx)
        if l == DEPTH - 1:
            hs = hs[:, n_ctx:]
            n_keep = 0
        else:
            n_keep = n_ctx
        hn = _modulate(_rmsnorm(hs), mc[3], mc[4], ml[3], ml[4], n_keep)
        f = _moe(hn, w_group_router[l], b_group_router[l], w_expert_router[l], b_expert_router[l],
                 w_expert_gate_up[l], w_expert_down[l])
        hs = hs + _gated(f, mc[5], ml[5], n_keep)
    return _rmsnorm(hs, final_gain)
```

```cpp
#include <hip/hip_runtime.h>
#include <cstdio>
#include <cstdint>

namespace {
constexpr int NB = 8, NCTX = 256, NLAT = 2048, NTOK = NCTX + NLAT, T = NB * NTOK, D = 1024, L = 4;
constexpr int DIN = 2208, NE = 32, DE = 256, CAP = 2 * T + NE * 128, NTILE_MOE = CAP / 128;
constexpr float EPS = 1e-6f;
constexpr int ZO_AU = 0, ZO_AV = 256, ZO_MQ = 512, ZO_MKV = 768, ZO_KPE = 896, ZO_CB = 928, ZO_CC = 1184, ZO_CX = 1440, ZO_GQ = 1696, ZO_GK = 1952, ZO_GV = 2080;

__device__ __forceinline__ float wave_sum(float v) {
#pragma unroll
  for (int o = 1; o < 64; o <<= 1) v += __shfl_xor(v, o);
  return v;
}
__device__ __forceinline__ float gelu_tanh(float x) {
  const float u = 0.7978845608028654f * (x + 0.044715f * x * x * x);
  return 0.5f * x * (1.f + tanhf(u));
}
__device__ __forceinline__ float siluf(float x) { return x / (1.f + __expf(-x)); }
__device__ __forceinline__ float sigmoidf(float x) { return 1.f / (1.f + __expf(-x)); }

__global__ __launch_bounds__(256) void k_mod(const float* c, const float* c_ctx, const float* w_ada, const float* b_ada, float* mod) {
  __shared__ float s[9][D];
  const int l = blockIdx.y, n = blockIdx.x * 256 + threadIdx.x;
  for (int i = threadIdx.x; i < 9 * D; i += 256) { const int r = i / D, k = i % D; const float v = r < 8 ? c[r * D + k] : c_ctx[k]; s[r][k] = siluf(v); }
  __syncthreads();
  float acc[9];
#pragma unroll
  for (int r = 0; r < 9; ++r) acc[r] = 0.f;
  const float* w = w_ada + (size_t)l * D * 6 * D + n;
  for (int k = 0; k < D; ++k) { const float wv = w[(size_t)k * 6 * D];
#pragma unroll
    for (int r = 0; r < 9; ++r) acc[r] += s[r][k] * wv; }
  const float bv = b_ada[l * 6 * D + n];
#pragma unroll
  for (int r = 0; r < 9; ++r) mod[((size_t)l * 9 + r) * 6 * D + n] = acc[r] + bv;
}

__global__ __launch_bounds__(256) void k_init_hs(const float* x, const float* ctx, float* hs) {
  const size_t i = (size_t)blockIdx.x * 256 + threadIdx.x;
  if (i >= (size_t)T * D / 4) return;
  const size_t m = i / (D / 4), k4 = i % (D / 4); const int b = m / NTOK, t = m % NTOK;
  const float4 v = t < NCTX ? ((const float4*)ctx)[((size_t)b * NCTX + t) * (D / 4) + k4] : ((const float4*)x)[((size_t)b * NLAT + (t - NCTX)) * (D / 4) + k4];
  ((float4*)hs)[i] = v;
}

__global__ __launch_bounds__(256) void k_norm_mod(const float* hs, const float* mod  , int shift_idx, float* hn) {
  const int m = blockIdx.x * 4 + (threadIdx.x >> 6), lane = threadIdx.x & 63;
  if (m >= T) return;
  const int b = m / NTOK, t = m % NTOK, r = t < NCTX ? 8 : b;
  const float* sh = mod + (size_t)r * 6 * D + shift_idx * D; const float* sc = sh + D;
  const float4* xr = (const float4*)(hs + (size_t)m * D);
  float4 v[4]; float ss = 0.f;
#pragma unroll
  for (int j = 0; j < 4; ++j) { v[j] = xr[lane + 64 * j]; ss += v[j].x * v[j].x + v[j].y * v[j].y + v[j].z * v[j].z + v[j].w * v[j].w; }
  const float rinv = rsqrtf(wave_sum(ss) * (1.f / D) + EPS);
#pragma unroll
  for (int j = 0; j < 4; ++j) { const float4 a = ((const float4*)sc)[lane + 64 * j], s4 = ((const float4*)sh)[lane + 64 * j]; float4 o;
    o.x = v[j].x * rinv * (1.f + a.x) + s4.x; o.y = v[j].y * rinv * (1.f + a.y) + s4.y; o.z = v[j].z * rinv * (1.f + a.z) + s4.z; o.w = v[j].w * rinv * (1.f + a.w) + s4.w;
    ((float4*)(hn + (size_t)m * D))[lane + 64 * j] = o; }
}

template <bool GATHER>
__global__ __launch_bounds__(256) void k_sgemm(const float* __restrict__ A, int lda, const int* __restrict__ rowidx, const float* __restrict__ B, int ldb, long bstride,
                                               const int* __restrict__ grp, float* __restrict__ C, int ldc, int M, int N, int K) {
  __shared__ float As[8][132];
  __shared__ float Bs[8][132];
  const int tid = threadIdx.x, tx = tid & 15, ty = tid >> 4;
  const int m0 = blockIdx.y * 128, n0 = blockIdx.x * 128;
  int g = 0; if (grp) { g = grp[blockIdx.y]; if (g < 0) return; }
  const float* Bp = B + (size_t)g * bstride;
  const int ar = tid >> 1, ak = (tid & 1) * 4;
  long arow = m0 + ar; if (GATHER) arow = rowidx[m0 + ar];
  const float* Ap = A + (size_t)arow * lda + ak;
  const int bk = tid >> 5, bn = (tid & 31) * 4;
  const bool bok = (n0 + bn) < N;
  const float* Bq = Bp + (size_t)bk * ldb + n0 + bn;
  float acc[8][8];
#pragma unroll
  for (int i = 0; i < 8; ++i)
#pragma unroll
    for (int j = 0; j < 8; ++j) acc[i][j] = 0.f;
  for (int k0 = 0; k0 < K; k0 += 8) {
    const float4 av = *(const float4*)(Ap + k0);
    float4 bv = make_float4(0.f, 0.f, 0.f, 0.f); if (bok) bv = *(const float4*)(Bq + (size_t)k0 * ldb);
    __syncthreads();
    As[ak + 0][ar] = av.x; As[ak + 1][ar] = av.y; As[ak + 2][ar] = av.z; As[ak + 3][ar] = av.w;
    *(float4*)&Bs[bk][bn] = bv;
    __syncthreads();
#pragma unroll
    for (int k = 0; k < 8; ++k) {
      float a[8], b[8];
      *(float4*)&a[0] = *(const float4*)&As[k][ty * 4]; *(float4*)&a[4] = *(const float4*)&As[k][64 + ty * 4];
      *(float4*)&b[0] = *(const float4*)&Bs[k][tx * 4]; *(float4*)&b[4] = *(const float4*)&Bs[k][64 + tx * 4];
#pragma unroll
      for (int i = 0; i < 8; ++i)
#pragma unroll
        for (int j = 0; j < 8; ++j) acc[i][j] += a[i] * b[j];
    }
  }
#pragma unroll
  for (int i = 0; i < 8; ++i) { const int m = m0 + (i < 4 ? ty * 4 + i : 64 + ty * 4 + i - 4);
#pragma unroll
    for (int jh = 0; jh < 2; ++jh) { const int n = n0 + jh * 64 + tx * 4; if (n < N) *(float4*)(C + (size_t)m * ldc + n) = make_float4(acc[i][jh * 4 + 0], acc[i][jh * 4 + 1], acc[i][jh * 4 + 2], acc[i][jh * 4 + 3]); } }
}

template <int ROT> __device__ __forceinline__ void rope_cs(int t, int i, float& cs, float& sn) {
  constexpr int NF = ROT / 4;
  if (t < NCTX) { cs = 1.f; sn = 0.f; return; }
  const int tl = t - NCTX; const float pos = (i < NF) ? (float)(tl >> 6) : (float)(tl & 63); const int fi = i % NF;
  const float fr = exp2f(-(float)fi * (13.287712379549449f / (float)NF));
  float rev = pos * fr * 0.15915494309189535f; rev = rev - floorf(rev);
  cs = __builtin_amdgcn_cosf(rev); sn = __builtin_amdgcn_sinf(rev);
}
template <int ROT>
__device__ __forceinline__ void rope_inplace(float* x, int t) {
  if (t < NCTX) return;
  const int tl = t - NCTX; const float row = (float)(tl >> 6), col = (float)(tl & 63);
  constexpr int NF = ROT / 4, HALF = ROT / 2;
#pragma unroll
  for (int i = 0; i < HALF; ++i) { float cs, sn; rope_cs<ROT>(t, i, cs, sn); const float x1 = x[i], x2 = x[i + HALF]; x[i] = x1 * cs - x2 * sn; x[i + HALF] = x1 * sn + x2 * cs; }
}

__global__ __launch_bounds__(256) void k_post_z(const float* z, const float* sgu_gain, const float* mq_gain, const float* mkv_gain, const float* gq_gain, const float* gk_gain,
                                              float* GU, float* AVN, float* MQN, float* MKVN, float* KPE, float* QD, float* KD) {
  const int m = blockIdx.x * 4 + (threadIdx.x >> 6), lane = threadIdx.x & 63;
  if (m >= T) return;
  const int t = m % NTOK; const float* zr = z + (size_t)m * DIN;
  for (int j = 0; j < 4; ++j) { const int c = lane + 64 * j; GU[(size_t)m * 256 + c] = gelu_tanh(zr[ZO_AU + c]); }
  { float v[4], ss = 0.f;
_Pragma("unroll") for (int j = 0; j < 4; ++j) { v[j] = gelu_tanh(zr[ZO_AV + lane + 64 * j]); ss += v[j] * v[j]; }
    const float rinv = rsqrtf(wave_sum(ss) * (1.f / 256.f) + EPS);
_Pragma("unroll") for (int j = 0; j < 4; ++j) { const int c = lane + 64 * j; AVN[(size_t)m * 256 + c] = v[j] * rinv * sgu_gain[c]; } }
  { float v[4], ss = 0.f;
_Pragma("unroll") for (int j = 0; j < 4; ++j) { v[j] = zr[ZO_MQ + lane + 64 * j]; ss += v[j] * v[j]; }
    const float rinv = rsqrtf(wave_sum(ss) * (1.f / 256.f) + EPS);
_Pragma("unroll") for (int j = 0; j < 4; ++j) { const int c = lane + 64 * j; MQN[(size_t)m * 256 + c] = v[j] * rinv * mq_gain[c]; } }
  { float v[2], ss = 0.f;
_Pragma("unroll") for (int j = 0; j < 2; ++j) { v[j] = zr[ZO_MKV + lane + 64 * j]; ss += v[j] * v[j]; }
    const float rinv = rsqrtf(wave_sum(ss) * (1.f / 128.f) + EPS);
_Pragma("unroll") for (int j = 0; j < 2; ++j) { const int c = lane + 64 * j; MKVN[(size_t)m * 128 + c] = v[j] * rinv * mkv_gain[c]; } }
  { const float xv = lane < 32 ? zr[ZO_KPE + (lane & 31)] : 0.f; const float xp = __shfl_xor(xv, 16); const int i = lane & 15; float cs, sn; rope_cs<32>(t, i, cs, sn);
    const float o = (lane & 16) ? (xp * sn + xv * cs) : (xv * cs - xp * sn); if (lane < 32) KPE[(size_t)m * 32 + lane] = o; }
  for (int hh = 0; hh < 6; ++hh) { const bool isq = hh < 4; const int h = isq ? hh : hh - 4; const float xv0 = zr[(isq ? ZO_GQ : ZO_GK) + h * 64 + lane];
    const float rinv = rsqrtf(wave_sum(xv0 * xv0) * (1.f / 64.f) + EPS); const float xv = xv0 * rinv * (isq ? gq_gain[lane] : gk_gain[lane]);
    const float xp = __shfl_xor(xv, 32); const int i = lane & 31; float cs, sn; rope_cs<64>(t, i, cs, sn);
    const float o = (lane & 32) ? (xp * sn + xv * cs) : (xv * cs - xp * sn);
    if (isq) QD[((size_t)m * 4 + h) * 64 + lane] = o; else KD[((size_t)m * 2 + h) * 64 + lane] = o; }
}

__global__ __launch_bounds__(256) void k_post_mla(float* q32, const float* kv32, const float* KPE, float* KM) {
  const int m = blockIdx.x * 256 + threadIdx.x; if (m >= T) return; const int t = m % NTOK;
  for (int h = 0; h < 4; ++h) { float x[32]; float* p = q32 + (size_t)m * 384 + h * 96 + 64;
_Pragma("unroll") for (int i = 0; i < 32; ++i) x[i] = p[i];
 rope_inplace<32>(x, t);
_Pragma("unroll") for (int i = 0; i < 32; ++i) p[i] = x[i];
    float* km = KM + ((size_t)m * 4 + h) * 96; const float* kn = kv32 + (size_t)m * 512 + h * 128; for (int i = 0; i < 64; ++i) km[i] = kn[i]; for (int i = 0; i < 32; ++i) km[64 + i] = KPE[(size_t)m * 32 + i]; }
}

template <int DK>
__global__ __launch_bounds__(128) void k_attn(const float* __restrict__ Q, int ldq, const float* __restrict__ K, int ldk, const float* __restrict__ V, int ldv, float* __restrict__ O, int ldo,
                                              int qh_stride, int kh_stride, int vh_stride, int oh_stride, int rep, float scale) {
  __shared__ float Ks[32][DK];
  __shared__ float Vs[32][64];
  const int m0 = blockIdx.x * 128, h = blockIdx.y, kvh = h / rep; const int b = m0 / NTOK, t0 = m0 % NTOK; const int kvn = t0 < NCTX ? NCTX : NTOK;
  const int m = m0 + threadIdx.x;
  float q[DK]; { const float* qp = Q + (size_t)m * ldq + h * qh_stride;
#pragma unroll
    for (int i = 0; i < DK; ++i) q[i] = qp[i] * scale; }
  float o[64];
#pragma unroll
  for (int i = 0; i < 64; ++i) o[i] = 0.f;
  float mx = -1e30f, l = 0.f;
  for (int k0 = 0; k0 < kvn; k0 += 32) {
    __syncthreads();
    for (int i = threadIdx.x; i < 32 * DK; i += 128) { const int r = i / DK, cc = i % DK; Ks[r][cc] = K[(size_t)(b * NTOK + k0 + r) * ldk + kvh * kh_stride + cc]; }
    for (int i = threadIdx.x; i < 32 * 64; i += 128) { const int r = i / 64, cc = i % 64; Vs[r][cc] = V[(size_t)(b * NTOK + k0 + r) * ldv + kvh * vh_stride + cc]; }
    __syncthreads();
    float s[32]; float tm = -1e30f;
#pragma unroll
    for (int j = 0; j < 32; ++j) { float a = 0.f;
#pragma unroll
      for (int i = 0; i < DK; ++i) a += q[i] * Ks[j][i];
      s[j] = a; tm = fmaxf(tm, a); }
    const float mn = fmaxf(mx, tm), alpha = __expf(mx - mn); mx = mn; l *= alpha;
#pragma unroll
    for (int i = 0; i < 64; ++i) o[i] *= alpha;
#pragma unroll
    for (int j = 0; j < 32; ++j) { const float p = __expf(s[j] - mn); l += p;
#pragma unroll
      for (int i = 0; i < 64; ++i) o[i] += p * Vs[j][i]; }
  }
  const float rl = 1.f / l; float* op = O + (size_t)m * ldo + h * oh_stride;
#pragma unroll
  for (int i = 0; i < 64; ++i) op[i] = o[i] * rl;
}

__global__ __launch_bounds__(256) void k_chunkmix(const float* GU, const float* AVN, const float* w_s, const float* b_s, float* Y) {
  const int m = blockIdx.x, c = threadIdx.x; const int g = c >> 6, p = m & 127, base = m - p;
  const float* w = w_s + ((size_t)g * 128 + p) * 128; float a = 0.f;
  for (int q = 0; q < 128; ++q) a += w[q] * AVN[(size_t)(base + q) * 256 + c];
  Y[(size_t)m * D + c] = GU[(size_t)m * 256 + c] * (a + b_s[g * 128 + p]);
}
__global__ __launch_bounds__(256) void k_conv(const float* z, const float* w_conv, float* Y) {
  const int m = blockIdx.x, c = threadIdx.x; const int t = m % NTOK; const int lo = t < NCTX ? 0 : NCTX, hi = t < NCTX ? NCTX : NTOK;
  float a = 0.f;
  for (int j = 0; j < 3; ++j) { const int tt = t + j - 1; if (tt < lo || tt >= hi) continue; const float* zr = z + (size_t)(m + j - 1) * DIN; a += w_conv[j * 256 + c] * zr[ZO_CC + c] * zr[ZO_CX + c]; }
  Y[(size_t)m * D + 512 + c] = z[(size_t)m * DIN + ZO_CB + c] * a;
}
__global__ __launch_bounds__(256) void k_merge(const float* G, const float* bg, const float* Zb, float* merged, int first) {
  const size_t i = (size_t)blockIdx.x * 256 + threadIdx.x; if (i >= (size_t)T * D) return; const int n = i % D;
  const float v = sigmoidf(G[i] + bg[n]) * Zb[i]; merged[i] = first ? v : merged[i] + v;
}
__global__ __launch_bounds__(256) void k_resid(float* hs, const float* y, const float* mod, int gate_idx) {
  const size_t i = (size_t)blockIdx.x * 256 + threadIdx.x; if (i >= (size_t)T * D) return; const int n = i % D; const size_t m = i / D; const int b = m / NTOK, t = m % NTOK, r = t < NCTX ? 8 : b;
  hs[i] += mod[(size_t)r * 6 * D + gate_idx * D + n] * y[i];
}
__global__ __launch_bounds__(256) void k_router(const float* hn, const float* wgr, const float* bgr, const float* wer, const float* ber, int* tok_e, float* tok_w, int* counts, int skip_ctx) {
  const int m = blockIdx.x * 4 + (threadIdx.x >> 6), lane = threadIdx.x & 63; if (m >= T) return;
  if (skip_ctx && (m % NTOK) < NCTX) { if (lane == 0) { tok_e[2 * m] = -1; tok_e[2 * m + 1] = -1; } return; }
  float acc[36];
#pragma unroll
  for (int j = 0; j < 36; ++j) acc[j] = 0.f;
  for (int i = 0; i < 16; ++i) { const int k = lane + 64 * i; const float h = hn[(size_t)m * D + k];
#pragma unroll
    for (int j = 0; j < 4; ++j) acc[j] += h * wgr[k * 4 + j];
#pragma unroll
    for (int j = 0; j < 32; ++j) acc[4 + j] += h * wer[k * 32 + j]; }
#pragma unroll
  for (int j = 0; j < 36; ++j) acc[j] = wave_sum(acc[j]);
  if (lane == 0) {
    float mxg = -1e30f; int g = 0;
#pragma unroll
    for (int j = 0; j < 4; ++j) { const float v = acc[j] + bgr[j]; if (v > mxg) { mxg = v; g = j; } }
    float sg = 0.f;
#pragma unroll
    for (int j = 0; j < 4; ++j) sg += __expf(acc[j] + bgr[j] - mxg);
    const float pg = 1.f / sg;
    float v0 = -1e30f, v1 = -1e30f; int e0 = 0, e1 = 0;
#pragma unroll
    for (int j = 0; j < 8; ++j) { float le = 0.f;
#pragma unroll
      for (int gg = 0; gg < 4; ++gg) if (gg == g) le = acc[4 + gg * 8 + j];
      le += ber[g * 8 + j];
      if (le > v0) { v1 = v0; e1 = e0; v0 = le; e0 = j; } else if (le > v1) { v1 = le; e1 = j; } }
    const float p0 = 1.f, p1 = __expf(v1 - v0); const float inv = pg / (p0 + p1);
    tok_e[2 * m] = g * 8 + e0; tok_e[2 * m + 1] = g * 8 + e1; tok_w[2 * m] = p0 * inv; tok_w[2 * m + 1] = p1 * inv;
    atomicAdd(&counts[g * 8 + e0], 1); atomicAdd(&counts[g * 8 + e1], 1);
  }
}
__global__ __launch_bounds__(256) void k_scan(const int* counts, int* pstart, int* cursor, int* tile_e, int* slot_tok) {
  __shared__ int ps[NE + 1];
  if (threadIdx.x == 0) { int a = 0; for (int e = 0; e < NE; ++e) { ps[e] = a; a += (counts[e] + 127) / 128 * 128; } ps[NE] = a; }
  __syncthreads();
  if (threadIdx.x < NE) { pstart[threadIdx.x] = ps[threadIdx.x]; cursor[threadIdx.x] = 0; }
  for (int i = threadIdx.x; i < NTILE_MOE; i += 256) { int e = -1; for (int j = 0; j < NE; ++j) if (i * 128 >= ps[j] && i * 128 < ps[j + 1]) e = j; tile_e[i] = e; }
  for (int i = threadIdx.x; i < CAP; i += 256) slot_tok[i] = 0;
}
__global__ __launch_bounds__(256) void k_scatter(const int* tok_e, const int* pstart, int* cursor, int* slot_tok, int* tok_slot) {
  const int i = blockIdx.x * 256 + threadIdx.x; if (i >= 2 * T) return; const int e = tok_e[i]; if (e < 0) { tok_slot[i] = -1; return; }
  const int pos = pstart[e] + atomicAdd(&cursor[e], 1); slot_tok[pos] = i >> 1; tok_slot[i] = pos;
}
__global__ __launch_bounds__(256) void k_moe_act(const float* GUs, float* Hs) {
  const size_t i = (size_t)blockIdx.x * 256 + threadIdx.x; if (i >= (size_t)CAP * 256) return; const size_t s = i / 256; const int c = i % 256;
  Hs[i] = siluf(GUs[s * 512 + c]) * GUs[s * 512 + 256 + c];
}
__global__ __launch_bounds__(256) void k_moe_combine(float* hs, const float* Fs, const int* tok_slot, const float* tok_w, const float* mod) {
  const size_t i = (size_t)blockIdx.x * 256 + threadIdx.x; if (i >= (size_t)T * D) return; const int n = i % D; const size_t m = i / D; const int s0 = tok_slot[2 * m], s1 = tok_slot[2 * m + 1]; if (s0 < 0) return;
  const int b = m / NTOK, t = m % NTOK, r = t < NCTX ? 8 : b;
  hs[i] += mod[(size_t)r * 6 * D + 5 * D + n] * (tok_w[2 * m] * Fs[(size_t)s0 * D + n] + tok_w[2 * m + 1] * Fs[(size_t)s1 * D + n]);
}
__global__ __launch_bounds__(256) void k_final(const float* hs, const float* fg, float* out) {
  const int r = blockIdx.x * 4 + (threadIdx.x >> 6), lane = threadIdx.x & 63; if (r >= NB * NLAT) return; const int b = r / NLAT, tl = r % NLAT; const size_t m = (size_t)b * NTOK + NCTX + tl;
  const float4* xr = (const float4*)(hs + m * D); float4 v[4]; float ss = 0.f;
#pragma unroll
  for (int j = 0; j < 4; ++j) { v[j] = xr[lane + 64 * j]; ss += v[j].x * v[j].x + v[j].y * v[j].y + v[j].z * v[j].z + v[j].w * v[j].w; }
  const float rinv = rsqrtf(wave_sum(ss) * (1.f / D) + EPS);
#pragma unroll
  for (int j = 0; j < 4; ++j) { const float4 g = ((const float4*)fg)[lane + 64 * j]; float4 o; o.x = v[j].x * rinv * g.x; o.y = v[j].y * rinv * g.y; o.z = v[j].z * rinv * g.z; o.w = v[j].w * rinv * g.w; ((float4*)(out + (size_t)r * D))[lane + 64 * j] = o; }
}

inline void sgemm(hipStream_t st, const float* A, int lda, const float* B, int ldb, float* C, int ldc, int M, int N, int K) {
  dim3 grid((N + 127) / 128, M / 128);
  hipLaunchKernelGGL(k_sgemm<false>, grid, dim3(256), 0, st, A, lda, (const int*)nullptr, B, ldb, 0L, (const int*)nullptr, C, ldc, M, N, K);
}
}

extern "C" void kernel_launch(void* const* d_in, const int* in_sizes, int n_in, void* d_out, int out_size, void* d_ws, size_t ws_size, hipStream_t stream) {
  const float* x = (const float*)d_in[0]; const float* c = (const float*)d_in[1]; const float* ctx = (const float*)d_in[2]; const float* c_ctx = (const float*)d_in[3];
  const float* w_ada = (const float*)d_in[4]; const float* b_ada = (const float*)d_in[5]; const float* w_in = (const float*)d_in[6]; const float* sgu_gain = (const float*)d_in[7];
  const float* w_sgu = (const float*)d_in[8]; const float* b_sgu = (const float*)d_in[9]; const float* mq_gain = (const float*)d_in[10]; const float* w_uq = (const float*)d_in[11];
  const float* mkv_gain = (const float*)d_in[12]; const float* w_ukv = (const float*)d_in[13]; const float* w_conv = (const float*)d_in[14]; const float* gq_gain = (const float*)d_in[15];
  const float* gk_gain = (const float*)d_in[16]; const float* w_gate = (const float*)d_in[17]; const float* b_gate = (const float*)d_in[18]; const float* w_branch = (const float*)d_in[19];
  const float* w_out = (const float*)d_in[20]; const float* w_gr = (const float*)d_in[21]; const float* b_gr = (const float*)d_in[22]; const float* w_er = (const float*)d_in[23];
  const float* b_er = (const float*)d_in[24]; const float* w_gu = (const float*)d_in[25]; const float* w_dn = (const float*)d_in[26]; const float* final_gain = (const float*)d_in[27];
  float* out = (float*)d_out;
  char* w = (char*)d_ws; size_t off = 0;
  auto alloc = [&](size_t bytes) { char* p = w + off; off += (bytes + 255) / 256 * 256; return p; };
  float* MOD = (float*)alloc((size_t)L * 9 * 6 * D * 4);
  float* HS = (float*)alloc((size_t)T * D * 4);
  float* HN = (float*)alloc((size_t)T * D * 4);
  float* Y = (float*)alloc((size_t)T * D * 4);
  float* MERGED = (float*)alloc((size_t)T * D * 4);
  float* G32 = (float*)alloc((size_t)T * D * 4);
  float* ZB32 = (float*)alloc((size_t)T * D * 4);
  int* TOK_E = (int*)alloc((size_t)2 * T * 4); float* TOK_W = (float*)alloc((size_t)2 * T * 4); int* TOK_SLOT = (int*)alloc((size_t)2 * T * 4);
  int* COUNTS = (int*)alloc(256); int* PSTART = (int*)alloc(256); int* CURSOR = (int*)alloc(256); int* TILE_E = (int*)alloc(NTILE_MOE * 4 + 256); int* SLOT_TOK = (int*)alloc((size_t)CAP * 4);
  const size_t arena = off;
  float* Z32 = (float*)alloc((size_t)T * DIN * 4);
  float* GU = (float*)alloc((size_t)T * 256 * 4); float* AVN = (float*)alloc((size_t)T * 256 * 4); float* MQN = (float*)alloc((size_t)T * 256 * 4); float* MKVN = (float*)alloc((size_t)T * 128 * 4);
  float* KPE = (float*)alloc((size_t)T * 32 * 4); float* QD = (float*)alloc((size_t)T * 256 * 4); float* KD = (float*)alloc((size_t)T * 128 * 4);
  float* Q32 = (float*)alloc((size_t)T * 384 * 4); float* KV32 = (float*)alloc((size_t)T * 512 * 4); float* KM = (float*)alloc((size_t)T * 384 * 4);
  const size_t mixer_end = off;
  off = arena;
  float* GUS = (float*)alloc((size_t)CAP * 512 * 4); float* HSL = (float*)alloc((size_t)CAP * 256 * 4); float* FS = (float*)alloc((size_t)CAP * D * 4);
  const size_t moe_end = off;
  const size_t need = mixer_end > moe_end ? mixer_end : moe_end;
  if (need > ws_size) { fprintf(stderr, "kernel_launch: workspace too small: need %zu have %zu\n", need, ws_size); return; }

  const int EW = (int)(((size_t)T * D + 255) / 256);
  hipLaunchKernelGGL(k_mod, dim3(6 * D / 256, L), dim3(256), 0, stream, c, c_ctx, w_ada, b_ada, MOD);
  hipLaunchKernelGGL(k_init_hs, dim3((T * D / 4 + 255) / 256), dim3(256), 0, stream, x, ctx, HS);
  for (int l = 0; l < L; ++l) {
    const float* mod = MOD + (size_t)l * 9 * 6 * D;
    hipLaunchKernelGGL(k_norm_mod, dim3(T / 4), dim3(256), 0, stream, HS, mod, 0, HN);
    sgemm(stream, HN, D, w_in + (size_t)l * D * DIN, DIN, Z32, DIN, T, DIN, D);
    hipLaunchKernelGGL(k_post_z, dim3(T / 4), dim3(256), 0, stream, Z32, sgu_gain + l * 256, mq_gain + l * 256, mkv_gain + l * 128, gq_gain + l * 64, gk_gain + l * 64, GU, AVN, MQN, MKVN, KPE, QD, KD);
    sgemm(stream, MQN, 256, w_uq + (size_t)l * 256 * 384, 384, Q32, 384, T, 384, 256);
    sgemm(stream, MKVN, 128, w_ukv + (size_t)l * 128 * 512, 512, KV32, 512, T, 512, 128);
    hipLaunchKernelGGL(k_post_mla, dim3(T / 256), dim3(256), 0, stream, Q32, KV32, KPE, KM);
    hipLaunchKernelGGL(k_chunkmix, dim3(T), dim3(256), 0, stream, GU, AVN, w_sgu + (size_t)l * 4 * 128 * 128, b_sgu + l * 4 * 128, Y);
    hipLaunchKernelGGL(k_conv, dim3(T), dim3(256), 0, stream, Z32, w_conv + l * 3 * 256, Y);
    hipLaunchKernelGGL(k_attn<96>, dim3(T / 128, 4), dim3(128), 0, stream, Q32, 384, KM, 384, KV32 + 64, 512, Y + 256, D, 96, 96, 128, 64, 1, 0.10206207261596577f);
    hipLaunchKernelGGL(k_attn<64>, dim3(T / 128, 4), dim3(128), 0, stream, QD, 256, KD, 128, Z32 + ZO_GV, DIN, Y + 768, D, 64, 64, 64, 64, 2, 0.125f);
    for (int i = 0; i < 4; ++i) {
      sgemm(stream, HN, D, w_gate + ((size_t)l * 4 + i) * D * D, D, G32, D, T, D, D);
      sgemm(stream, Y + i * 256, D, w_branch + ((size_t)l * 4 + i) * 256 * D, D, ZB32, D, T, D, 256);
      hipLaunchKernelGGL(k_merge, dim3(EW), dim3(256), 0, stream, G32, b_gate + ((size_t)l * 4 + i) * D, ZB32, MERGED, i == 0 ? 1 : 0);
    }
    sgemm(stream, MERGED, D, w_out + (size_t)l * D * D, D, G32, D, T, D, D);
    hipLaunchKernelGGL(k_resid, dim3(EW), dim3(256), 0, stream, HS, G32, mod, 2);
    hipLaunchKernelGGL(k_norm_mod, dim3(T / 4), dim3(256), 0, stream, HS, mod, 3, HN);
    hipMemsetAsync(COUNTS, 0, 256, stream);
    hipLaunchKernelGGL(k_router, dim3(T / 4), dim3(256), 0, stream, HN, w_gr + (size_t)l * D * 4, b_gr + l * 4, w_er + (size_t)l * D * 32, b_er + l * 32, TOK_E, TOK_W, COUNTS, l == L - 1 ? 1 : 0);
    hipLaunchKernelGGL(k_scan, dim3(1), dim3(256), 0, stream, COUNTS, PSTART, CURSOR, TILE_E, SLOT_TOK);
    hipLaunchKernelGGL(k_scatter, dim3(2 * T / 256), dim3(256), 0, stream, TOK_E, PSTART, CURSOR, SLOT_TOK, TOK_SLOT);
    hipLaunchKernelGGL(k_sgemm<true>, dim3(4, NTILE_MOE), dim3(256), 0, stream, HN, D, SLOT_TOK, w_gu + (size_t)l * NE * D * 512, 512, (long)D * 512, TILE_E, GUS, 512, CAP, 512, D);
    hipLaunchKernelGGL(k_moe_act, dim3(CAP), dim3(256), 0, stream, GUS, HSL);
    hipLaunchKernelGGL(k_sgemm<false>, dim3(8, NTILE_MOE), dim3(256), 0, stream, HSL, 256, (const int*)nullptr, w_dn + (size_t)l * NE * 256 * D, D, (long)256 * D, TILE_E, FS, D, CAP, D, 256);
    hipLaunchKernelGGL(k_moe_combine, dim3(EW), dim3(256), 0, stream, HS, FS, TOK_SLOT, TOK_W, mod);
  }
  hipLaunchKernelGGL(k_final, dim3(NB * NLAT / 4), dim3(256), 0, stream, HS, final_gain, out);
}
```

```cpp
#include <hip/hip_runtime.h>
#include <cstdio>
#include <cstdint>
namespace v0 {

constexpr int NB = 8, NCTX = 256, NLAT = 2048, NTOK = NCTX + NLAT, T = NB * NTOK, D = 1024, L = 4;
constexpr int DIN = 2208, NE = 32, DE = 256, CAP = 2 * T + NE * 128, NTILE_MOE = CAP / 128;
constexpr float EPS = 1e-6f;
constexpr int ZO_AU = 0, ZO_AV = 256, ZO_MQ = 512, ZO_MKV = 768, ZO_KPE = 896, ZO_CB = 928, ZO_CC = 1184, ZO_CX = 1440, ZO_GQ = 1696, ZO_GK = 1952, ZO_GV = 2080;

__device__ __forceinline__ float wave_sum(float v) {
#pragma unroll
  for (int o = 1; o < 64; o <<= 1) v += __shfl_xor(v, o);
  return v;
}
__device__ __forceinline__ float gelu_tanh(float x) {
  const float u = 0.7978845608028654f * (x + 0.044715f * x * x * x);
  return 0.5f * x * (1.f + tanhf(u));
}
__device__ __forceinline__ float siluf(float x) { return x / (1.f + __expf(-x)); }
__device__ __forceinline__ float sigmoidf(float x) { return 1.f / (1.f + __expf(-x)); }

__global__ __launch_bounds__(256) void k_mod(const float* c, const float* c_ctx, const float* w_ada, const float* b_ada, float* mod) {
  __shared__ float s[9][D];
  const int l = blockIdx.y, n = blockIdx.x * 256 + threadIdx.x;
  for (int i = threadIdx.x; i < 9 * D; i += 256) { const int r = i / D, k = i % D; const float v = r < 8 ? c[r * D + k] : c_ctx[k]; s[r][k] = siluf(v); }
  __syncthreads();
  float acc[9];
#pragma unroll
  for (int r = 0; r < 9; ++r) acc[r] = 0.f;
  const float* w = w_ada + (size_t)l * D * 6 * D + n;
  for (int k = 0; k < D; ++k) { const float wv = w[(size_t)k * 6 * D];
#pragma unroll
    for (int r = 0; r < 9; ++r) acc[r] += s[r][k] * wv; }
  const float bv = b_ada[l * 6 * D + n];
#pragma unroll
  for (int r = 0; r < 9; ++r) mod[((size_t)l * 9 + r) * 6 * D + n] = acc[r] + bv;
}

__global__ __launch_bounds__(256) void k_init_hs(const float* x, const float* ctx, float* hs) {
  const size_t i = (size_t)blockIdx.x * 256 + threadIdx.x;
  if (i >= (size_t)T * D / 4) return;
  const size_t m = i / (D / 4), k4 = i % (D / 4); const int b = m / NTOK, t = m % NTOK;
  const float4 v = t < NCTX ? ((const float4*)ctx)[((size_t)b * NCTX + t) * (D / 4) + k4] : ((const float4*)x)[((size_t)b * NLAT + (t - NCTX)) * (D / 4) + k4];
  ((float4*)hs)[i] = v;
}

__global__ __launch_bounds__(256) void k_norm_mod(const float* hs, const float* mod  , int shift_idx, float* hn) {
  const int m = blockIdx.x * 4 + (threadIdx.x >> 6), lane = threadIdx.x & 63;
  if (m >= T) return;
  const int b = m / NTOK, t = m % NTOK, r = t < NCTX ? 8 : b;
  const float* sh = mod + (size_t)r * 6 * D + shift_idx * D; const float* sc = sh + D;
  const float4* xr = (const float4*)(hs + (size_t)m * D);
  float4 v[4]; float ss = 0.f;
#pragma unroll
  for (int j = 0; j < 4; ++j) { v[j] = xr[lane + 64 * j]; ss += v[j].x * v[j].x + v[j].y * v[j].y + v[j].z * v[j].z + v[j].w * v[j].w; }
  const float rinv = rsqrtf(wave_sum(ss) * (1.f / D) + EPS);
#pragma unroll
  for (int j = 0; j < 4; ++j) { const float4 a = ((const float4*)sc)[lane + 64 * j], s4 = ((const float4*)sh)[lane + 64 * j]; float4 o;
    o.x = v[j].x * rinv * (1.f + a.x) + s4.x; o.y = v[j].y * rinv * (1.f + a.y) + s4.y; o.z = v[j].z * rinv * (1.f + a.z) + s4.z; o.w = v[j].w * rinv * (1.f + a.w) + s4.w;
    ((float4*)(hn + (size_t)m * D))[lane + 64 * j] = o; }
}

template <bool GATHER>
__global__ __launch_bounds__(256) void k_sgemm(const float* __restrict__ A, int lda, const int* __restrict__ rowidx, const float* __restrict__ B, int ldb, long bstride,
                                               const int* __restrict__ grp, float* __restrict__ C, int ldc, int M, int N, int K) {
  __shared__ float As[8][132];
  __shared__ float Bs[8][132];
  const int tid = threadIdx.x, tx = tid & 15, ty = tid >> 4;
  const int m0 = blockIdx.y * 128, n0 = blockIdx.x * 128;
  int g = 0; if (grp) { g = grp[blockIdx.y]; if (g < 0) return; }
  const float* Bp = B + (size_t)g * bstride;
  const int ar = tid >> 1, ak = (tid & 1) * 4;
  long arow = m0 + ar; if (GATHER) arow = rowidx[m0 + ar];
  const float* Ap = A + (size_t)arow * lda + ak;
  const int bk = tid >> 5, bn = (tid & 31) * 4;
  const bool bok = (n0 + bn) < N;
  const float* Bq = Bp + (size_t)bk * ldb + n0 + bn;
  float acc[8][8];
#pragma unroll
  for (int i = 0; i < 8; ++i)
#pragma unroll
    for (int j = 0; j < 8; ++j) acc[i][j] = 0.f;
  for (int k0 = 0; k0 < K; k0 += 8) {
    const float4 av = *(const float4*)(Ap + k0);
    float4 bv = make_float4(0.f, 0.f, 0.f, 0.f); if (bok) bv = *(const float4*)(Bq + (size_t)k0 * ldb);
    __syncthreads();
    As[ak + 0][ar] = av.x; As[ak + 1][ar] = av.y; As[ak + 2][ar] = av.z; As[ak + 3][ar] = av.w;
    *(float4*)&Bs[bk][bn] = bv;
    __syncthreads();
#pragma unroll
    for (int k = 0; k < 8; ++k) {
      float a[8], b[8];
      *(float4*)&a[0] = *(const float4*)&As[k][ty * 4]; *(float4*)&a[4] = *(const float4*)&As[k][64 + ty * 4];
      *(float4*)&b[0] = *(const float4*)&Bs[k][tx * 4]; *(float4*)&b[4] = *(const float4*)&Bs[k][64 + tx * 4];
#pragma unroll
      for (int i = 0; i < 8; ++i)
#pragma unroll
        for (int j = 0; j < 8; ++j) acc[i][j] += a[i] * b[j];
    }
  }
#pragma unroll
  for (int i = 0; i < 8; ++i) { const int m = m0 + (i < 4 ? ty * 4 + i : 64 + ty * 4 + i - 4);
#pragma unroll
    for (int jh = 0; jh < 2; ++jh) { const int n = n0 + jh * 64 + tx * 4; if (n < N) *(float4*)(C + (size_t)m * ldc + n) = make_float4(acc[i][jh * 4 + 0], acc[i][jh * 4 + 1], acc[i][jh * 4 + 2], acc[i][jh * 4 + 3]); } }
}

template <int ROT> __device__ __forceinline__ void rope_cs(int t, int i, float& cs, float& sn) {
  constexpr int NF = ROT / 4;
  if (t < NCTX) { cs = 1.f; sn = 0.f; return; }
  const int tl = t - NCTX; const float pos = (i < NF) ? (float)(tl >> 6) : (float)(tl & 63); const int fi = i % NF;
  const float fr = exp2f(-(float)fi * (13.287712379549449f / (float)NF));
  float rev = pos * fr * 0.15915494309189535f; rev = rev - floorf(rev);
  cs = __builtin_amdgcn_cosf(rev); sn = __builtin_amdgcn_sinf(rev);
}
template <int ROT>
__device__ __forceinline__ void rope_inplace(float* x, int t) {
  if (t < NCTX) return;
  const int tl = t - NCTX; const float row = (float)(tl >> 6), col = (float)(tl & 63);
  constexpr int NF = ROT / 4, HALF = ROT / 2;
#pragma unroll
  for (int i = 0; i < HALF; ++i) { float cs, sn; rope_cs<ROT>(t, i, cs, sn); const float x1 = x[i], x2 = x[i + HALF]; x[i] = x1 * cs - x2 * sn; x[i + HALF] = x1 * sn + x2 * cs; }
}

__global__ __launch_bounds__(256) void k_post_z(const float* z, const float* sgu_gain, const float* mq_gain, const float* mkv_gain, const float* gq_gain, const float* gk_gain,
                                              float* GU, float* AVN, float* MQN, float* MKVN, float* KPE, float* QD, float* KD) {
  const int m = blockIdx.x * 4 + (threadIdx.x >> 6), lane = threadIdx.x & 63;
  if (m >= T) return;
  const int t = m % NTOK; const float* zr = z + (size_t)m * DIN;
  for (int j = 0; j < 4; ++j) { const int c = lane + 64 * j; GU[(size_t)m * 256 + c] = gelu_tanh(zr[ZO_AU + c]); }
  { float v[4], ss = 0.f;
_Pragma("unroll") for (int j = 0; j < 4; ++j) { v[j] = gelu_tanh(zr[ZO_AV + lane + 64 * j]); ss += v[j] * v[j]; }
    const float rinv = rsqrtf(wave_sum(ss) * (1.f / 256.f) + EPS);
_Pragma("unroll") for (int j = 0; j < 4; ++j) { const int c = lane + 64 * j; AVN[(size_t)m * 256 + c] = v[j] * rinv * sgu_gain[c]; } }
  { float v[4], ss = 0.f;
_Pragma("unroll") for (int j = 0; j < 4; ++j) { v[j] = zr[ZO_MQ + lane + 64 * j]; ss += v[j] * v[j]; }
    const float rinv = rsqrtf(wave_sum(ss) * (1.f / 256.f) + EPS);
_Pragma("unroll") for (int j = 0; j < 4; ++j) { const int c = lane + 64 * j; MQN[(size_t)m * 256 + c] = v[j] * rinv * mq_gain[c]; } }
  { float v[2], ss = 0.f;
_Pragma("unroll") for (int j = 0; j < 2; ++j) { v[j] = zr[ZO_MKV + lane + 64 * j]; ss += v[j] * v[j]; }
    const float rinv = rsqrtf(wave_sum(ss) * (1.f / 128.f) + EPS);
_Pragma("unroll") for (int j = 0; j < 2; ++j) { const int c = lane + 64 * j; MKVN[(size_t)m * 128 + c] = v[j] * rinv * mkv_gain[c]; } }
  { const float xv = lane < 32 ? zr[ZO_KPE + (lane & 31)] : 0.f; const float xp = __shfl_xor(xv, 16); const int i = lane & 15; float cs, sn; rope_cs<32>(t, i, cs, sn);
    const float o = (lane & 16) ? (xp * sn + xv * cs) : (xv * cs - xp * sn); if (lane < 32) KPE[(size_t)m * 32 + lane] = o; }
  for (int hh = 0; hh < 6; ++hh) { const bool isq = hh < 4; const int h = isq ? hh : hh - 4; const float xv0 = zr[(isq ? ZO_GQ : ZO_GK) + h * 64 + lane];
    const float rinv = rsqrtf(wave_sum(xv0 * xv0) * (1.f / 64.f) + EPS); const float xv = xv0 * rinv * (isq ? gq_gain[lane] : gk_gain[lane]);
    const float xp = __shfl_xor(xv, 32); const int i = lane & 31; float cs, sn; rope_cs<64>(t, i, cs, sn);
    const float o = (lane & 32) ? (xp * sn + xv * cs) : (xv * cs - xp * sn);
    if (isq) QD[((size_t)m * 4 + h) * 64 + lane] = o; else KD[((size_t)m * 2 + h) * 64 + lane] = o; }
}

__global__ __launch_bounds__(256) void k_post_mla(float* q32, const float* kv32, const float* KPE, float* KM) {
  const int m = blockIdx.x * 256 + threadIdx.x; if (m >= T) return; const int t = m % NTOK;
  for (int h = 0; h < 4; ++h) { float x[32]; float* p = q32 + (size_t)m * 384 + h * 96 + 64;
_Pragma("unroll") for (int i = 0; i < 32; ++i) x[i] = p[i];
 rope_inplace<32>(x, t);
_Pragma("unroll") for (int i = 0; i < 32; ++i) p[i] = x[i];
    float* km = KM + ((size_t)m * 4 + h) * 96; const float* kn = kv32 + (size_t)m * 512 + h * 128; for (int i = 0; i < 64; ++i) km[i] = kn[i]; for (int i = 0; i < 32; ++i) km[64 + i] = KPE[(size_t)m * 32 + i]; }
}

template <int DK>
__global__ __launch_bounds__(128) void k_attn(const float* __restrict__ Q, int ldq, const float* __restrict__ K, int ldk, const float* __restrict__ V, int ldv, float* __restrict__ O, int ldo,
                                              int qh_stride, int kh_stride, int vh_stride, int oh_stride, int rep, float scale) {
  __shared__ float Ks[32][DK];
  __shared__ float Vs[32][64];
  const int m0 = blockIdx.x * 128, h = blockIdx.y, kvh = h / rep; const int b = m0 / NTOK, t0 = m0 % NTOK; const int kvn = t0 < NCTX ? NCTX : NTOK;
  const int m = m0 + threadIdx.x;
  float q[DK]; { const float* qp = Q + (size_t)m * ldq + h * qh_stride;
#pragma unroll
    for (int i = 0; i < DK; ++i) q[i] = qp[i] * scale; }
  float o[64];
#pragma unroll
  for (int i = 0; i < 64; ++i) o[i] = 0.f;
  float mx = -1e30f, l = 0.f;
  for (int k0 = 0; k0 < kvn; k0 += 32) {
    __syncthreads();
    for (int i = threadIdx.x; i < 32 * DK; i += 128) { const int r = i / DK, cc = i % DK; Ks[r][cc] = K[(size_t)(b * NTOK + k0 + r) * ldk + kvh * kh_stride + cc]; }
    for (int i = threadIdx.x; i < 32 * 64; i += 128) { const int r = i / 64, cc = i % 64; Vs[r][cc] = V[(size_t)(b * NTOK + k0 + r) * ldv + kvh * vh_stride + cc]; }
    __syncthreads();
    float s[32]; float tm = -1e30f;
#pragma unroll
    for (int j = 0; j < 32; ++j) { float a = 0.f;
#pragma unroll
      for (int i = 0; i < DK; ++i) a += q[i] * Ks[j][i];
      s[j] = a; tm = fmaxf(tm, a); }
    const float mn = fmaxf(mx, tm), alpha = __expf(mx - mn); mx = mn; l *= alpha;
#pragma unroll
    for (int i = 0; i < 64; ++i) o[i] *= alpha;
#pragma unroll
    for (int j = 0; j < 32; ++j) { const float p = __expf(s[j] - mn); l += p;
#pragma unroll
      for (int i = 0; i < 64; ++i) o[i] += p * Vs[j][i]; }
  }
  const float rl = 1.f / l; float* op = O + (size_t)m * ldo + h * oh_stride;
#pragma unroll
  for (int i = 0; i < 64; ++i) op[i] = o[i] * rl;
}

__global__ __launch_bounds__(256) void k_chunkmix(const float* GU, const float* AVN, const float* w_s, const float* b_s, float* Y) {
  const int m = blockIdx.x, c = threadIdx.x; const int g = c >> 6, p = m & 127, base = m - p;
  const float* w = w_s + ((size_t)g * 128 + p) * 128; float a = 0.f;
  for (int q = 0; q < 128; ++q) a += w[q] * AVN[(size_t)(base + q) * 256 + c];
  Y[(size_t)m * D + c] = GU[(size_t)m * 256 + c] * (a + b_s[g * 128 + p]);
}
__global__ __launch_bounds__(256) void k_conv(const float* z, const float* w_conv, float* Y) {
  const int m = blockIdx.x, c = threadIdx.x; const int t = m % NTOK; const int lo = t < NCTX ? 0 : NCTX, hi = t < NCTX ? NCTX : NTOK;
  float a = 0.f;
  for (int j = 0; j < 3; ++j) { const int tt = t + j - 1; if (tt < lo || tt >= hi) continue; const float* zr = z + (size_t)(m + j - 1) * DIN; a += w_conv[j * 256 + c] * zr[ZO_CC + c] * zr[ZO_CX + c]; }
  Y[(size_t)m * D + 512 + c] = z[(size_t)m * DIN + ZO_CB + c] * a;
}
__global__ __launch_bounds__(256) void k_merge(const float* G, const float* bg, const float* Zb, float* merged, int first) {
  const size_t i = (size_t)blockIdx.x * 256 + threadIdx.x; if (i >= (size_t)T * D) return; const int n = i % D;
  const float v = sigmoidf(G[i] + bg[n]) * Zb[i]; merged[i] = first ? v : merged[i] + v;
}
__global__ __launch_bounds__(256) void k_resid(float* hs, const float* y, const float* mod, int gate_idx) {
  const size_t i = (size_t)blockIdx.x * 256 + threadIdx.x; if (i >= (size_t)T * D) return; const int n = i % D; const size_t m = i / D; const int b = m / NTOK, t = m % NTOK, r = t < NCTX ? 8 : b;
  hs[i] += mod[(size_t)r * 6 * D + gate_idx * D + n] * y[i];
}
__global__ __launch_bounds__(256) void k_router(const float* hn, const float* wgr, const float* bgr, const float* wer, const float* ber, int* tok_e, float* tok_w, int* counts, int skip_ctx) {
  const int m = blockIdx.x * 4 + (threadIdx.x >> 6), lane = threadIdx.x & 63; if (m >= T) return;
  if (skip_ctx && (m % NTOK) < NCTX) { if (lane == 0) { tok_e[2 * m] = -1; tok_e[2 * m + 1] = -1; } return; }
  float acc[36];
#pragma unroll
  for (int j = 0; j < 36; ++j) acc[j] = 0.f;
  for (int i = 0; i < 16; ++i) { const int k = lane + 64 * i; const float h = hn[(size_t)m * D + k];
#pragma unroll
    for (int j = 0; j < 4; ++j) acc[j] += h * wgr[k * 4 + j];
#pragma unroll
    for (int j = 0; j < 32; ++j) acc[4 + j] += h * wer[k * 32 + j]; }
#pragma unroll
  for (int j = 0; j < 36; ++j) acc[j] = wave_sum(acc[j]);
  if (lane == 0) {
    float mxg = -1e30f; int g = 0;
#pragma unroll
    for (int j = 0; j < 4; ++j) { const float v = acc[j] + bgr[j]; if (v > mxg) { mxg = v; g = j; } }
    float sg = 0.f;
#pragma unroll
    for (int j = 0; j < 4; ++j) sg += __expf(acc[j] + bgr[j] - mxg);
    const float pg = 1.f / sg;
    float v0 = -1e30f, v1 = -1e30f; int e0 = 0, e1 = 0;
#pragma unroll
    for (int j = 0; j < 8; ++j) { float le = 0.f;
#pragma unroll
      for (int gg = 0; gg < 4; ++gg) if (gg == g) le = acc[4 + gg * 8 + j];
      le += ber[g * 8 + j];
      if (le > v0) { v1 = v0; e1 = e0; v0 = le; e0 = j; } else if (le > v1) { v1 = le; e1 = j; } }
    const float p0 = 1.f, p1 = __expf(v1 - v0); const float inv = pg / (p0 + p1);
    tok_e[2 * m] = g * 8 + e0; tok_e[2 * m + 1] = g * 8 + e1; tok_w[2 * m] = p0 * inv; tok_w[2 * m + 1] = p1 * inv;
    atomicAdd(&counts[g * 8 + e0], 1); atomicAdd(&counts[g * 8 + e1], 1);
  }
}
__global__ __launch_bounds__(256) void k_scan(const int* counts, int* pstart, int* cursor, int* tile_e, int* slot_tok) {
  __shared__ int ps[NE + 1];
  if (threadIdx.x == 0) { int a = 0; for (int e = 0; e < NE; ++e) { ps[e] = a; a += (counts[e] + 127) / 128 * 128; } ps[NE] = a; }
  __syncthreads();
  if (threadIdx.x < NE) { pstart[threadIdx.x] = ps[threadIdx.x]; cursor[threadIdx.x] = 0; }
  for (int i = threadIdx.x; i < NTILE_MOE; i += 256) { int e = -1; for (int j = 0; j < NE; ++j) if (i * 128 >= ps[j] && i * 128 < ps[j + 1]) e = j; tile_e[i] = e; }
  for (int i = threadIdx.x; i < CAP; i += 256) slot_tok[i] = 0;
}
__global__ __launch_bounds__(256) void k_scatter(const int* tok_e, const int* pstart, int* cursor, int* slot_tok, int* tok_slot) {
  const int i = blockIdx.x * 256 + threadIdx.x; if (i >= 2 * T) return; const int e = tok_e[i]; if (e < 0) { tok_slot[i] = -1; return; }
  const int pos = pstart[e] + atomicAdd(&cursor[e], 1); slot_tok[pos] = i >> 1; tok_slot[i] = pos;
}
__global__ __launch_bounds__(256) void k_moe_act(const float* GUs, float* Hs) {
  const size_t i = (size_t)blockIdx.x * 256 + threadIdx.x; if (i >= (size_t)CAP * 256) return; const size_t s = i / 256; const int c = i % 256;
  Hs[i] = siluf(GUs[s * 512 + c]) * GUs[s * 512 + 256 + c];
}
__global__ __launch_bounds__(256) void k_moe_combine(float* hs, const float* Fs, const int* tok_slot, const float* tok_w, const float* mod) {
  const size_t i = (size_t)blockIdx.x * 256 + threadIdx.x; if (i >= (size_t)T * D) return; const int n = i % D; const size_t m = i / D; const int s0 = tok_slot[2 * m], s1 = tok_slot[2 * m + 1]; if (s0 < 0) return;
  const int b = m / NTOK, t = m % NTOK, r = t < NCTX ? 8 : b;
  hs[i] += mod[(size_t)r * 6 * D + 5 * D + n] * (tok_w[2 * m] * Fs[(size_t)s0 * D + n] + tok_w[2 * m + 1] * Fs[(size_t)s1 * D + n]);
}
__global__ __launch_bounds__(256) void k_final(const float* hs, const float* fg, float* out) {
  const int r = blockIdx.x * 4 + (threadIdx.x >> 6), lane = threadIdx.x & 63; if (r >= NB * NLAT) return; const int b = r / NLAT, tl = r % NLAT; const size_t m = (size_t)b * NTOK + NCTX + tl;
  const float4* xr = (const float4*)(hs + m * D); float4 v[4]; float ss = 0.f;
#pragma unroll
  for (int j = 0; j < 4; ++j) { v[j] = xr[lane + 64 * j]; ss += v[j].x * v[j].x + v[j].y * v[j].y + v[j].z * v[j].z + v[j].w * v[j].w; }
  const float rinv = rsqrtf(wave_sum(ss) * (1.f / D) + EPS);
#pragma unroll
  for (int j = 0; j < 4; ++j) { const float4 g = ((const float4*)fg)[lane + 64 * j]; float4 o; o.x = v[j].x * rinv * g.x; o.y = v[j].y * rinv * g.y; o.z = v[j].z * rinv * g.z; o.w = v[j].w * rinv * g.w; ((float4*)(out + (size_t)r * D))[lane + 64 * j] = o; }
}

inline void sgemm(hipStream_t st, const float* A, int lda, const float* B, int ldb, float* C, int ldc, int M, int N, int K) {
  dim3 grid((N + 127) / 128, M / 128);
  hipLaunchKernelGGL(k_sgemm<false>, grid, dim3(256), 0, st, A, lda, (const int*)nullptr, B, ldb, 0L, (const int*)nullptr, C, ldc, M, N, K);
}
}
namespace g8 {
#define G8_LAS __attribute__((address_space(3)))
typedef unsigned short bf16_t;
typedef short bf16x8 __attribute__((ext_vector_type(8)));
typedef float f32x4 __attribute__((ext_vector_type(4)));
typedef float f32x2 __attribute__((ext_vector_type(2)));
typedef unsigned u32x4 __attribute__((ext_vector_type(4)));
typedef unsigned u32x2 __attribute__((ext_vector_type(2)));
constexpr int BM = 256, BK = 64, HALF = 128, HTB = HALF * BK * 2, STAGE_BYTES = 8 * HTB;

__host__ __device__ __forceinline__ int lds_byte(int r, int c) { const int st = (r >> 4) * 2 + (c >> 5), rr = r & 15, cc = c & 31, ob = rr * 64 + cc * 2; return st * 1024 + (ob ^ (((ob >> 9) & 1) << 5)); }
__host__ __device__ __forceinline__ void stage_rc(int b, int& R, int& C) { const int st = b / 1024, sb = b % 1024, swz = sb ^ (((sb >> 9) & 1) << 5); R = (st >> 1) * 16 + swz / 64; C = (st & 1) * 32 + (swz % 64) / 2; }
__host__ __device__ __forceinline__ int perm32(int rho) { const int n = rho >> 4, i = rho & 15; return 8 * (i >> 2) + 4 * n + (i & 3); }

struct Unit { const char* a; const char* b; int pm, pn, aux; };

__device__ __forceinline__ unsigned cvt_pk_bf16(float lo, float hi) { unsigned r; asm volatile("v_cvt_pk_bf16_f32 %0, %1, %2" : "=v"(r) : "v"(lo), "v"(hi)); return r; }

template <class Epi, class Sched, bool ALIGN_EPI>
__device__ __forceinline__ void gemm_phase(G8_LAS unsigned char* lds, const int ldaB, const int ldbB, const int K, const Sched& S, const Epi& E) {
    const int tid = threadIdx.x, wid = __builtin_amdgcn_readfirstlane(tid >> 6), lane = tid & 63, wr = wid >> 2, wc = wid & 3, fr = lane & 15, fq = lane >> 4;
    const int nt = K / BK;
    unsigned voffA[2], voffB[2];
#pragma unroll
    for (int i = 0; i < 2; ++i) { int R, C; stage_rc(tid * 16 + i * 8192, R, C); const int Rb = Epi::PERM ? ((R & ~31) + perm32(R & 31)) : R;
        voffA[i] = (unsigned)(R * ldaB + C * 2); voffB[i] = (unsigned)(Rb * ldbB + C * 2); }
    const size_t kstep = (size_t)(BK * 2);
    const size_t hstepA = (size_t)HALF * ldaB, hstepB = (size_t)HALF * ldbB;
    const unsigned ldsw = (unsigned)wid * 1024u;
    const int aoff = lds_byte(wr * 64 + fr, fq * 8), boff = lds_byte(wc * 32 + fr, fq * 8);
#define G8_SA(b, h) (((b) * 2 + (h)) * HTB)
#define G8_SB(b, h) ((4 + (b) * 2 + (h)) * HTB)
#define G8_STAGE(bufoff, gbase, voff) do { _Pragma("unroll") for (int _i = 0; _i < 2; ++_i) \
        __builtin_amdgcn_global_load_lds((const unsigned*)((const char*)(gbase) + (voff)[_i]), (G8_LAS unsigned*)(lds + (bufoff) + ldsw + _i * 8192), 16, 0, 0); } while (0)
#define G8_LDA(dst, b, h) do { _Pragma("unroll") for (int m = 0; m < 4; ++m) _Pragma("unroll") for (int k = 0; k < 2; ++k) dst[m][k] = *(const G8_LAS bf16x8*)(lds + G8_SA(b, h) + aoff + m * 2048 + k * 1024); } while (0)
#define G8_LDB(dst, b, h) do { _Pragma("unroll") for (int n = 0; n < 2; ++n) _Pragma("unroll") for (int k = 0; k < 2; ++k) dst[n][k] = *(const G8_LAS bf16x8*)(lds + G8_SB(b, h) + boff + n * 2048 + k * 1024); } while (0)
#define G8_MMA(ai, bj, At, Bt) do { __builtin_amdgcn_s_setprio(1); _Pragma("unroll") for (int m = 0; m < 4; ++m) _Pragma("unroll") for (int n = 0; n < 2; ++n) _Pragma("unroll") for (int k = 0; k < 2; ++k) \
        acc[ai][bj][m][n] = __builtin_amdgcn_mfma_f32_16x16x32_bf16(Bt[n][k], At[m][k], acc[ai][bj][m][n], 0, 0, 0); __builtin_amdgcn_s_setprio(0); } while (0)
#define G8_WAIT_V(n) asm volatile("s_waitcnt vmcnt(" #n ")" ::: "memory")
#define G8_WAIT_L(n) asm volatile("s_waitcnt lgkmcnt(" #n ")" ::: "memory")
#define G8_BAR __builtin_amdgcn_s_barrier()
#define G8_SCHED __builtin_amdgcn_sched_barrier(0)
    Unit cur, nxt; int ui = 0;
    if (!S.next(0, cur)) return;
    f32x4 acc[2][2][4][2];
#pragma unroll
    for (int a = 0; a < 2; ++a)
#pragma unroll
        for (int b = 0; b < 2; ++b)
#pragma unroll
            for (int m = 0; m < 4; ++m)
#pragma unroll
                for (int n = 0; n < 2; ++n) acc[a][b][m][n] = (f32x4){0.f, 0.f, 0.f, 0.f};
    bf16x8 At[4][2], B0[2][2], B1[2][2];
    const char* cA = cur.a; const char* cB = cur.b;
    G8_STAGE(G8_SB(0, 0), cB, voffB); G8_STAGE(G8_SB(0, 1), cB + hstepB, voffB); G8_STAGE(G8_SA(0, 0), cA, voffA); G8_STAGE(G8_SA(0, 1), cA + hstepA, voffA);
    if (wr == 1) G8_BAR;
    G8_WAIT_V(2); G8_BAR;
    G8_STAGE(G8_SB(1, 0), cB + kstep, voffB); G8_STAGE(G8_SA(1, 0), cA + kstep, voffA); G8_STAGE(G8_SB(1, 1), cB + hstepB + kstep, voffB);
    G8_WAIT_V(6); G8_BAR;
#pragma unroll 1
    for (;;) {
        const bool has_next = S.next(ui + 1, nxt);
        const char* nA = has_next ? nxt.a : cA; const char* nB = has_next ? nxt.b : cB;
#pragma unroll 1
        for (int t = 0; t < nt; t += 2) {
            const bool last = (t == nt - 2);
            const char* a1 = cA + (size_t)(t + 1) * kstep;
            const char* a2 = last ? nA : cA + (size_t)(t + 2) * kstep; const char* b2 = last ? nB : cB + (size_t)(t + 2) * kstep;
            const char* a3 = a2 + kstep; const char* b3 = b2 + kstep;
            G8_LDB(B0, 0, 0); G8_LDB(B1, 0, 1); G8_SCHED; G8_LDA(At, 0, 0); G8_STAGE(G8_SA(1, 1), a1 + hstepA, voffA);
            G8_WAIT_V(8); G8_WAIT_L(0); G8_BAR; G8_MMA(0, 0, At, B0); G8_MMA(0, 1, At, B1); G8_BAR; G8_SCHED;
            G8_LDA(At, 0, 1); G8_STAGE(G8_SB(0, 0), b2, voffB); G8_STAGE(G8_SB(0, 1), b2 + hstepB, voffB); G8_STAGE(G8_SA(0, 0), a2, voffA);
            G8_WAIT_V(8); G8_WAIT_L(0); G8_BAR; G8_MMA(1, 0, At, B0); G8_MMA(1, 1, At, B1); G8_BAR; G8_SCHED;
            G8_LDB(B0, 1, 0); G8_LDB(B1, 1, 1); G8_SCHED; G8_LDA(At, 1, 0); G8_STAGE(G8_SA(0, 1), a2 + hstepA, voffA);
            G8_WAIT_V(8); G8_WAIT_L(0); G8_BAR; G8_MMA(0, 0, At, B0); G8_MMA(0, 1, At, B1); G8_BAR; G8_SCHED;
            G8_LDA(At, 1, 1); G8_STAGE(G8_SB(1, 0), b3, voffB); G8_STAGE(G8_SB(1, 1), b3 + hstepB, voffB); G8_STAGE(G8_SA(1, 0), a3, voffA);
            G8_WAIT_V(8); G8_WAIT_L(0); G8_BAR; G8_MMA(1, 0, At, B0); G8_MMA(1, 1, At, B1); G8_BAR; G8_SCHED;
        }
        if constexpr (ALIGN_EPI) { if (wr == 0) G8_BAR; }
        E(acc, cur, wr, wc, fr, fq);
        if (!has_next) break;
#pragma unroll
        for (int a = 0; a < 2; ++a)
#pragma unroll
            for (int b = 0; b < 2; ++b)
#pragma unroll
                for (int m = 0; m < 4; ++m)
#pragma unroll
                    for (int n = 0; n < 2; ++n) acc[a][b][m][n] = (f32x4){0.f, 0.f, 0.f, 0.f};
        cur = nxt; cA = nA; cB = nB; ++ui;
        if constexpr (ALIGN_EPI) { if (wr == 1) G8_BAR; }
    }
    G8_WAIT_V(0);
    if constexpr (!ALIGN_EPI) { if (wr == 0) G8_BAR; }
    G8_BAR;
#undef G8_SA
#undef G8_SB
#undef G8_STAGE
#undef G8_LDA
#undef G8_LDB
#undef G8_MMA
#undef G8_WAIT_V
#undef G8_WAIT_L
#undef G8_BAR
#undef G8_SCHED
}
}
namespace mk {
using namespace g8;
constexpr int NB = 8, NCTX = 256, NLAT = 2048, NTOK = NCTX + NLAT, T = NB * NTOK, D = 1024, L = 4, NE = 32;
constexpr int NWAVES = 8, NTHR = 512;
constexpr float EPS = 1e-6f;
constexpr int NROWT = T / 256;
constexpr int ZBW = 2304, ZB_AU = 0, ZB_AV = 256, ZB_MQ = 512, ZB_CB = 768, ZB_CC = 1024, ZB_CX = 1280, ZB_GQ = 1536, ZB_GK = 1792, ZB_GV = 1920, ZB_MKV = 2048, ZB_KPE = 2176;
constexpr int DIN = 2208;
constexpr int RING_BYTES = 131072, MISC_OFF = RING_BYTES, XSCR_OFF = RING_BYTES + 1024, LDS_BYTES = 163840 - 4096;
constexpr size_t MiB = 1u << 20;
constexpr size_t al(size_t x) { return (x + 255) / 256 * 256; }
constexpr size_t WS_CTL = 0, CTL_BYTES = 1 * MiB;
constexpr size_t WS_MOD = WS_CTL + CTL_BYTES, SZ_MOD = al((size_t)L * 9 * 6 * D * 4);
constexpr size_t WS_WIN = WS_MOD + SZ_MOD, SZ_WIN1 = (size_t)ZBW * D * 2;
constexpr size_t WS_WG = WS_WIN + L * SZ_WIN1, SZ_WG1 = (size_t)4096 * D * 2;
constexpr size_t WS_WB = WS_WG + L * SZ_WG1, SZ_WB1 = (size_t)4 * 1024 * 256 * 2;
constexpr size_t WS_WOUT = WS_WB + L * SZ_WB1, SZ_WOUT1 = (size_t)D * D * 2;
constexpr size_t WS_WUQ = WS_WOUT + L * SZ_WOUT1, SZ_WUQ1 = (size_t)512 * 256 * 2;
constexpr size_t WS_WUKV = WS_WUQ + L * SZ_WUQ1, SZ_WUKV1 = (size_t)512 * 256 * 2;
constexpr size_t WS_WSGU = WS_WUKV + L * SZ_WUKV1, SZ_WSGU1 = (size_t)4 * 128 * 128 * 2;
constexpr size_t WS_WGU = WS_WSGU + L * SZ_WSGU1, SZ_WGU1 = (size_t)NE * 512 * D * 2;
constexpr size_t WS_WDN = WS_WGU + L * SZ_WGU1, SZ_WDN1 = (size_t)NE * D * 256 * 2;
constexpr size_t WS_HS = WS_WDN + L * SZ_WDN1, SZ_HS = (size_t)T * D * 4;
constexpr size_t WS_HN = WS_HS + SZ_HS, SZ_HN = (size_t)T * D * 2;
constexpr size_t WS_ARENA = WS_HN + SZ_HN;

#define GAS __attribute__((address_space(1)))
#define LAS __attribute__((address_space(3)))
typedef unsigned short bf16;
typedef unsigned v4u __attribute__((ext_vector_type(4)));
typedef unsigned v2u __attribute__((ext_vector_type(2)));
#define LDS_WAIT() asm volatile("s_waitcnt lgkmcnt(0)" ::: "memory")
#define VM_WAIT() asm volatile("s_waitcnt vmcnt(0)" ::: "memory")
__device__ __forceinline__ unsigned f2bf(float f) { unsigned u = __builtin_bit_cast(unsigned, f); return (u + 0x7fffu + ((u >> 16) & 1u)) >> 16; }
__device__ __forceinline__ unsigned pk2(float lo, float hi) { return f2bf(lo) | (f2bf(hi) << 16); }
__device__ __forceinline__ float bf2f(unsigned short h) { return __builtin_bit_cast(float, (unsigned)h << 16); }
__device__ __forceinline__ float bflo(unsigned w) { return __builtin_bit_cast(float, w << 16); }
__device__ __forceinline__ float bfhi(unsigned w) { return __builtin_bit_cast(float, w & 0xffff0000u); }
__device__ __forceinline__ float wave_sum(float v) {
#pragma unroll
  for (int o = 1; o < 64; o <<= 1) v += __shfl_xor(v, o);
  return v;
}
__device__ __forceinline__ float siluf(float x) { return x / (1.f + __expf(-x)); }
__device__ __forceinline__ float sigmoidf(float x) { return 1.f / (1.f + __expf(-x)); }
__device__ __forceinline__ float gelu_tanh(float x) { const float u = 0.7978845608028654f * (x + 0.044715f * x * x * x); const float e = __expf(2.f * u); return x - x / (e + 1.f); }

#define XB_TMO      128
#define XB_XCNT(j)  (256  + 64 * (j))
#define XB_XSUB(j)  (1280 + 64 * (j))
#define XB_XGEN(j)  (2304 + 64 * (j))
#define XB_TOP      3328
#define XB_TOPGEN   3392
#define XCD_BAR_WORDS 3456
#define XB_SPIN_CAP (1u << 18)
__device__ __forceinline__ unsigned xb_ld(unsigned* p)              { return __hip_atomic_load(p, __ATOMIC_RELAXED, __HIP_MEMORY_SCOPE_AGENT); }
__device__ __forceinline__ unsigned xb_add(unsigned* p, unsigned v) { return __hip_atomic_fetch_add(p, v, __ATOMIC_RELAXED, __HIP_MEMORY_SCOPE_AGENT); }
__device__ __forceinline__ unsigned xb_xcc_id() { return (unsigned)__builtin_amdgcn_s_getreg((3 << 11) | 20) & 0xFu; }
#define XB_SPIN(cond, bar) do { unsigned _sp = 0; while (cond) { __builtin_amdgcn_s_sleep(1); \
    if ((++_sp & 255u) == 0u) { if (xb_ld(&(bar)[XB_TMO])) break; if (_sp > XB_SPIN_CAP) { atomicAdd(&(bar)[XB_TMO], 1u); break; } } } } while (0)
struct XcdBarrier { unsigned* bar; unsigned x; volatile LAS unsigned* st; };
__device__ __forceinline__ XcdBarrier xcd_barrier_post(unsigned* bar, volatile LAS unsigned* st) {
    XcdBarrier b; b.bar = bar; b.x = xb_xcc_id(); b.st = st;
    if (threadIdx.x == 0) (void)xb_add(&bar[XB_XCNT(b.x)], 1u);
    return b;
}
__device__ __forceinline__ void xcd_barrier_complete(unsigned* bar, unsigned x, unsigned& nloc, unsigned& nx) {
    const unsigned G = gridDim.x * gridDim.y * gridDim.z;
    unsigned sum, cnt, mine, sp = 0u;
    for (;;) {
        sum = 0u; cnt = 0u; mine = 0u;
#pragma unroll
        for (unsigned j = 0; j < 16; ++j) { const unsigned c = xb_ld(&bar[XB_XCNT(j)]); sum += c; cnt += (c > 0u) ? 1u : 0u; mine = (j == x) ? c : mine; }
        if (sum == G) break;
        __builtin_amdgcn_s_sleep(1);
        if ((++sp & 255u) == 0u) { if (xb_ld(&bar[XB_TMO])) break; if (sp > XB_SPIN_CAP) { atomicAdd(&bar[XB_TMO], 1u); break; } }
    }
    nloc = mine > 0u ? mine : 1u; nx = cnt > 0u ? cnt : 1u;
}
__device__ __forceinline__ void xcd_barrier(const XcdBarrier& b) {
    asm volatile("s_waitcnt vmcnt(0)" ::: "memory");
    __syncthreads();
    if (threadIdx.x == 0) {
        unsigned* bar = b.bar;
        __builtin_amdgcn_s_waitcnt(0);
        unsigned nloc = b.st[0], nx = b.st[1];
        if (nloc == 0u) { xcd_barrier_complete(bar, b.x, nloc, nx); b.st[0] = nloc; b.st[1] = nx; }
        const unsigned old = xb_add(&bar[XB_XSUB(b.x)], 1u);
        const unsigned gen = old / nloc;
        if (old + 1u == (gen + 1u) * nloc) {
            __builtin_amdgcn_fence(__ATOMIC_RELEASE, "agent");
            asm volatile("s_waitcnt vmcnt(0)" ::: "memory");
            const unsigned og = xb_add(&bar[XB_TOP], 1u);
            const unsigned tg = og / nx;
            if (og + 1u == (tg + 1u) * nx) xb_add(&bar[XB_TOPGEN], 1u);
            else XB_SPIN(xb_ld(&bar[XB_TOPGEN]) == tg, bar);
            __builtin_amdgcn_fence(__ATOMIC_ACQUIRE, "agent");
            xb_add(&bar[XB_XGEN(b.x)], 1u);
            asm volatile("s_waitcnt vmcnt(0)" ::: "memory");
        } else {
            XB_SPIN(xb_ld(&bar[XB_XGEN(b.x)]) == gen, bar);
            __builtin_amdgcn_fence(__ATOMIC_ACQUIRE, "agent");
            asm volatile("s_waitcnt vmcnt(0)" ::: "memory");
        }
    }
    __syncthreads();
}

struct Args { const float* in[28]; float* out; unsigned char* ws; int phase, layer, flag, pad; };
struct Ctx {
  LAS unsigned char* lds; unsigned char* ws; int tid, lane, wave, vcu, G;
};

struct TileOrder {
  int nM, nN, nwg, G, c;
  __device__ void init(int nM_, int nN_, int G_, int c_) { nM = nM_; nN = nN_; nwg = nM * nN; G = G_; c = c_; }
  __device__ __forceinline__ bool tile(int i, int& pm, int& pn) const {
    const long Lx = (long)i * G + c; if (Lx >= nwg) return false;
    int wgid = (int)Lx; { const int q = nwg / 8, r = nwg % 8, xcd = wgid % 8, off = wgid / 8; wgid = (xcd < r ? xcd * (q + 1) : r * (q + 1) + (xcd - r) * q) + off; }
    constexpr int WGM = 8; const int nig = WGM * nN, gid = wgid / nig, fm = gid * WGM, gsz = (nM - fm) < WGM ? (nM - fm) : WGM;
    pm = fm + ((wgid % nig) % gsz); pn = (wgid % nig) / gsz; return true;
  }
};
struct PlainSched {
  TileOrder o; const char* A; const char* B; size_t aTile, bTile;
  __device__ __forceinline__ bool next(int i, Unit& u) const { int pm, pn; if (!o.tile(i, pm, pn)) return false; u.pm = pm; u.pn = pn; u.aux = 0; u.a = A + (size_t)pm * aTile; u.b = B + (size_t)pn * bTile; return true; }
};
struct EpiStoreBf16 {
  static constexpr bool PERM = true;
  bf16* O; int ldc;
  __device__ __forceinline__ void operator()(const f32x4 (&acc)[2][2][4][2], const Unit& u, int wr, int wc, int fr, int fq) const {
    const int row0 = u.pm * 256 + wr * 64 + fr, col0 = u.pn * 256 + wc * 32 + 8 * fq;
#pragma unroll
    for (int ai = 0; ai < 2; ++ai)
#pragma unroll
      for (int m = 0; m < 4; ++m) { bf16* rowp = O + (size_t)(row0 + ai * 128 + m * 16) * ldc + col0;
#pragma unroll
        for (int bj = 0; bj < 2; ++bj) { const f32x4 v0 = acc[ai][bj][m][0], v1 = acc[ai][bj][m][1];
          v4u w; w.x = cvt_pk_bf16(v0[0], v0[1]); w.y = cvt_pk_bf16(v0[2], v0[3]); w.z = cvt_pk_bf16(v1[0], v1[1]); w.w = cvt_pk_bf16(v1[2], v1[3]);
          *(v4u*)(rowp + bj * 128) = w; } }
  }
};

template <class Map>
__device__ __forceinline__ void transpose_item(const float* W, int ldw, bf16* dst, int ldd, const float* kscale, LAS float* scr, int k0, int n0, int lane, Map map) {
#pragma unroll 8
  for (int i = 0; i < 32; ++i) { const int kk = 2 * i + (lane >> 5); float v = W[(size_t)(k0 + kk) * ldw + n0 + (lane & 31)]; if (kscale) v *= kscale[k0 + kk]; scr[kk * 33 + (lane & 31)] = v; }
  LDS_WAIT(); asm volatile("" ::: "memory");
  const int c = lane & 7;
#pragma unroll
  for (int j = 0; j < 4; ++j) { const int n = (lane >> 3) + 8 * j; const LAS float* s = scr + (8 * c) * 33 + n;
    v4u o; o.x = pk2(s[0 * 33], s[1 * 33]); o.y = pk2(s[2 * 33], s[3 * 33]); o.z = pk2(s[4 * 33], s[5 * 33]); o.w = pk2(s[6 * 33], s[7 * 33]);
    *(v4u*)(dst + (size_t)map(n0 + n) * ldd + k0 + 8 * c) = o; }
  LDS_WAIT(); asm volatile("" ::: "memory");
}
__device__ __forceinline__ int zmap(int n) {
  if (n < 768) return n;
  if (n < 896) return ZB_MKV + (n - 768);
  if (n < 928) return ZB_KPE + (n - 896);
  if (n < 1184) return ZB_CB + (n - 928);
  if (n < 1440) return ZB_CC + (n - 1184);
  if (n < 1696) return ZB_CX + (n - 1440);
  if (n < 1952) return ZB_GQ + (n - 1696);
  if (n < 2080) return ZB_GK + (n - 1952);
  return ZB_GV + (n - 2080);
}
__device__ __forceinline__ int gmap(int i, int c) { const int jp = c >> 6, cl = c & 63, wc = cl >> 4, fq = (cl >> 2) & 3, e = cl & 3, bj = i >> 1, n = i & 1; return 256 * jp + 128 * bj + 32 * wc + 16 * n + 4 * fq + e; }
__device__ __forceinline__ int uqmap(int n) { const int h = n / 96, dd = n % 96; if (dd < 64) return 64 * h + dd; const int d = dd - 64; return 256 + 32 * h + 8 * ((d >> 2) & 3) + 4 * (d >> 4) + (d & 3); }
__device__ __forceinline__ int gumap(int n) { const int up = n >> 8, j = n & 255; return 256 * (j >> 7) + 128 * up + (j & 127); }

__device__ __forceinline__ void phase_prep(Ctx& F, const Args& A) {
  LAS float* scr = (LAS float*)(F.lds + F.wave * 8448);
  const int gw = F.vcu * NWAVES + F.wave, NGW = F.G * NWAVES, lane = F.lane;
  const float* w_in = A.in[6]; const float* w_gate = A.in[17]; const float* w_branch = A.in[19]; const float* w_out = A.in[20];
  const float* w_uq = A.in[11]; const float* w_ukv = A.in[13]; const float* w_gu = A.in[25]; const float* w_dn = A.in[26]; const float* w_sgu = A.in[8];
  const float* mq_gain = A.in[10]; const float* mkv_gain = A.in[12];
  constexpr int I_IN = 16 * 69, I_G = 4 * 16 * 32, I_B = 4 * 4 * 32, I_O = 16 * 32, I_UQ = 4 * 12, I_UKV = 2 * 16, I_GU = NE * 16 * 16, I_DN = NE * 4 * 32;
  constexpr int I_L = I_IN + I_G + I_B + I_O + I_UQ + I_UKV + I_GU + I_DN;
  for (int it = gw; it < L * I_L; it += NGW) {
    const int l = it / I_L; int r = it % I_L;
    if (r < I_IN) { const int kb = r / 69, nb = r % 69; transpose_item(w_in + (size_t)l * D * DIN, DIN, (bf16*)(F.ws + WS_WIN + l * SZ_WIN1), D, nullptr, scr, kb * 64, nb * 32, lane, [](int n) { return zmap(n); }); continue; } r -= I_IN;
    if (r < I_G) { const int i = r / 512, rr = r % 512, kb = rr / 32, nb = rr % 32; transpose_item(w_gate + ((size_t)l * 4 + i) * D * D, D, (bf16*)(F.ws + WS_WG + l * SZ_WG1), D, nullptr, scr, kb * 64, nb * 32, lane, [i](int n) { return gmap(i, n); }); continue; } r -= I_G;
    if (r < I_B) { const int i = r / 128, rr = r % 128, kb = rr / 32, nb = rr % 32; transpose_item(w_branch + ((size_t)l * 4 + i) * 256 * D, D, (bf16*)(F.ws + WS_WB + l * SZ_WB1) + (size_t)i * 1024 * 256, 256, nullptr, scr, kb * 64, nb * 32, lane, [](int n) { return n; }); continue; } r -= I_B;
    if (r < I_O) { const int kb = r / 32, nb = r % 32; transpose_item(w_out + (size_t)l * D * D, D, (bf16*)(F.ws + WS_WOUT + l * SZ_WOUT1), D, nullptr, scr, kb * 64, nb * 32, lane, [](int n) { return n; }); continue; } r -= I_O;
    if (r < I_UQ) { const int kb = r / 12, nb = r % 12; transpose_item(w_uq + (size_t)l * 256 * 384, 384, (bf16*)(F.ws + WS_WUQ + l * SZ_WUQ1), 256, mq_gain + l * 256, scr, kb * 64, nb * 32, lane, [](int n) { return uqmap(n); }); continue; } r -= I_UQ;
    if (r < I_UKV) { const int kb = r / 16, nb = r % 16; transpose_item(w_ukv + (size_t)l * 128 * 512, 512, (bf16*)(F.ws + WS_WUKV + l * SZ_WUKV1), 256, mkv_gain + l * 128, scr, kb * 64, nb * 32, lane, [](int n) { return n; }); continue; } r -= I_UKV;
    if (r < I_GU) { const int e = r / 256, rr = r % 256, kb = rr / 16, nb = rr % 16; transpose_item(w_gu + ((size_t)l * NE + e) * D * 512, 512, (bf16*)(F.ws + WS_WGU + l * SZ_WGU1) + (size_t)e * 512 * D, D, nullptr, scr, kb * 64, nb * 32, lane, [](int n) { return gumap(n); }); continue; } r -= I_GU;
    { const int e = r / 128, rr = r % 128, kb = rr / 32, nb = rr % 32; transpose_item(w_dn + ((size_t)l * NE + e) * 256 * D, D, (bf16*)(F.ws + WS_WDN + l * SZ_WDN1) + (size_t)e * D * 256, 256, nullptr, scr, kb * 64, nb * 32, lane, [](int n) { return n; }); }
  }
  const size_t gt = (size_t)F.vcu * NTHR + F.tid, NGT = (size_t)F.G * NTHR;
  for (int l = 0; l < L; ++l) {
    v4u z4 = {0u, 0u, 0u, 0u};
    { v4u* p = (v4u*)(F.ws + WS_WIN + l * SZ_WIN1 + (size_t)DIN * D * 2); for (size_t i = gt; i < (size_t)(ZBW - DIN) * D * 2 / 16; i += NGT) p[i] = z4; }
    { v4u* p = (v4u*)(F.ws + WS_WUQ + l * SZ_WUQ1 + (size_t)384 * 256 * 2); for (size_t i = gt; i < (size_t)128 * 256 * 2 / 16; i += NGT) p[i] = z4; }
    { for (size_t i = gt; i < (size_t)512 * 16; i += NGT) { const size_t row = i / 16, c = i % 16; *(v4u*)(F.ws + WS_WUKV + l * SZ_WUKV1 + row * 512 + 256 + c * 16) = z4; } }
    { const float* s = w_sgu + (size_t)l * 4 * 128 * 128; bf16* d = (bf16*)(F.ws + WS_WSGU + l * SZ_WSGU1); for (size_t i = gt; i < (size_t)4 * 128 * 128 / 2; i += NGT) ((unsigned*)d)[i] = pk2(s[2 * i], s[2 * i + 1]); }
  }
  { const float* c = A.in[1]; const float* c_ctx = A.in[3]; const float* w_ada = A.in[4]; const float* b_ada = A.in[5]; float* mod = (float*)(F.ws + WS_MOD);
    for (int it = gw; it < L * 96; it += NGW) { const int l = it / 96, n = (it % 96) * 64 + lane; float acc[9];
#pragma unroll
      for (int r = 0; r < 9; ++r) acc[r] = 0.f;
      const float* w = w_ada + (size_t)l * D * 6 * D + n;
      for (int k = 0; k < D; ++k) { const float wv = w[(size_t)k * 6 * D];
#pragma unroll
        for (int r = 0; r < 9; ++r) { const float cv = r < 8 ? c[r * D + k] : c_ctx[k]; acc[r] += siluf(cv) * wv; } }
      const float bv = b_ada[l * 6 * D + n];
#pragma unroll
      for (int r = 0; r < 9; ++r) mod[((size_t)l * 9 + r) * 6 * D + n] = acc[r] + bv; } }
}

__device__ __forceinline__ void phase_norm_mod(Ctx& F, const Args& A, int l, int shift_idx, bool from_inputs) {
  const int gw = F.vcu * NWAVES + F.wave, NGW = F.G * NWAVES, lane = F.lane;
  float* hs = (float*)(F.ws + WS_HS); bf16* hn = (bf16*)(F.ws + WS_HN); const float* mod = (const float*)(F.ws + WS_MOD) + (size_t)l * 9 * 6 * D;
  for (int m = gw; m < T; m += NGW) {
    const int b = m / NTOK, t = m % NTOK, r = t < NCTX ? 8 : b;
    const float4* xr = from_inputs ? (t < NCTX ? (const float4*)(A.in[2] + ((size_t)b * NCTX + t) * D) : (const float4*)(A.in[0] + ((size_t)b * NLAT + (t - NCTX)) * D)) : (const float4*)(hs + (size_t)m * D);
    const float4* sh = (const float4*)(mod + (size_t)r * 6 * D + shift_idx * D); const float4* sc = sh + D / 4;
    float4 v[4]; float ss = 0.f;
#pragma unroll
    for (int j = 0; j < 4; ++j) { v[j] = xr[lane + 64 * j]; ss += v[j].x * v[j].x + v[j].y * v[j].y + v[j].z * v[j].z + v[j].w * v[j].w; }
    const float rinv = rsqrtf(wave_sum(ss) * (1.f / D) + EPS);
#pragma unroll
    for (int j = 0; j < 4; ++j) { const float4 a = sc[lane + 64 * j], s4 = sh[lane + 64 * j];
      if (from_inputs) ((float4*)(hs + (size_t)m * D))[lane + 64 * j] = v[j];
      v2u o; o.x = pk2(v[j].x * rinv * (1.f + a.x) + s4.x, v[j].y * rinv * (1.f + a.y) + s4.y); o.y = pk2(v[j].z * rinv * (1.f + a.z) + s4.z, v[j].w * rinv * (1.f + a.w) + s4.w);
      ((v2u*)(hn + (size_t)m * D))[lane + 64 * j] = o; }
  }
}
}
namespace mk {
__device__ __forceinline__ void phase_zgemm(Ctx& F, const Args& A, int l) {
  PlainSched S; S.o.init(NROWT, ZBW / 256, F.G, (int)blockIdx.x); S.A = (const char*)(F.ws + WS_HN); S.B = (const char*)(F.ws + WS_WIN + l * SZ_WIN1); S.aTile = (size_t)256 * D * 2; S.bTile = (size_t)256 * D * 2;
  EpiStoreBf16 E{(bf16*)(F.ws + WS_ARENA), ZBW};
  gemm_phase<EpiStoreBf16, PlainSched, true>(F.lds, D * 2, D * 2, D, S, E);
}
constexpr size_t WS_ZB = WS_ARENA, SZ_ZB = (size_t)T * ZBW * 2;
constexpr size_t WS_Y = WS_ZB + SZ_ZB, SZ_Y = (size_t)T * D * 2;
constexpr size_t WS_Z4 = WS_Y + SZ_Y, SZ_Z4 = (size_t)T * 4096 * 2;
constexpr size_t WS_MG = WS_Z4 + SZ_Z4, SZ_MG = (size_t)T * D * 2;
constexpr size_t WS_END1 = WS_MG + SZ_MG;
struct BranchSched {
  TileOrder o; const char* Y; const char* WB;
  __device__ __forceinline__ bool next(int i, Unit& u) const { int pm, pn; if (!o.tile(i, pm, pn)) return false; u.pm = pm; u.pn = pn; u.aux = 0; const int br = pn >> 2;
    u.a = Y + (size_t)pm * 256 * D * 2 + br * 512; u.b = WB + (size_t)br * 1024 * 512 + (size_t)(pn & 3) * 256 * 512; return true; }
};
__device__ __forceinline__ void phase_branch(Ctx& F, const Args& A, int l) {
  BranchSched S; S.o.init(NROWT, 16, F.G, (int)blockIdx.x); S.Y = (const char*)(F.ws + WS_Y); S.WB = (const char*)(F.ws + WS_WB + l * SZ_WB1);
  EpiStoreBf16 E{(bf16*)(F.ws + WS_Z4), 4096};
  gemm_phase<EpiStoreBf16, BranchSched, true>(F.lds, D * 2, 512, 256, S, E);
}
struct EpiMerge {
  static constexpr bool PERM = false;
  const bf16* Z4; const float* bg; bf16* M;
  __device__ __forceinline__ void operator()(const f32x4 (&acc)[2][2][4][2], const Unit& u, int wr, int wc, int fr, int fq) const {
    const int c0 = u.pn * 64 + wc * 16 + fq * 4;
    f32x4 bv[2][2];
#pragma unroll
    for (int bj = 0; bj < 2; ++bj)
#pragma unroll
      for (int n = 0; n < 2; ++n) bv[bj][n] = *(const f32x4*)(bg + (2 * bj + n) * D + c0);
#pragma unroll
    for (int ai = 0; ai < 2; ++ai)
#pragma unroll
      for (int m = 0; m < 4; ++m) { const size_t r = (size_t)u.pm * 256 + ai * 128 + wr * 64 + m * 16 + fr; f32x4 s = {0.f, 0.f, 0.f, 0.f};
#pragma unroll
        for (int bj = 0; bj < 2; ++bj)
#pragma unroll
          for (int n = 0; n < 2; ++n) { const v2u zz = *(const v2u*)(Z4 + r * 4096 + (2 * bj + n) * D + c0); const f32x4 g = acc[ai][bj][m][n] + bv[bj][n];
            s[0] += bflo(zz.x) * __builtin_amdgcn_rcpf(1.f + __expf(-g[0])); s[1] += bfhi(zz.x) * __builtin_amdgcn_rcpf(1.f + __expf(-g[1]));
            s[2] += bflo(zz.y) * __builtin_amdgcn_rcpf(1.f + __expf(-g[2])); s[3] += bfhi(zz.y) * __builtin_amdgcn_rcpf(1.f + __expf(-g[3])); }
        v2u o; o.x = cvt_pk_bf16(s[0], s[1]); o.y = cvt_pk_bf16(s[2], s[3]); *(v2u*)(M + r * D + c0) = o; }
  }
};
__device__ __forceinline__ void phase_gate(Ctx& F, const Args& A, int l) {
  PlainSched S; S.o.init(NROWT, 16, F.G, (int)blockIdx.x); S.A = (const char*)(F.ws + WS_HN); S.B = (const char*)(F.ws + WS_WG + l * SZ_WG1); S.aTile = (size_t)256 * D * 2; S.bTile = (size_t)256 * D * 2;
  EpiMerge E{(const bf16*)(F.ws + WS_Z4), A.in[18] + (size_t)l * 4 * D, (bf16*)(F.ws + WS_MG)};
  gemm_phase<EpiMerge, PlainSched, true>(F.lds, D * 2, D * 2, D, S, E);
}
struct EpiResid {
  static constexpr bool PERM = false;
  float* hs; const float* mod;
  __device__ __forceinline__ void operator()(const f32x4 (&acc)[2][2][4][2], const Unit& u, int wr, int wc, int fr, int fq) const {
    const int b = u.pm / 9, rm = (u.pm % 9 == 0) ? 8 : b; const float* gv = mod + (size_t)rm * 6 * D + 2 * D;
    const int col0 = u.pn * 256 + wc * 32 + fq * 4;
#pragma unroll
    for (int bj = 0; bj < 2; ++bj)
#pragma unroll
      for (int n = 0; n < 2; ++n) { const int c = col0 + bj * 128 + n * 16; const f32x4 g = *(const f32x4*)(gv + c);
#pragma unroll
        for (int ai = 0; ai < 2; ++ai)
#pragma unroll
          for (int m = 0; m < 4; ++m) { float* p = hs + ((size_t)u.pm * 256 + ai * 128 + wr * 64 + m * 16 + fr) * D + c; const f32x4 h = *(const f32x4*)p; *(f32x4*)p = h + g * acc[ai][bj][m][n]; } }
  }
};
__device__ __forceinline__ void phase_out(Ctx& F, const Args& A, int l) {
  PlainSched S; S.o.init(NROWT, 4, F.G, (int)blockIdx.x); S.A = (const char*)(F.ws + WS_MG); S.B = (const char*)(F.ws + WS_WOUT + l * SZ_WOUT1); S.aTile = (size_t)256 * D * 2; S.bTile = (size_t)256 * D * 2;
  EpiResid E{(float*)(F.ws + WS_HS), (const float*)(F.ws + WS_MOD) + (size_t)l * 9 * 6 * D};
  gemm_phase<EpiResid, PlainSched, true>(F.lds, D * 2, D * 2, D, S, E);
}
constexpr int CAP2 = 2 * T + NE * 256, NT_MOE = CAP2 / 256;
constexpr size_t WS_XG = WS_ARENA, SZ_XG = (size_t)CAP2 * D * 2;
constexpr size_t WS_HE = WS_XG + SZ_XG, SZ_HE = (size_t)CAP2 * 256 * 2;
constexpr size_t WS_FS = WS_HE + SZ_HE, SZ_FS = (size_t)CAP2 * D * 2;
static_assert(WS_FS + SZ_FS <= WS_END1, "moe arena fits in the mixer arena");
constexpr size_t WS_TOKE = WS_END1, WS_TOKW = WS_TOKE + (size_t)2 * T * 4, WS_TOKR = WS_TOKW + (size_t)2 * T * 4, WS_TOKS = WS_TOKR + (size_t)2 * T * 4, WS_END2 = WS_TOKS + (size_t)2 * T * 4;
constexpr int CW_CNT = 8192;
__device__ __forceinline__ void phase_norm_router(Ctx& F, const Args& A, int l, bool skip_ctx) {
  const int gw = F.vcu * NWAVES + F.wave, NGW = F.G * NWAVES, lane = F.lane;
  const float* hs = (const float*)(F.ws + WS_HS); bf16* hn = (bf16*)(F.ws + WS_HN); const float* mod = (const float*)(F.ws + WS_MOD) + (size_t)l * 9 * 6 * D;
  const float* wgr = A.in[21] + (size_t)l * D * 4; const float* bgr = A.in[22] + l * 4; const float* wer = A.in[23] + (size_t)l * D * 32; const float* ber = A.in[24] + l * 32;
  int* tok_e = (int*)(F.ws + WS_TOKE); float* tok_w = (float*)(F.ws + WS_TOKW); int* tok_r = (int*)(F.ws + WS_TOKR);
  unsigned* counts = (unsigned*)(F.ws + WS_CTL) + CW_CNT + l * 64;
  for (int m = gw; m < T; m += NGW) {
    const int b = m / NTOK, t = m % NTOK, r = t < NCTX ? 8 : b;
    if (skip_ctx && t < NCTX) { if (lane == 0) { tok_e[2 * m] = -1; tok_e[2 * m + 1] = -1; } continue; }
    const float4* xr = (const float4*)(hs + (size_t)m * D);
    const float4* sh = (const float4*)(mod + (size_t)r * 6 * D + 3 * D); const float4* sc = sh + D / 4;
    float4 v[4]; float ss = 0.f;
#pragma unroll
    for (int j = 0; j < 4; ++j) { v[j] = xr[lane + 64 * j]; ss += v[j].x * v[j].x + v[j].y * v[j].y + v[j].z * v[j].z + v[j].w * v[j].w; }
    const float rinv = rsqrtf(wave_sum(ss) * (1.f / D) + EPS);
    float acc[36];
#pragma unroll
    for (int j = 0; j < 36; ++j) acc[j] = 0.f;
#pragma unroll
    for (int j = 0; j < 4; ++j) { const float4 a = sc[lane + 64 * j], s4 = sh[lane + 64 * j];
      float h[4]; h[0] = v[j].x * rinv * (1.f + a.x) + s4.x; h[1] = v[j].y * rinv * (1.f + a.y) + s4.y; h[2] = v[j].z * rinv * (1.f + a.z) + s4.z; h[3] = v[j].w * rinv * (1.f + a.w) + s4.w;
      v2u o; o.x = pk2(h[0], h[1]); o.y = pk2(h[2], h[3]); ((v2u*)(hn + (size_t)m * D))[lane + 64 * j] = o;
#pragma unroll
      for (int e = 0; e < 4; ++e) { const int k = 4 * (lane + 64 * j) + e; const float4 g4 = *(const float4*)(wgr + k * 4);
        acc[0] += h[e] * g4.x; acc[1] += h[e] * g4.y; acc[2] += h[e] * g4.z; acc[3] += h[e] * g4.w;
#pragma unroll
        for (int q = 0; q < 8; ++q) { const float4 e4 = *(const float4*)(wer + k * 32 + q * 4); acc[4 + 4 * q] += h[e] * e4.x; acc[5 + 4 * q] += h[e] * e4.y; acc[6 + 4 * q] += h[e] * e4.z; acc[7 + 4 * q] += h[e] * e4.w; } } }
#pragma unroll
    for (int j = 0; j < 36; ++j) acc[j] = wave_sum(acc[j]);
    if (lane == 0) {
      float mxg = -1e30f; int g = 0;
#pragma unroll
      for (int j = 0; j < 4; ++j) { const float vv = acc[j] + bgr[j]; if (vv > mxg) { mxg = vv; g = j; } }
      float sg = 0.f;
#pragma unroll
      for (int j = 0; j < 4; ++j) sg += __expf(acc[j] + bgr[j] - mxg);
      const float pg = 1.f / sg;
      float v0 = -1e30f, v1 = -1e30f; int e0 = 0, e1 = 0;
#pragma unroll
      for (int j = 0; j < 8; ++j) { float le = 0.f;
#pragma unroll
        for (int gg = 0; gg < 4; ++gg) if (gg == g) le = acc[4 + gg * 8 + j];
        le += ber[g * 8 + j];
        if (le > v0) { v1 = v0; e1 = e0; v0 = le; e0 = j; } else if (le > v1) { v1 = le; e1 = j; } }
      const float p1 = __expf(v1 - v0); const float inv = pg / (1.f + p1);
      const int E0 = g * 8 + e0, E1 = g * 8 + e1;
      tok_e[2 * m] = E0; tok_e[2 * m + 1] = E1; tok_w[2 * m] = inv; tok_w[2 * m + 1] = p1 * inv;
      tok_r[2 * m] = (int)atomicAdd(&counts[E0], 1u); tok_r[2 * m + 1] = (int)atomicAdd(&counts[E1], 1u);
    }
  }
}
__device__ __forceinline__ void moe_tables(Ctx& F, const Args& A, int l) {
  LAS int* ps = (LAS int*)(F.lds + XSCR_OFF); LAS int* te = ps + 64;
  const unsigned* counts = (const unsigned*)(F.ws + WS_CTL) + CW_CNT + l * 64;
  if (F.tid == 0) { int a = 0; for (int e = 0; e < NE; ++e) { ps[e] = a; a += ((int)__hip_atomic_load(counts + e, __ATOMIC_RELAXED, __HIP_MEMORY_SCOPE_AGENT) + 255) / 256 * 256; } ps[NE] = a; }
  __syncthreads();
  for (int i = F.tid; i < NT_MOE; i += NTHR) { int e = -1;
    for (int j = 0; j < NE; ++j) if (i * 256 >= ps[j] && i * 256 < ps[j + 1]) e = j;
    te[i] = e; }
  __syncthreads();
}
__device__ __forceinline__ void phase_moe_gather(Ctx& F, const Args& A, int l) {
  moe_tables(F, A, l);
  LAS int* ps = (LAS int*)(F.lds + XSCR_OFF);
  const int gw = F.vcu * NWAVES + F.wave, NGW = F.G * NWAVES, lane = F.lane;
  const int* tok_e = (const int*)(F.ws + WS_TOKE); const int* tok_r = (const int*)(F.ws + WS_TOKR); int* tok_s = (int*)(F.ws + WS_TOKS);
  const bf16* hn = (const bf16*)(F.ws + WS_HN); bf16* xg = (bf16*)(F.ws + WS_XG);
  for (int i = gw; i < 2 * T; i += NGW) { const int e = tok_e[i]; if (e < 0) { if (lane == 0) tok_s[i] = -1; continue; }
    const int slot = ps[e] + tok_r[i]; if (lane == 0) tok_s[i] = slot;
    const v4u* src = (const v4u*)(hn + (size_t)(i >> 1) * D); v4u* dst = (v4u*)(xg + (size_t)slot * D);
    dst[lane] = src[lane]; dst[lane + 64] = src[lane + 64]; }
}
struct MoeSched {
  int G, c, npn, ntile; const char* A; const char* W; size_t aTile, wExp, wTile; const LAS int* te;
  __device__ __forceinline__ bool next(int i, Unit& u) const { const int Lx = i * G + c; if (Lx >= ntile * npn) return false; const int rt = Lx / npn, pn = Lx % npn; const int e = te[rt];
    u.pm = rt; u.pn = pn; u.aux = e; u.a = A + (size_t)rt * aTile; u.b = W + (size_t)e * wExp + (size_t)pn * wTile; return true; }
};
struct EpiSwiGLU {
  static constexpr bool PERM = true;
  bf16* H;
  __device__ __forceinline__ void operator()(const f32x4 (&acc)[2][2][4][2], const Unit& u, int wr, int wc, int fr, int fq) const {
#pragma unroll
    for (int ai = 0; ai < 2; ++ai)
#pragma unroll
      for (int m = 0; m < 4; ++m) { const size_t r = (size_t)u.pm * 256 + ai * 128 + wr * 64 + m * 16 + fr; float h[8];
#pragma unroll
        for (int n = 0; n < 2; ++n)
#pragma unroll
          for (int e = 0; e < 4; ++e) { const float g = acc[ai][0][m][n][e]; h[4 * n + e] = g * __builtin_amdgcn_rcpf(1.f + __expf(-g)) * acc[ai][1][m][n][e]; }
        v4u w; w.x = cvt_pk_bf16(h[0], h[1]); w.y = cvt_pk_bf16(h[2], h[3]); w.z = cvt_pk_bf16(h[4], h[5]); w.w = cvt_pk_bf16(h[6], h[7]);
        *(v4u*)(H + r * 256 + u.pn * 128 + wc * 32 + fq * 8) = w; }
  }
};
__device__ __forceinline__ void phase_moe_gu(Ctx& F, const Args& A, int l) {
  moe_tables(F, A, l);
  const LAS int* ps = (const LAS int*)(F.lds + XSCR_OFF);
  MoeSched S; S.G = F.G; S.c = (int)blockIdx.x; S.npn = 2; S.ntile = ps[NE] / 256; S.A = (const char*)(F.ws + WS_XG); S.W = (const char*)(F.ws + WS_WGU + l * SZ_WGU1); S.aTile = (size_t)256 * D * 2; S.wExp = (size_t)512 * D * 2; S.wTile = (size_t)256 * D * 2; S.te = ps + 64;
  EpiSwiGLU E{(bf16*)(F.ws + WS_HE)};
  gemm_phase<EpiSwiGLU, MoeSched, true>(F.lds, D * 2, D * 2, D, S, E);
}
__device__ __forceinline__ void phase_moe_dn(Ctx& F, const Args& A, int l) {
  moe_tables(F, A, l);
  const LAS int* ps = (const LAS int*)(F.lds + XSCR_OFF);
  MoeSched S; S.G = F.G; S.c = (int)blockIdx.x; S.npn = 4; S.ntile = ps[NE] / 256; S.A = (const char*)(F.ws + WS_HE); S.W = (const char*)(F.ws + WS_WDN + l * SZ_WDN1); S.aTile = (size_t)256 * 256 * 2; S.wExp = (size_t)D * 256 * 2; S.wTile = (size_t)256 * 256 * 2; S.te = ps + 64;
  EpiStoreBf16 E{(bf16*)(F.ws + WS_FS), D};
  gemm_phase<EpiStoreBf16, MoeSched, true>(F.lds, 512, 512, 256, S, E);
}
__device__ __forceinline__ void phase_moe_combine(Ctx& F, const Args& A, int l) {
  const int gw = F.vcu * NWAVES + F.wave, NGW = F.G * NWAVES, lane = F.lane;
  float* hs = (float*)(F.ws + WS_HS); const float* mod = (const float*)(F.ws + WS_MOD) + (size_t)l * 9 * 6 * D;
  const int* tok_s = (const int*)(F.ws + WS_TOKS); const float* tok_w = (const float*)(F.ws + WS_TOKW); const bf16* fs = (const bf16*)(F.ws + WS_FS);
  for (int m = gw; m < T; m += NGW) { const int s0 = tok_s[2 * m], s1 = tok_s[2 * m + 1]; if (s0 < 0) continue;
    const int b = m / NTOK, t = m % NTOK, r = t < NCTX ? 8 : b; const float w0 = tok_w[2 * m], w1 = tok_w[2 * m + 1];
    const float4* g5 = (const float4*)(mod + (size_t)r * 6 * D + 5 * D);
#pragma unroll
    for (int j = 0; j < 4; ++j) { const int c4 = lane + 64 * j; const v2u a = ((const v2u*)(fs + (size_t)s0 * D))[c4], bq = ((const v2u*)(fs + (size_t)s1 * D))[c4]; const float4 g = g5[c4];
      float4 h = ((float4*)(hs + (size_t)m * D))[c4];
      h.x += g.x * (w0 * bflo(a.x) + w1 * bflo(bq.x)); h.y += g.y * (w0 * bfhi(a.x) + w1 * bfhi(bq.x)); h.z += g.z * (w0 * bflo(a.y) + w1 * bflo(bq.y)); h.w += g.w * (w0 * bfhi(a.y) + w1 * bfhi(bq.y));
      ((float4*)(hs + (size_t)m * D))[c4] = h; } }
}
}
namespace mk {
constexpr int NKT = NTOK / 64;
constexpr size_t WS_QM = WS_END2, SZ_QM = (size_t)NB * 4 * NTOK * 96 * 2;
constexpr size_t WS_QD = WS_QM + SZ_QM, SZ_QD = (size_t)NB * 4 * NTOK * 64 * 2;
constexpr size_t WS_KM = WS_QD + SZ_QD, SZ_KM = (size_t)NB * 4 * NKT * 12288;
constexpr size_t WS_KD = WS_KM + SZ_KM, SZ_KD = (size_t)NB * 2 * NKT * 8192;
constexpr size_t WS_VM = WS_KD + SZ_KD, SZ_VM = (size_t)NB * 4 * NKT * 8192;
constexpr size_t WS_VD = WS_VM + SZ_VM, SZ_VD = (size_t)NB * 2 * NKT * 8192;
constexpr size_t WS_END3 = WS_VD + SZ_VD;
constexpr float QSCALE_M = 0.10206207261596577f * 1.4426950408889634f, QSCALE_D = 0.125f * 1.4426950408889634f;

template <int NCB> __device__ __forceinline__ int v_st(int k, int c) { const int kk = (k & ~0xC) | ((k & 4) << 1) | ((k & 8) >> 1); return ((kk >> 3) * NCB + (c >> 5)) * 512 + ((kk & 7) * 32 + (c & 31)) * 2; }
__device__ __forceinline__ int v_rd_base(int lane) { return ((lane & 3) << 3) | (((lane >> 2) & 3) << 6) | (((lane >> 4) & 1) << 5) | (((lane >> 5) & 1) << 8); }
template <int NCB> constexpr int v_rd_off(int d0, int ks, int half) { return d0 * 512 + ks * (2 * NCB * 512) + half * (NCB * 512); }
typedef short s16x4 __attribute__((ext_vector_type(4)));
typedef float f32x16 __attribute__((ext_vector_type(16)));
template <int OFF> __device__ __forceinline__ s16x4 tr_read(int vb) { s16x4 r; asm volatile("ds_read_b64_tr_b16 %0, %1 offset:%2" : "=&v"(r) : "v"(vb), "i"(OFF) : "memory"); return r; }
__device__ __forceinline__ int crow(int r, int hi) { return (r & 3) + 8 * (r >> 2) + 4 * hi; }
#define SBAR() __builtin_amdgcn_sched_barrier(0)

template <int ROT> __device__ __forceinline__ void rope_cs(int t, int i, float& cs, float& sn) {
  constexpr int NF = ROT / 4;
  if (t < NCTX) { cs = 1.f; sn = 0.f; return; }
  const int tl = t - NCTX; const float pos = (i < NF) ? (float)(tl >> 6) : (float)(tl & 63); const int fi = i % NF;
  const float fr = exp2f(-(float)fi * (13.287712379549449f / (float)NF));
  float rev = pos * fr * 0.15915494309189535f; rev = rev - floorf(rev);
  cs = __builtin_amdgcn_cosf(rev); sn = __builtin_amdgcn_sinf(rev);
}

__device__ __forceinline__ void phase_b_rows(Ctx& F, const Args& A, int l) {
  const int gw = F.vcu * NWAVES + F.wave, NGW = F.G * NWAVES, lane = F.lane;
  const bf16* zb = (const bf16*)(F.ws + WS_ZB); bf16* Y = (bf16*)(F.ws + WS_Y);
  const float* gq_gain = A.in[15] + l * 64; const float* gk_gain = A.in[16] + l * 64; const float* w_conv = A.in[14] + l * 3 * 256;
  const float gq = gq_gain[lane], gk = gk_gain[lane];
  float wc0[4], wc1[4], wc2[4];
#pragma unroll
  for (int e = 0; e < 4; ++e) { wc0[e] = w_conv[0 * 256 + 4 * lane + e]; wc1[e] = w_conv[1 * 256 + 4 * lane + e]; wc2[e] = w_conv[2 * 256 + 4 * lane + e]; }
  for (int m = gw; m < T; m += NGW) {
    const int b = m / NTOK, t = m % NTOK, tile = t >> 6, rr = t & 63; const bf16* zr = zb + (size_t)m * ZBW;
    { const float xv = bf2f(zr[ZB_KPE + (lane & 31)]); const float xp = __shfl_xor(xv, 16); float cs, sn; rope_cs<32>(t, lane & 15, cs, sn);
      const float o = (lane & 16) ? (xp * sn + xv * cs) : (xv * cs - xp * sn); const bf16 ob = (bf16)f2bf(o);
      if (lane < 32) {
#pragma unroll
        for (int h = 0; h < 4; ++h) ((bf16*)(F.ws + WS_KM + ((size_t)(b * 4 + h) * NKT + tile) * 12288))[(8 + (lane >> 3)) * 512 + rr * 8 + (lane & 7)] = ob; } }
#pragma unroll
    for (int h = 0; h < 4; ++h) { const float x0 = bf2f(zr[ZB_GQ + h * 64 + lane]); const float rinv = rsqrtf(wave_sum(x0 * x0) * (1.f / 64.f) + EPS); const float xv = x0 * rinv * gq;
      const float xp = __shfl_xor(xv, 32); float cs, sn; rope_cs<64>(t, lane & 31, cs, sn); const float o = ((lane & 32) ? (xp * sn + xv * cs) : (xv * cs - xp * sn)) * QSCALE_D;
      ((bf16*)(F.ws + WS_QD))[((size_t)(b * 4 + h) * NTOK + t) * 64 + lane] = (bf16)f2bf(o); }
#pragma unroll
    for (int h = 0; h < 2; ++h) { const float x0 = bf2f(zr[ZB_GK + h * 64 + lane]); const float rinv = rsqrtf(wave_sum(x0 * x0) * (1.f / 64.f) + EPS); const float xv = x0 * rinv * gk;
      const float xp = __shfl_xor(xv, 32); float cs, sn; rope_cs<64>(t, lane & 31, cs, sn); const float o = (lane & 32) ? (xp * sn + xv * cs) : (xv * cs - xp * sn);
      ((bf16*)(F.ws + WS_KD + ((size_t)(b * 2 + h) * NKT + tile) * 8192))[(lane >> 3) * 512 + rr * 8 + (lane & 7)] = (bf16)f2bf(o);
      *(bf16*)(F.ws + WS_VD + ((size_t)(b * 2 + h) * NKT + tile) * 8192 + v_st<2>(rr, lane)) = zr[ZB_GV + h * 64 + lane]; }
    { const int lo = t < NCTX ? 0 : NCTX, hi = t < NCTX ? NCTX : NTOK; float a[4] = {0.f, 0.f, 0.f, 0.f};
#pragma unroll
      for (int j = 0; j < 3; ++j) { const int tt = t + j - 1; if (tt < lo || tt >= hi) continue; const bf16* z2 = zb + (size_t)(m + j - 1) * ZBW;
        const v2u cc = *(const v2u*)(z2 + ZB_CC + 4 * lane), cx = *(const v2u*)(z2 + ZB_CX + 4 * lane); const float* wj = j == 0 ? wc0 : (j == 1 ? wc1 : wc2);
        a[0] += wj[0] * bflo(cc.x) * bflo(cx.x); a[1] += wj[1] * bfhi(cc.x) * bfhi(cx.x); a[2] += wj[2] * bflo(cc.y) * bflo(cx.y); a[3] += wj[3] * bfhi(cc.y) * bfhi(cx.y); }
      const v2u cb = *(const v2u*)(zr + ZB_CB + 4 * lane); v2u o; o.x = pk2(bflo(cb.x) * a[0], bfhi(cb.x) * a[1]); o.y = pk2(bflo(cb.y) * a[2], bfhi(cb.y) * a[3]);
      *(v2u*)(Y + (size_t)m * D + 512 + 4 * lane) = o; }
  }
}
template <int NWID> __device__ __forceinline__ float seg_rinv(const bf16* seg, int fq) {
  float ss = 0.f;
#pragma unroll
  for (int i = 0; i < NWID / 32; ++i) { const v4u w = *(const v4u*)(seg + fq * (NWID / 4) + i * 8);
    ss += bflo(w.x) * bflo(w.x) + bfhi(w.x) * bfhi(w.x) + bflo(w.y) * bflo(w.y) + bfhi(w.y) * bfhi(w.y) + bflo(w.z) * bflo(w.z) + bfhi(w.z) * bfhi(w.z) + bflo(w.w) * bflo(w.w) + bfhi(w.w) * bfhi(w.w); }
  ss += __shfl_xor(ss, 16); ss += __shfl_xor(ss, 32);
  return rsqrtf(ss * (1.f / NWID) + EPS);
}
struct EpiQm {
  static constexpr bool PERM = true;
  const bf16* zb; bf16* QM;
  __device__ __forceinline__ void operator()(const f32x4 (&acc)[2][2][4][2], const Unit& u, int wr, int wc, int fr, int fq) const {
#pragma unroll
    for (int ai = 0; ai < 2; ++ai)
#pragma unroll
      for (int m = 0; m < 4; ++m) { const int r = u.pm * 256 + ai * 128 + wr * 64 + m * 16 + fr; const int b = r / NTOK, t = r % NTOK;
        const float sc = seg_rinv<256>(zb + (size_t)r * ZBW + ZB_MQ, fq) * QSCALE_M;
        if (u.pn == 0) {
#pragma unroll
          for (int bj = 0; bj < 2; ++bj) { const int h = 2 * bj + (wc >> 1), d = 32 * (wc & 1) + 8 * fq; const f32x4 v0 = acc[ai][bj][m][0] * sc, v1 = acc[ai][bj][m][1] * sc;
            v4u w; w.x = cvt_pk_bf16(v0[0], v0[1]); w.y = cvt_pk_bf16(v0[2], v0[3]); w.z = cvt_pk_bf16(v1[0], v1[1]); w.w = cvt_pk_bf16(v1[2], v1[3]);
            *(v4u*)(QM + ((size_t)(b * 4 + h) * NTOK + t) * 96 + d) = w; }
        } else { const int h = wc; const f32x4 x1 = acc[ai][0][m][0] * sc, x2 = acc[ai][0][m][1] * sc; float o1[4], o2[4];
#pragma unroll
          for (int e = 0; e < 4; ++e) { float cs, sn; rope_cs<32>(t, 4 * fq + e, cs, sn); o1[e] = x1[e] * cs - x2[e] * sn; o2[e] = x1[e] * sn + x2[e] * cs; }
          bf16* q = QM + ((size_t)(b * 4 + h) * NTOK + t) * 96 + 64 + 4 * fq;
          v2u w1; w1.x = cvt_pk_bf16(o1[0], o1[1]); w1.y = cvt_pk_bf16(o1[2], o1[3]); *(v2u*)q = w1;
          v2u w2; w2.x = cvt_pk_bf16(o2[0], o2[1]); w2.y = cvt_pk_bf16(o2[2], o2[3]); *(v2u*)(q + 16) = w2; }
      }
  }
};
struct EpiKVm {
  static constexpr bool PERM = true;
  const bf16* zb; unsigned char* ws;
  __device__ __forceinline__ void operator()(const f32x4 (&acc)[2][2][4][2], const Unit& u, int wr, int wc, int fr, int fq) const {
#pragma unroll
    for (int ai = 0; ai < 2; ++ai)
#pragma unroll
      for (int m = 0; m < 4; ++m) { const int r = u.pm * 256 + ai * 128 + wr * 64 + m * 16 + fr; const int b = r / NTOK, t = r % NTOK, tile = t >> 6, rr = t & 63;
        const float sc = seg_rinv<128>(zb + (size_t)r * ZBW + ZB_MKV, fq);
#pragma unroll
        for (int bj = 0; bj < 2; ++bj) { const int h = 2 * u.pn + bj; const f32x4 v0 = acc[ai][bj][m][0] * sc, v1 = acc[ai][bj][m][1] * sc;
          v4u w; w.x = cvt_pk_bf16(v0[0], v0[1]); w.y = cvt_pk_bf16(v0[2], v0[3]); w.z = cvt_pk_bf16(v1[0], v1[1]); w.w = cvt_pk_bf16(v1[2], v1[3]);
          if (wc < 2) *(v4u*)(ws + WS_KM + ((size_t)(b * 4 + h) * NKT + tile) * 12288 + (4 * wc + fq) * 1024 + rr * 16) = w;
          else *(v4u*)(ws + WS_VM + ((size_t)(b * 4 + h) * NKT + tile) * 8192 + v_st<2>(rr, 32 * (wc - 2) + 8 * fq)) = w; }
      }
  }
};
struct SliceSched {
  TileOrder o; const char* A; const char* B;
  __device__ __forceinline__ bool next(int i, Unit& u) const { int pm, pn; if (!o.tile(i, pm, pn)) return false; u.pm = pm; u.pn = pn; u.aux = 0; u.a = A + (size_t)pm * 256 * ZBW * 2; u.b = B + (size_t)pn * 256 * 512; return true; }
};
__device__ __forceinline__ void phase_b_chunkmix(Ctx& F, const Args& A, int l) {
  const int lane = F.lane, wave = F.wave, r32 = lane & 31, hi = lane >> 5;
  const bf16* zb = (const bf16*)(F.ws + WS_ZB); bf16* Y = (bf16*)(F.ws + WS_Y); const bf16* wsg = (const bf16*)(F.ws + WS_WSGU + l * SZ_WSGU1);
  const float* sgu_gain = A.in[7] + l * 256; const float* b_s = A.in[9] + l * 4 * 128;
  const float g0 = sgu_gain[4 * lane], g1 = sgu_gain[4 * lane + 1], g2 = sgu_gain[4 * lane + 2], g3 = sgu_gain[4 * lane + 3];
  LAS unsigned char* img = F.lds;
  const int g = wave >> 1, ph = wave & 1;
  for (int ch = (int)blockIdx.x; ch < T / 128; ch += F.G) {
    const int m0 = ch * 128;
    __syncthreads();
    for (int q = wave; q < 128; q += NWAVES) { const v2u w = *(const v2u*)(zb + (size_t)(m0 + q) * ZBW + ZB_AV + 4 * lane);
      const float a0 = gelu_tanh(bflo(w.x)), a1 = gelu_tanh(bfhi(w.x)), a2 = gelu_tanh(bflo(w.y)), a3 = gelu_tanh(bfhi(w.y));
      const float rinv = rsqrtf(wave_sum(a0 * a0 + a1 * a1 + a2 * a2 + a3 * a3) * (1.f / 256.f) + EPS);
      v2u o; o.x = pk2(a0 * rinv * g0, a1 * rinv * g1); o.y = pk2(a2 * rinv * g2, a3 * rinv * g3);
      *(LAS v2u*)(img + v_st<8>(q, 4 * lane)) = o; }
    __syncthreads();
    f32x16 acc[2][2];
#pragma unroll
    for (int a = 0; a < 2; ++a)
#pragma unroll
      for (int c = 0; c < 2; ++c) acc[a][c] = f32x16{};
    const int vb = (int)(uintptr_t)img + v_rd_base(lane) + (2 * g) * 512;
    const bf16* wrow = wsg + ((size_t)g * 128 + 64 * ph + r32) * 128 + 8 * hi;
#define CM_STEP(KS) do { const bf16x8 a0 = *(const bf16x8*)(wrow + 16 * (KS)), a1 = *(const bf16x8*)(wrow + 32 * 128 + 16 * (KS)); \
      const s16x4 l0 = tr_read<v_rd_off<8>(0, KS, 0)>(vb), h0 = tr_read<v_rd_off<8>(0, KS, 1)>(vb), l1 = tr_read<v_rd_off<8>(1, KS, 0)>(vb), h1 = tr_read<v_rd_off<8>(1, KS, 1)>(vb); \
      asm volatile("s_waitcnt lgkmcnt(0)" ::: "memory"); SBAR(); \
      const bf16x8 b0 = (bf16x8){l0[0], l0[1], l0[2], l0[3], h0[0], h0[1], h0[2], h0[3]}, b1 = (bf16x8){l1[0], l1[1], l1[2], l1[3], h1[0], h1[1], h1[2], h1[3]}; \
      acc[0][0] = __builtin_amdgcn_mfma_f32_32x32x16_bf16(a0, b0, acc[0][0], 0, 0, 0); acc[0][1] = __builtin_amdgcn_mfma_f32_32x32x16_bf16(a0, b1, acc[0][1], 0, 0, 0); \
      acc[1][0] = __builtin_amdgcn_mfma_f32_32x32x16_bf16(a1, b0, acc[1][0], 0, 0, 0); acc[1][1] = __builtin_amdgcn_mfma_f32_32x32x16_bf16(a1, b1, acc[1][1], 0, 0, 0); } while (0)
    CM_STEP(0); CM_STEP(1); CM_STEP(2); CM_STEP(3); CM_STEP(4); CM_STEP(5); CM_STEP(6); CM_STEP(7);
#undef CM_STEP
#pragma unroll
    for (int pt = 0; pt < 2; ++pt)
#pragma unroll
      for (int r = 0; r < 16; ++r) { const int p = 64 * ph + 32 * pt + crow(r, hi); const float bs = b_s[g * 128 + p];
#pragma unroll
        for (int cb = 0; cb < 2; ++cb) { const int c = 64 * g + 32 * cb + r32; const float au = gelu_tanh(bf2f(zb[(size_t)(m0 + p) * ZBW + ZB_AU + c]));
          Y[(size_t)(m0 + p) * D + c] = (bf16)f2bf(au * (acc[pt][cb][r] + bs)); } }
  }
  __syncthreads();
}
constexpr float ATT_THR = 8.f;
__device__ __forceinline__ void att_partialSM(f32x16& p0, f32x16& p1, float& m_reg, float& alpha) {
  float pmax = p0[0];
#pragma unroll
  for (int r = 1; r < 16; ++r) pmax = fmaxf(pmax, p0[r]);
#pragma unroll
  for (int r = 0; r < 16; ++r) pmax = fmaxf(pmax, p1[r]);
  { auto rr = __builtin_amdgcn_permlane32_swap(__float_as_uint(pmax), __float_as_uint(pmax), false, false); pmax = fmaxf(__uint_as_float(rr[0]), __uint_as_float(rr[1])); }
  float mn;
  if (__builtin_expect(__all(pmax - m_reg <= ATT_THR), 1)) { mn = m_reg; alpha = 1.f; }
  else { mn = fmaxf(m_reg, pmax); alpha = __builtin_amdgcn_exp2f(m_reg - mn); m_reg = mn; }
#pragma unroll
  for (int r = 0; r < 16; ++r) { p0[r] -= mn; p1[r] -= mn; }
#pragma unroll
  for (int r = 0; r < 16; ++r) p0[r] = __builtin_amdgcn_exp2f(p0[r]);
}
__device__ __forceinline__ void att_finishSM(f32x16& p0, f32x16& p1, float alpha, float& l_reg, bf16x8& pa0, bf16x8& pa1, bf16x8& pa2, bf16x8& pa3) {
#pragma unroll
  for (int r = 0; r < 16; ++r) p1[r] = __builtin_amdgcn_exp2f(p1[r]);
  float ps = 0.f;
#pragma unroll
  for (int r = 0; r < 16; ++r) ps += p0[r];
#pragma unroll
  for (int r = 0; r < 16; ++r) ps += p1[r];
  { auto rr = __builtin_amdgcn_permlane32_swap(__float_as_uint(ps), __float_as_uint(ps), false, false); ps = __uint_as_float(rr[0]) + __uint_as_float(rr[1]); }
  l_reg = l_reg * alpha + ps;
#define PK4(P, BASE, OUT) do { unsigned a0 = cvt_pk_bf16(P[BASE + 0], P[BASE + 1]), a1 = cvt_pk_bf16(P[BASE + 2], P[BASE + 3]);   \
    unsigned b0 = cvt_pk_bf16(P[BASE + 4], P[BASE + 5]), b1 = cvt_pk_bf16(P[BASE + 6], P[BASE + 7]);                              \
    auto r0 = __builtin_amdgcn_permlane32_swap(a0, b0, false, false); auto r1 = __builtin_amdgcn_permlane32_swap(a1, b1, false, false); \
    v4u w = {r0[0], r1[0], r0[1], r1[1]}; OUT = __builtin_bit_cast(bf16x8, w); } while (0)
  PK4(p0, 0, pa0); PK4(p0, 8, pa1); PK4(p1, 0, pa2); PK4(p1, 8, pa3);
#undef PK4
}
template <int DK> __device__ __forceinline__ void att_qkt(f32x16& p0, f32x16& p1, const LAS unsigned char* Ks, const bf16x8* qr, int r32, int hi) {
  p0 = f32x16{}; p1 = f32x16{};
#pragma unroll
  for (int d0 = 0; d0 < DK / 16; ++d0) { const LAS unsigned char* kb = Ks + (2 * d0 + hi) * 1024 + r32 * 16;
    const bf16x8 b0 = *(const LAS bf16x8*)kb, b1 = *(const LAS bf16x8*)(kb + 512);
    p0 = __builtin_amdgcn_mfma_f32_32x32x16_bf16(b0, qr[d0], p0, 0, 0, 0);
    p1 = __builtin_amdgcn_mfma_f32_32x32x16_bf16(b1, qr[d0], p1, 0, 0, 0); }
}
template <int D0> __device__ __forceinline__ void att_pv_one(f32x16& od, int vb, bf16x8 pa0, bf16x8 pa1, bf16x8 pa2, bf16x8 pa3) {
  const s16x4 l0 = tr_read<v_rd_off<2>(D0, 0, 0)>(vb), h0 = tr_read<v_rd_off<2>(D0, 0, 1)>(vb), l1 = tr_read<v_rd_off<2>(D0, 1, 0)>(vb), h1 = tr_read<v_rd_off<2>(D0, 1, 1)>(vb);
  const s16x4 l2 = tr_read<v_rd_off<2>(D0, 2, 0)>(vb), h2 = tr_read<v_rd_off<2>(D0, 2, 1)>(vb), l3 = tr_read<v_rd_off<2>(D0, 3, 0)>(vb), h3 = tr_read<v_rd_off<2>(D0, 3, 1)>(vb);
  asm volatile("s_waitcnt lgkmcnt(0)" ::: "memory"); SBAR();
#define PK(Lx, Hx) (bf16x8){Lx[0], Lx[1], Lx[2], Lx[3], Hx[0], Hx[1], Hx[2], Hx[3]}
  od = __builtin_amdgcn_mfma_f32_32x32x16_bf16(pa0, PK(l0, h0), od, 0, 0, 0);
  od = __builtin_amdgcn_mfma_f32_32x32x16_bf16(pa1, PK(l1, h1), od, 0, 0, 0);
  od = __builtin_amdgcn_mfma_f32_32x32x16_bf16(pa2, PK(l2, h2), od, 0, 0, 0);
  od = __builtin_amdgcn_mfma_f32_32x32x16_bf16(pa3, PK(l3, h3), od, 0, 0, 0);
#undef PK
}
template <int DK>
__device__ __forceinline__ void attn_unit(LAS unsigned char* lds, const bf16* __restrict__ Qb, const unsigned char* __restrict__ Kt, const unsigned char* __restrict__ Vt, const int NT, bf16* Ob) {
  constexpr int KB = DK * 128, ND = DK / 16;
  const int tid = threadIdx.x, wid = __builtin_amdgcn_readfirstlane(tid >> 6), lane = tid & 63, r32 = lane & 31, hi = lane >> 5;
  LAS unsigned char* Vl = lds; LAS unsigned char* Kl = lds + 16384; LAS float* wsf = (LAS float*)(lds + 16384 + 2 * KB) + wid * 64; LAS float* li_l = wsf; LAS float* al_l = wsf + 32;
  LAS bf16* stg = (LAS bf16*)(lds + 16384 + 2 * KB + 2048) + wid * 2048;
  float m_reg = -1e30f, l_reg = 0.f; f32x16 o[2] = {f32x16{}, f32x16{}}; bf16x8 qr[ND];
  const bf16* Qw = Qb + (size_t)(wid * 32 + r32) * DK + hi * 8;
#pragma unroll
  for (int d0 = 0; d0 < ND; ++d0) qr[d0] = *(const bf16x8*)(Qw + d0 * 16);
  const bool has2 = (DK == 96) && (wid < 4);
  const int vb0 = (int)(uintptr_t)Vl + v_rd_base(lane);
  struct { v4u k0, k1, v; } sr_[2];
#define SLOAD(i, tl) do { const unsigned char* kp_ = Kt + (size_t)(tl) * KB + tid * 16; sr_[i].k0 = *(const v4u*)kp_; if (has2) sr_[i].k1 = *(const v4u*)(kp_ + 8192); sr_[i].v = *(const v4u*)(Vt + (size_t)(tl) * 8192 + tid * 16); } while (0)
#define SWRITE(b, i) do { *(LAS v4u*)(Kl + (b) * KB + tid * 16) = sr_[i].k0; if (has2) *(LAS v4u*)(Kl + (b) * KB + 8192 + tid * 16) = sr_[i].k1; *(LAS v4u*)(Vl + (b) * 8192 + tid * 16) = sr_[i].v; } while (0)
#define RESC(a) do { if (__any((a) < 1.f)) { if (hi == 0) al_l[r32] = (a); asm volatile("s_waitcnt lgkmcnt(0)" ::: "memory"); \
    _Pragma("unroll") for (int d = 0; d < 2; ++d) _Pragma("unroll") for (int r = 0; r < 16; ++r) o[d][r] *= al_l[crow(r, hi)]; } } while (0)
  f32x16 pA0, pA1, pB0, pB1; float alA, alB; bf16x8 pa0, pa1, pa2, pa3;
  SLOAD(0, 0); SWRITE(0, 0); __syncthreads();
  att_qkt<DK>(pA0, pA1, Kl, qr, r32, hi); att_partialSM(pA0, pA1, m_reg, alA);
  SLOAD(1, 1); SLOAD(0, 2);
  SWRITE(1, 1); __syncthreads();
#pragma unroll 1
  for (int j = 1; j + 1 < NT; j += 2) {
    SBAR(); att_qkt<DK>(pB0, pB1, Kl + KB, qr, r32, hi);
    att_finishSM(pA0, pA1, alA, l_reg, pa0, pa1, pa2, pa3); SBAR();
    SLOAD(1, j + 2); SBAR();
    att_pv_one<0>(o[0], vb0, pa0, pa1, pa2, pa3); att_pv_one<1>(o[1], vb0, pa0, pa1, pa2, pa3); att_partialSM(pB0, pB1, m_reg, alB);
    __syncthreads(); SWRITE(0, 0);
    RESC(alB); __syncthreads();
    SBAR(); att_qkt<DK>(pA0, pA1, Kl, qr, r32, hi);
    att_finishSM(pB0, pB1, alB, l_reg, pa0, pa1, pa2, pa3); SBAR();
    if (j + 3 < NT) SLOAD(0, j + 3); SBAR();
    att_pv_one<0>(o[0], vb0 + 8192, pa0, pa1, pa2, pa3); att_pv_one<1>(o[1], vb0 + 8192, pa0, pa1, pa2, pa3); att_partialSM(pA0, pA1, m_reg, alA);
    __syncthreads(); SWRITE(1, 1);
    RESC(alA); __syncthreads();
  }
  SBAR(); att_qkt<DK>(pB0, pB1, Kl + KB, qr, r32, hi);
  att_finishSM(pA0, pA1, alA, l_reg, pa0, pa1, pa2, pa3); SBAR();
  att_pv_one<0>(o[0], vb0, pa0, pa1, pa2, pa3); att_pv_one<1>(o[1], vb0, pa0, pa1, pa2, pa3); att_partialSM(pB0, pB1, m_reg, alB);
  __syncthreads(); RESC(alB);
  att_finishSM(pB0, pB1, alB, l_reg, pa0, pa1, pa2, pa3); SBAR();
  att_pv_one<0>(o[0], vb0 + 8192, pa0, pa1, pa2, pa3); att_pv_one<1>(o[1], vb0 + 8192, pa0, pa1, pa2, pa3);
  if (hi == 0) li_l[r32] = l_reg; asm volatile("s_waitcnt lgkmcnt(0)" ::: "memory");
#pragma unroll
  for (int r = 0; r < 16; ++r) { const float rl = __builtin_amdgcn_rcpf(li_l[crow(r, hi)]); const int orow = crow(r, hi);
    stg[orow * 64 + r32] = (bf16)f2bf(o[0][r] * rl); stg[orow * 64 + 32 + r32] = (bf16)f2bf(o[1][r] * rl); }
  asm volatile("s_waitcnt lgkmcnt(0)" ::: "memory");
#pragma unroll
  for (int i = 0; i < 4; ++i) { const int row = i * 8 + (lane >> 3), ch = lane & 7; const v4u v = *(const LAS v4u*)(stg + row * 64 + ch * 8); *(v4u*)(Ob + (size_t)(wid * 32 + row) * D + ch * 8) = v; }
#undef SLOAD
#undef SWRITE
#undef RESC
}
__device__ __forceinline__ void phase_attn(Ctx& F, const Args& A) {
  for (int i = 0;; ++i) {
    const int Lx = i * F.G + (int)blockIdx.x; if (Lx >= 576) break;
    int kind, b, h, qb;
    if (Lx < 512) { kind = Lx >> 8; const int rem = Lx & 255; b = rem & 7; const int idx = rem >> 3; h = idx >> 3; qb = 1 + (idx & 7); }
    else { const int ll = Lx - 512; b = ll & 7; const int j = ll >> 3; kind = j >> 2; h = j & 3; qb = 0; }
    const int NT = qb == 0 ? 4 : NKT;
    bf16* Ob = (bf16*)(F.ws + WS_Y) + (size_t)(b * NTOK + qb * 256) * D + (kind == 0 ? 256 : 768) + h * 64;
    if (kind == 0) attn_unit<96>(F.lds, (const bf16*)(F.ws + WS_QM) + ((size_t)(b * 4 + h) * NTOK + qb * 256) * 96, F.ws + WS_KM + (size_t)(b * 4 + h) * NKT * 12288, F.ws + WS_VM + (size_t)(b * 4 + h) * NKT * 8192, NT, Ob);
    else attn_unit<64>(F.lds, (const bf16*)(F.ws + WS_QD) + ((size_t)(b * 4 + h) * NTOK + qb * 256) * 64, F.ws + WS_KD + (size_t)(b * 2 + (h >> 1)) * NKT * 8192, F.ws + WS_VD + (size_t)(b * 2 + (h >> 1)) * NKT * 8192, NT, Ob);
  }
  __syncthreads();
}
__device__ __forceinline__ void phase_b(Ctx& F, const Args& A, int l) {
  phase_b_rows(F, A, l);
  { SliceSched S; S.o.init(NROWT, 2, F.G, (int)blockIdx.x); S.A = (const char*)(F.ws + WS_ZB) + ZB_MQ * 2; S.B = (const char*)(F.ws + WS_WUQ + l * SZ_WUQ1);
    EpiQm E{(const bf16*)(F.ws + WS_ZB), (bf16*)(F.ws + WS_QM)}; gemm_phase<EpiQm, SliceSched, true>(F.lds, ZBW * 2, 512, 256, S, E); }
  { SliceSched S; S.o.init(NROWT, 2, F.G, (int)blockIdx.x); S.A = (const char*)(F.ws + WS_ZB) + ZB_MKV * 2; S.B = (const char*)(F.ws + WS_WUKV + l * SZ_WUKV1);
    EpiKVm E{(const bf16*)(F.ws + WS_ZB), F.ws}; gemm_phase<EpiKVm, SliceSched, true>(F.lds, ZBW * 2, 512, 256, S, E); }
  phase_b_chunkmix(F, A, l);
}
}
namespace mk {
__global__ void __launch_bounds__(NTHR, 2) mk_kernel(Args a) {
  extern __shared__ __attribute__((aligned(16))) unsigned char lds_raw[];
  Ctx F; F.lds = (LAS unsigned char*)lds_raw; F.ws = a.ws; F.tid = threadIdx.x; F.lane = F.tid & 63; F.wave = __builtin_amdgcn_readfirstlane(F.tid >> 6);
  F.G = gridDim.x; { const int bx = blockIdx.x; F.vcu = (F.G % 8 == 0) ? (bx % 8) * (F.G / 8) + bx / 8 : bx; }
  if (a.phase == 0) phase_prep(F, a);
  else if (a.phase == 1) phase_norm_mod(F, a, a.layer, 0, a.flag != 0);
  else if (a.phase == 2) phase_zgemm(F, a, a.layer);
  else if (a.phase == 3) phase_branch(F, a, a.layer);
  else if (a.phase == 4) phase_gate(F, a, a.layer);
  else if (a.phase == 5) phase_out(F, a, a.layer);
  else if (a.phase == 6) phase_norm_router(F, a, a.layer, a.flag != 0);
  else if (a.phase == 7) phase_moe_gather(F, a, a.layer);
  else if (a.phase == 8) phase_moe_gu(F, a, a.layer);
  else if (a.phase == 9) phase_moe_dn(F, a, a.layer);
  else if (a.phase == 10) phase_moe_combine(F, a, a.layer);
  else if (a.phase == 11) phase_b(F, a, a.layer);
  else if (a.phase == 12) phase_attn(F, a);
}
__global__ __launch_bounds__(256) void k_shim_zb(const bf16* ZB, float* Z32) {
  const size_t i = (size_t)blockIdx.x * 256 + threadIdx.x; if (i >= (size_t)T * DIN) return; const size_t m = i / DIN; const int n = i % DIN;
  Z32[i] = bf2f(ZB[m * ZBW + zmap(n)]);
}
__global__ __launch_bounds__(256) void k_shim_bf2f(const bf16* src, float* dst, size_t n) { const size_t i = (size_t)blockIdx.x * 256 + threadIdx.x; if (i < n) dst[i] = bf2f(src[i]); }
__global__ __launch_bounds__(256) void k_shim_f2bf(const float* src, bf16* dst, size_t n) { const size_t i = (size_t)blockIdx.x * 256 + threadIdx.x; if (i < n) dst[i] = (bf16)f2bf(src[i]); }
}

extern "C" void kernel_launch(void* const* d_in, const int* in_sizes, int n_in, void* d_out, int out_size, void* d_ws, size_t ws_size, hipStream_t stream) {
  using namespace mk;
  static int grid = 0;
  if (grid == 0) {
    int dev = 0, cus = 0, per_cu = 0;
    hipGetDevice(&dev); hipDeviceGetAttribute(&cus, hipDeviceAttributeMultiprocessorCount, dev);
    hipFuncSetAttribute((const void*)mk_kernel, hipFuncAttributeMaxDynamicSharedMemorySize, LDS_BYTES);
    hipOccupancyMaxActiveBlocksPerMultiprocessor(&per_cu, (const void*)mk_kernel, NTHR, LDS_BYTES);
    grid = per_cu >= 1 ? cus : -1;
  }
  if (grid < 0 || WS_END3 > ws_size) { fprintf(stderr, "kernel_launch: cannot run (grid %d, ws need %zu have %zu)\n", grid, (size_t)WS_END3, ws_size); (void)hipMemsetAsync(d_out, 0xFF, (size_t)out_size * 4, stream); return; }
  char* w = (char*)d_ws; float* HS = (float*)(w + WS_HS);
  Args a{}; for (int i = 0; i < 28; ++i) a.in[i] = (const float*)d_in[i]; a.out = (float*)d_out; a.ws = (unsigned char*)d_ws;
  auto run = [&](int phase, int layer, int flag) { a.phase = phase; a.layer = layer; a.flag = flag; hipLaunchKernelGGL(mk_kernel, dim3(grid), dim3(NTHR), LDS_BYTES, stream, a); };
  (void)hipMemsetAsync(d_ws, 0, CTL_BYTES, stream);
  run(0, 0, 0);
  hipLaunchKernelGGL(v0::k_init_hs, dim3((T * D / 4 + 255) / 256), dim3(256), 0, stream, (const float*)d_in[0], (const float*)d_in[2], HS);
  for (int l = 0; l < L; ++l) {
    run(1, l, 0); run(2, l, 0); run(11, l, 0); run(12, l, 0); run(3, l, 0); run(4, l, 0); run(5, l, 0);
    run(6, l, l == L - 1 ? 1 : 0); run(7, l, 0); run(8, l, 0); run(9, l, 0); run(10, l, 0);
  }
  hipLaunchKernelGGL(v0::k_final, dim3(NB * NLAT / 4), dim3(256), 0, stream, HS, (const float*)d_in[27], (float*)d_out);
}
```

```cpp
#define DUP 4096
#include <hip/hip_runtime.h>
#include <cstdio>
#include <cstdint>
namespace g8 {
#define G8_LAS __attribute__((address_space(3)))
typedef unsigned short bf16_t;
typedef short bf16x8 __attribute__((ext_vector_type(8)));
typedef float f32x4 __attribute__((ext_vector_type(4)));
typedef float f32x2 __attribute__((ext_vector_type(2)));
typedef unsigned u32x4 __attribute__((ext_vector_type(4)));
typedef unsigned u32x2 __attribute__((ext_vector_type(2)));
typedef int i32x4 __attribute__((ext_vector_type(4)));
typedef int i32x8 __attribute__((ext_vector_type(8)));
constexpr int BM = 256, BK = 64, HALF = 128, HTB = HALF * BK * 2, STAGE_BYTES = 8 * HTB;

__host__ __device__ __forceinline__ int lds_byte(int r, int c) { const int st = (r >> 4) * 2 + (c >> 5), rr = r & 15, cc = c & 31, ob = rr * 64 + cc * 2; return st * 1024 + (ob ^ (((ob >> 9) & 1) << 5)); }
__host__ __device__ __forceinline__ void stage_rc(int b, int& R, int& C) { const int st = b / 1024, sb = b % 1024, swz = sb ^ (((sb >> 9) & 1) << 5); R = (st >> 1) * 16 + swz / 64; C = (st & 1) * 32 + (swz % 64) / 2; }
__host__ __device__ __forceinline__ int perm32(int rho) { const int n = rho >> 4, i = rho & 15; return 8 * (i >> 2) + 4 * n + (i & 3); }

struct Unit { const char* a; const char* b; const int* rows; int pm, pn, aux, nv; };

__device__ __forceinline__ unsigned cvt_pk_bf16(float lo, float hi) { unsigned r; asm volatile("v_cvt_pk_bf16_f32 %0, %1, %2" : "=v"(r) : "v"(lo), "v"(hi)); return r; }

template <class...> using void_tt = void;
template <class E, class = void> struct has_acc_init { static constexpr bool value = false; };
template <class E> struct has_acc_init<E, void_tt<decltype(&E::acc_init)>> { static constexpr bool value = true; };
template <class Epi, class Sched, bool ALIGN_EPI, bool GATHER = false, bool FP8 = false>
__device__ __forceinline__ void gemm_phase(G8_LAS unsigned char* lds, const int tid, const int ldaB, const int ldbB, const int K, const Sched& S, const Epi& E) {
    const int wid = __builtin_amdgcn_readfirstlane(tid >> 6), lane = tid & 63, wr = wid >> 2, wc = wid & 3, fr = lane & 15, fq = lane >> 4;
    const int nt = K / BK;
    unsigned voffA[2], voffB[2]; int Rr[2], Cc2[2];
#pragma unroll
    for (int i = 0; i < 2; ++i) { int R, C; stage_rc(tid * 16 + i * 8192, R, C); const int Rb = Epi::PERM ? ((R & ~31) + perm32(R & 31)) : R; Rr[i] = R; Cc2[i] = C * 2;
        voffA[i] = (unsigned)(R * ldaB + C * 2); voffB[i] = (unsigned)(Rb * ldbB + C * 2); }
    const size_t kstep = (size_t)(BK * 2);
    const size_t hstepA = (size_t)HALF * ldaB, hstepB = (size_t)HALF * ldbB;
    const unsigned ldsw = (unsigned)wid * 1024u;
    const G8_LAS unsigned char* abase = lds + (FP8 ? lds_byte(wr * 64 + fr, fq * 16) : lds_byte(wr * 64 + fr, fq * 8));
    const G8_LAS unsigned char* bbase = lds + 4 * HTB + (FP8 ? lds_byte(wc * 32 + fr, fq * 16) : lds_byte(wc * 32 + fr, fq * 8));
#define G8_SA(b, h) (((b) * 2 + (h)) * HTB)
#define G8_SB(b, h) ((4 + (b) * 2 + (h)) * HTB)
#define G8_STAGE(bufoff, gbase, voff) do { _Pragma("unroll") for (int _i = 0; _i < 2; ++_i) \
        __builtin_amdgcn_global_load_lds((const unsigned*)((const char*)(gbase) + (voff)[_i]), (G8_LAS unsigned*)(lds + (bufoff) + ldsw + _i * 8192), 16, 0, 0); } while (0)
#define G8_STAGE_A(bufoff, h, base, nx) do { if constexpr (GATHER) { unsigned vo_[2] = {(nx) ? gvN[h][0] : gvC[h][0], (nx) ? gvN[h][1] : gvC[h][1]}; G8_STAGE(bufoff, base, vo_); } else { G8_STAGE(bufoff, (base) + ((h) ? hstepA : 0), voffA); } } while (0)
#define G8_LDA(dst, b, h) do { if constexpr (FP8) { _Pragma("unroll") for (int m = 0; m < 4; ++m) dst##8[m] = *(const G8_LAS i32x8*)(abase + (G8_SA(b, h) + m * 2048)); } \
      else { _Pragma("unroll") for (int m = 0; m < 4; ++m) _Pragma("unroll") for (int k = 0; k < 2; ++k) dst[m][k] = *(const G8_LAS bf16x8*)(abase + (G8_SA(b, h) + m * 2048 + k * 1024)); } } while (0)
#define G8_LDB(dst, b, h) do { if constexpr (FP8) { _Pragma("unroll") for (int n = 0; n < 2; ++n) dst##8[n] = *(const G8_LAS i32x8*)(bbase + (((b) * 2 + (h)) * HTB + n * 2048)); } \
      else { _Pragma("unroll") for (int n = 0; n < 2; ++n) _Pragma("unroll") for (int k = 0; k < 2; ++k) dst[n][k] = *(const G8_LAS bf16x8*)(bbase + (((b) * 2 + (h)) * HTB + n * 2048 + k * 1024)); } } while (0)
#define G8_MMA(ai, bj, At, Bt) do { __builtin_amdgcn_s_setprio(1); if constexpr (FP8) { _Pragma("unroll") for (int m = 0; m < 4; ++m) _Pragma("unroll") for (int n = 0; n < 2; ++n) \
        asm volatile("v_mfma_scale_f32_16x16x128_f8f6f4 %0, %1, %2, %0, %3, %3 op_sel_hi:[0,0,0]" : "+v"(acc[ai][bj][m][n]) : "v"(Bt##8[n]), "v"(At##8[m]), "v"(sc1f8)); } \
      else { _Pragma("unroll") for (int m = 0; m < 4; ++m) _Pragma("unroll") for (int n = 0; n < 2; ++n) _Pragma("unroll") for (int k = 0; k < 2; ++k) \
        acc[ai][bj][m][n] = __builtin_amdgcn_mfma_f32_16x16x32_bf16(Bt[n][k], At[m][k], acc[ai][bj][m][n], 0, 0, 0); } __builtin_amdgcn_s_setprio(0); } while (0)
#define G8_WAIT_V(n) asm volatile("s_waitcnt vmcnt(" #n ")" ::: "memory")
#define G8_WAIT_L(n) asm volatile("s_waitcnt lgkmcnt(" #n ")" ::: "memory")
#define G8_BAR __builtin_amdgcn_s_barrier()
#define G8_SCHED __builtin_amdgcn_sched_barrier(0)
    Unit cur, nxt; int ui = 0;
    if (!S.next(0, cur)) return;
    f32x4 acc[2][2][4][2];
#pragma unroll
    for (int a = 0; a < 2; ++a)
#pragma unroll
        for (int b = 0; b < 2; ++b)
#pragma unroll
            for (int m = 0; m < 4; ++m)
#pragma unroll
                for (int n = 0; n < 2; ++n) acc[a][b][m][n] = (f32x4){0.f, 0.f, 0.f, 0.f};
    if constexpr (has_acc_init<Epi>::value) E.acc_init(acc, cur, wr, wc, fr, fq);
    bf16x8 At[4][2], B0[2][2], B1[2][2]; i32x8 At8[4], B08[2], B18[2];
    int sc1f8 = 0x7F7F7F7F; if constexpr (FP8) asm volatile("" : "+v"(sc1f8));
    const char* cA = cur.a; const char* cB = cur.b;
    S.a_ready(cur, tid);
    unsigned gvC[2][2], gvN[2][2];
    if constexpr (GATHER) {
#pragma unroll
        for (int h = 0; h < 2; ++h)
#pragma unroll
            for (int i = 0; i < 2; ++i) { gvC[h][i] = (h * 128 + Rr[i] < cur.nv ? (unsigned)cur.rows[h * 128 + Rr[i]] : 0u) * (unsigned)ldaB + (unsigned)Cc2[i]; gvN[h][i] = gvC[h][i]; } }
    G8_STAGE(G8_SB(0, 0), cB, voffB); G8_STAGE(G8_SB(0, 1), cB + hstepB, voffB); G8_STAGE_A(G8_SA(0, 0), 0, cA, false); G8_STAGE_A(G8_SA(0, 1), 1, cA, false);
    if (wr == 1) G8_BAR;
    G8_WAIT_V(2); G8_BAR;
    G8_STAGE(G8_SB(1, 0), cB + kstep, voffB); G8_STAGE_A(G8_SA(1, 0), 0, cA + kstep, false); G8_STAGE(G8_SB(1, 1), cB + hstepB + kstep, voffB);
    G8_WAIT_V(6); G8_BAR;
#pragma unroll 1
    for (;;) {
        const bool has_next = S.next(ui + 1, nxt);
        const char* nA = has_next ? nxt.a : cA; const char* nB = has_next ? nxt.b : cB;
        if constexpr (GATHER) { if (has_next) {
#pragma unroll
            for (int h = 0; h < 2; ++h)
#pragma unroll
                for (int i = 0; i < 2; ++i) gvN[h][i] = (h * 128 + Rr[i] < nxt.nv ? (unsigned)nxt.rows[h * 128 + Rr[i]] : 0u) * (unsigned)ldaB + (unsigned)Cc2[i]; } }
#pragma unroll 1
        for (int t = 0; t < nt; t += 2) {
            const bool last = (t == nt - 2);
            if (last && has_next) S.a_ready(nxt, tid);
            const char* a1 = cA + (size_t)(t + 1) * kstep;
            const char* a2 = last ? nA : cA + (size_t)(t + 2) * kstep; const char* b2 = last ? nB : cB + (size_t)(t + 2) * kstep;
            const char* a3 = a2 + kstep; const char* b3 = b2 + kstep;
            G8_LDB(B0, 0, 0); G8_LDB(B1, 0, 1); G8_SCHED; G8_LDA(At, 0, 0); G8_STAGE_A(G8_SA(1, 1), 1, a1, false);
            G8_WAIT_V(8); G8_WAIT_L(0); G8_BAR; G8_MMA(0, 0, At, B0); G8_MMA(0, 1, At, B1); G8_BAR; G8_SCHED;
            G8_LDA(At, 0, 1); G8_STAGE(G8_SB(0, 0), b2, voffB); G8_STAGE(G8_SB(0, 1), b2 + hstepB, voffB); G8_STAGE_A(G8_SA(0, 0), 0, a2, last);
            G8_WAIT_V(8); G8_WAIT_L(0); G8_BAR; G8_MMA(1, 0, At, B0); G8_MMA(1, 1, At, B1); G8_BAR; G8_SCHED;
            G8_LDB(B0, 1, 0); G8_LDB(B1, 1, 1); G8_SCHED; G8_LDA(At, 1, 0); G8_STAGE_A(G8_SA(0, 1), 1, a2, last);
            G8_WAIT_V(8); G8_WAIT_L(0); G8_BAR; G8_MMA(0, 0, At, B0); G8_MMA(0, 1, At, B1); G8_BAR; G8_SCHED;
            G8_LDA(At, 1, 1); G8_STAGE(G8_SB(1, 0), b3, voffB); G8_STAGE(G8_SB(1, 1), b3 + hstepB, voffB); G8_STAGE_A(G8_SA(1, 0), 0, a3, last);
            G8_WAIT_V(8); G8_WAIT_L(0); G8_BAR; G8_MMA(1, 0, At, B0); G8_MMA(1, 1, At, B1); G8_BAR; G8_SCHED;
        }
        if constexpr (FP8) asm volatile("s_nop 15\n\ts_nop 7" ::: "memory");
        if constexpr (ALIGN_EPI) { if (wr == 0) G8_BAR; }
        E(acc, cur, wr, wc, fr, fq);
        if (!has_next) break;
#pragma unroll
        for (int a = 0; a < 2; ++a)
#pragma unroll
            for (int b = 0; b < 2; ++b)
#pragma unroll
                for (int m = 0; m < 4; ++m)
#pragma unroll
                    for (int n = 0; n < 2; ++n) acc[a][b][m][n] = (f32x4){0.f, 0.f, 0.f, 0.f};
        if constexpr (has_acc_init<Epi>::value) E.acc_init(acc, nxt, wr, wc, fr, fq);
        cur = nxt; cA = nA; cB = nB; ++ui;
        if constexpr (GATHER) {
#pragma unroll
            for (int h = 0; h < 2; ++h)
#pragma unroll
                for (int i = 0; i < 2; ++i) gvC[h][i] = gvN[h][i]; }
        if constexpr (ALIGN_EPI) { if (wr == 1) G8_BAR; }
    }
    G8_WAIT_V(0);
    if constexpr (!ALIGN_EPI) { if (wr == 0) G8_BAR; }
    G8_BAR;
#undef G8_SA
#undef G8_SB
#undef G8_STAGE
#undef G8_STAGE_A
#undef G8_LDA
#undef G8_LDB
#undef G8_MMA
#undef G8_WAIT_V
#undef G8_WAIT_L
#undef G8_BAR
#undef G8_SCHED
}
}
namespace mk {
using namespace g8;
constexpr int NB = 8, NCTX = 256, NLAT = 2048, NTOK = NCTX + NLAT, T = NB * NTOK, D = 1024, L = 4, NE = 32;
constexpr int NWAVES = 8, NTHR = 512;
constexpr float EPS = 1e-6f;
constexpr int NROWT = T / 256;
constexpr int ZBW = 2304, ZB_AU = 0, ZB_AV = 256, ZB_MQ = 512, ZB_CB = 768, ZB_CC = 1024, ZB_CX = 1280, ZB_GQ = 1536, ZB_GK = 1792, ZB_GV = 1920, ZB_MKV = 2048, ZB_KPE = 2176;
constexpr int DIN = 2208;
constexpr int RING_BYTES = 131072, MISC_OFF = 153600, XSCR_OFF = MISC_OFF + 1024, LDS_BYTES = 163840 - 4096;
constexpr size_t MiB = 1u << 20;
constexpr size_t al(size_t x) { return (x + 255) / 256 * 256; }
constexpr size_t WS_CTL = 0, CTL_BYTES = 1 * MiB;
constexpr size_t WS_MOD = WS_CTL + CTL_BYTES, SZ_MOD = al((size_t)L * 9 * 6 * D * 4);
constexpr size_t WS_WIN = WS_MOD + SZ_MOD, SZ_WIN1 = (size_t)ZBW * D * 2;
constexpr size_t WS_WG = WS_WIN + L * SZ_WIN1, SZ_WG1 = (size_t)4096 * D * 2;
constexpr size_t WS_WB = WS_WG + L * SZ_WG1, SZ_WB1 = (size_t)4 * 1024 * 256 * 2;
constexpr size_t WS_WOUT = WS_WB + L * SZ_WB1, SZ_WOUT1 = (size_t)D * D * 2;
constexpr size_t WS_WUQ = WS_WOUT + L * SZ_WOUT1, SZ_WUQ1 = (size_t)512 * 256 * 2;
constexpr size_t WS_WUKV = WS_WUQ + L * SZ_WUQ1, SZ_WUKV1 = (size_t)512 * 256 * 2;
constexpr size_t WS_WSGU = WS_WUKV + L * SZ_WUKV1, SZ_WSGU1 = (size_t)4 * 128 * 128 * 2;
constexpr size_t WS_WGU = WS_WSGU + L * SZ_WSGU1, SZ_WGU1 = (size_t)NE * 512 * D * 2;
constexpr size_t WS_WDN = WS_WGU + L * SZ_WGU1, SZ_WDN1 = (size_t)NE * D * 256 * 2;
constexpr size_t WS_WG8 = WS_WDN + L * SZ_WDN1, SZ_WG81 = (size_t)4096 * D;
constexpr size_t WS_HS = WS_WG8 + L * SZ_WG81, SZ_HS = (size_t)T * D * 2;
constexpr size_t WS_HN = WS_HS + SZ_HS, SZ_HN = (size_t)T * D * 2;
constexpr size_t WS_HN8 = WS_HN + SZ_HN, SZ_HN8 = (size_t)T * D;
constexpr size_t WS_RSS = WS_HN8 + SZ_HN8, SZ_RSS = (size_t)T * 2 * 4 * 4;
constexpr size_t WS_ARENA = WS_RSS + SZ_RSS;

#define GAS __attribute__((address_space(1)))
#define LAS __attribute__((address_space(3)))
typedef unsigned short bf16;
typedef unsigned v4u __attribute__((ext_vector_type(4)));
typedef unsigned v2u __attribute__((ext_vector_type(2)));
#define LDS_WAIT() asm volatile("s_waitcnt lgkmcnt(0)" ::: "memory")
#define VM_WAIT() asm volatile("s_waitcnt vmcnt(0)" ::: "memory")
__device__ __forceinline__ unsigned f2bf(float f) { unsigned u = __builtin_bit_cast(unsigned, f); return (u + 0x7fffu + ((u >> 16) & 1u)) >> 16; }
__device__ __forceinline__ unsigned pk2(float lo, float hi) { return f2bf(lo) | (f2bf(hi) << 16); }
__device__ __forceinline__ float bf2f(unsigned short h) { return __builtin_bit_cast(float, (unsigned)h << 16); }
__device__ __forceinline__ float bflo(unsigned w) { return __builtin_bit_cast(float, w << 16); }
__device__ __forceinline__ float bfhi(unsigned w) { return __builtin_bit_cast(float, w & 0xffff0000u); }
template <int CTRL> __device__ __forceinline__ float dppf(float v) { return __builtin_bit_cast(float, __builtin_amdgcn_update_dpp(0, __builtin_bit_cast(int, v), CTRL, 0xF, 0xF, true)); }
__device__ __forceinline__ unsigned opq(unsigned x) { asm volatile("" : "+v"(x)); return x; }
__device__ __forceinline__ float sum_x16(float v) { const unsigned a = __float_as_uint(v); auto rr = __builtin_amdgcn_permlane16_swap(a, opq(a), false, false); const unsigned r0 = rr[0], r1 = rr[1]; return __uint_as_float(r0) + __uint_as_float(r1); }
__device__ __forceinline__ float sum_x32(float v) { const unsigned a = __float_as_uint(v); auto rr = __builtin_amdgcn_permlane32_swap(a, opq(a), false, false); const unsigned r0 = rr[0], r1 = rr[1]; return __uint_as_float(r0) + __uint_as_float(r1); }
__device__ __forceinline__ float get_x16(float v, int lane) { const unsigned a = __float_as_uint(v); auto rr = __builtin_amdgcn_permlane16_swap(a, opq(a), false, false); const unsigned r0 = rr[0], r1 = rr[1]; return __uint_as_float((lane & 16) ? r0 : r1); }
__device__ __forceinline__ float get_x32(float v, int lane) { const unsigned a = __float_as_uint(v); auto rr = __builtin_amdgcn_permlane32_swap(a, opq(a), false, false); const unsigned r0 = rr[0], r1 = rr[1]; return __uint_as_float((lane & 32) ? r0 : r1); }
__device__ __forceinline__ float wave_sum(float v) {
  v += dppf<0xB1>(v);
  v += dppf<0x4E>(v);
  v += dppf<0x141>(v);
  v += dppf<0x140>(v);
  v = sum_x16(v);
  return sum_x32(v);
}
__device__ __forceinline__ float siluf(float x) { return x / (1.f + __expf(-x)); }
__device__ __forceinline__ float sigmoidf(float x) { return 1.f / (1.f + __expf(-x)); }
__device__ __forceinline__ float gelu_tanh(float x) { const float u = 0.7978845608028654f * (x + 0.044715f * x * x * x); const float e = __expf(2.f * u); return x - x * __builtin_amdgcn_rcpf(e + 1.f); }

#define XB_TMO      128
#define XB_XCNT(j)  (256  + 64 * (j))
#define XB_XSUB(j)  (1280 + 64 * (j))
#define XB_XGEN(j)  (2304 + 64 * (j))
#define XB_TOP      3328
#define XB_TOPGEN   3392
#define XCD_BAR_WORDS 3456
#define XB_SPIN_CAP (1u << 18)
__device__ __forceinline__ unsigned xb_ld(unsigned* p)              { return __hip_atomic_load(p, __ATOMIC_RELAXED, __HIP_MEMORY_SCOPE_AGENT); }
__device__ __forceinline__ unsigned xb_add(unsigned* p, unsigned v) { return __hip_atomic_fetch_add(p, v, __ATOMIC_RELAXED, __HIP_MEMORY_SCOPE_AGENT); }
__device__ __forceinline__ unsigned xb_xcc_id() { return (unsigned)__builtin_amdgcn_s_getreg((3 << 11) | 20) & 0xFu; }
#define XB_SPIN(cond, bar) do { unsigned _sp = 0; while (cond) { __builtin_amdgcn_s_sleep(1); \
    if ((++_sp & 255u) == 0u) { if (xb_ld(&(bar)[XB_TMO])) break; if (_sp > XB_SPIN_CAP) { atomicAdd(&(bar)[XB_TMO], 1u); break; } } } } while (0)
struct XcdBarrier { unsigned* bar; unsigned x; volatile LAS unsigned* st; };
__device__ __forceinline__ XcdBarrier xcd_barrier_post(unsigned* bar, volatile LAS unsigned* st, const bool leader) {
    XcdBarrier b; b.bar = bar; b.x = xb_xcc_id(); b.st = st;
    if (leader) (void)xb_add(&bar[XB_XCNT(b.x)], 1u);
    return b;
}
__device__ __forceinline__ void xcd_barrier_complete(unsigned* bar, unsigned x, unsigned& nloc, unsigned& nx) {
    const unsigned G = gridDim.x * gridDim.y * gridDim.z;
    unsigned sum, cnt, mine, sp = 0u;
    for (;;) {
        sum = 0u; cnt = 0u; mine = 0u;
#pragma unroll
        for (unsigned j = 0; j < 16; ++j) { const unsigned c = xb_ld(&bar[XB_XCNT(j)]); sum += c; cnt += (c > 0u) ? 1u : 0u; mine = (j == x) ? c : mine; }
        if (sum == G) break;
        __builtin_amdgcn_s_sleep(1);
        if ((++sp & 255u) == 0u) { if (xb_ld(&bar[XB_TMO])) break; if (sp > XB_SPIN_CAP) { atomicAdd(&bar[XB_TMO], 1u); break; } }
    }
    nloc = mine > 0u ? mine : 1u; nx = cnt > 0u ? cnt : 1u;
}
__device__ __forceinline__ void xcd_barrier(const XcdBarrier& b, const bool leader) {
    asm volatile("s_waitcnt vmcnt(0)" ::: "memory");
    __syncthreads();
    if (leader) {
        unsigned* bar = b.bar;
        __builtin_amdgcn_s_waitcnt(0);
        unsigned nloc = b.st[0], nx = b.st[1];
        if (nloc == 0u) { xcd_barrier_complete(bar, b.x, nloc, nx); b.st[0] = nloc; b.st[1] = nx; }
        const unsigned old = xb_add(&bar[XB_XSUB(b.x)], 1u);
        const unsigned gen = old / nloc;
        if (old + 1u == (gen + 1u) * nloc) {
            __builtin_amdgcn_fence(__ATOMIC_RELEASE, "agent");
            asm volatile("s_waitcnt vmcnt(0)" ::: "memory");
            const unsigned og = xb_add(&bar[XB_TOP], 1u);
            const unsigned tg = og / nx;
            if (og + 1u == (tg + 1u) * nx) xb_add(&bar[XB_TOPGEN], 1u);
            else XB_SPIN(xb_ld(&bar[XB_TOPGEN]) == tg, bar);
            __builtin_amdgcn_fence(__ATOMIC_ACQUIRE, "agent");
            xb_add(&bar[XB_XGEN(b.x)], 1u);
            asm volatile("s_waitcnt vmcnt(0)" ::: "memory");
        } else {
            XB_SPIN(xb_ld(&bar[XB_XGEN(b.x)]) == gen, bar);
            __builtin_amdgcn_fence(__ATOMIC_ACQUIRE, "agent");
            asm volatile("s_waitcnt vmcnt(0)" ::: "memory");
        }
    }
    __syncthreads();
}

struct Args { const float* in[28]; float* out; unsigned char* ws; int phase, layer, flag, pad; };
struct Ctx {
  LAS unsigned char* lds; unsigned char* ws; int tid, lane, wave, vcu, G;
};

__device__ __forceinline__ void refresh_ctx(Ctx& F, const Args& A) {
  unsigned char* w_ = A.ws; asm volatile("" : "+s"(w_)); F.ws = w_;
  int wv_ = F.wave; asm volatile("" : "+s"(wv_)); F.wave = wv_; unsigned z_ = 0u; asm volatile("" : "+v"(z_)); const int l_ = (int)__builtin_amdgcn_mbcnt_hi(~0u, __builtin_amdgcn_mbcnt_lo(~0u, z_)); F.lane = l_; F.tid = wv_ * 64 + l_;
}
struct TileOrder {
  int nM, nN, nwg, G, c, skip, wgm;
  __device__ void init(int nM_, int nN_, int G_, int c_, int skip_ = 0, int wgm_ = 8) { nM = nM_; nN = nN_; nwg = nM * nN; G = G_; c = c_; skip = skip_; wgm = wgm_; }
  __device__ __forceinline__ bool tile(int i, int& pm, int& pn) const {
    const long Lx = (long)i * G + c; if (Lx >= nwg) return false;
    int wgid = (int)Lx; { const int q = nwg / 8, r = nwg % 8, xcd = wgid % 8, off = wgid / 8; wgid = (xcd < r ? xcd * (q + 1) : r * (q + 1) + (xcd - r) * q) + off; }
    const int WGM = wgm; const int nig = WGM * nN, gid = wgid / nig, fm = gid * WGM, gsz = (nM - fm) < WGM ? (nM - fm) : WGM;
    pm = fm + ((wgid % nig) % gsz); pn = (wgid % nig) / gsz; if (skip) pm += pm / 8 + 1; return true;
  }
};
struct PlainSched {
  TileOrder o; const char* A; const char* B; size_t aTile, bTile;
  __device__ __forceinline__ bool next(int i, Unit& u) const { int pm, pn; if (!o.tile(i, pm, pn)) return false; u.pm = pm; u.pn = pn; u.aux = 0; u.a = A + (size_t)pm * aTile; u.b = B + (size_t)pn * bTile; return true; }
  __device__ __forceinline__ void a_ready(const Unit&, int) const {}
};
constexpr int STG_PITCH = 528;
template <bool SC1> __device__ __forceinline__ void store_tile_rows(const f32x4 (&acc)[2][2][4][2], LAS unsigned char* stg, bf16* O, int obytes, int ldc, int row_base, int col_base, int wr, int wc, int fr, int fq) {
  const int tid = (wr * 4 + wc) * 64 + fq * 16 + fr;
  const __amdgpu_buffer_rsrc_t rs = __builtin_amdgcn_make_buffer_rsrc(O, 0, obytes, 0x00020000);
  LAS unsigned char* wp = stg + (wr * 16 + fr) * STG_PITCH + (wc * 32 + fq * 8) * 2; const LAS unsigned char* rp = stg + (tid >> 5) * STG_PITCH + (tid & 31) * 16;
#pragma unroll
  for (int ai = 0; ai < 2; ++ai)
#pragma unroll
    for (int m = 0; m < 4; ++m) {
#pragma unroll
      for (int bj = 0; bj < 2; ++bj) { const f32x4 v0 = acc[ai][bj][m][0], v1 = acc[ai][bj][m][1];
        v4u w; w.x = cvt_pk_bf16(v0[0], v0[1]); w.y = cvt_pk_bf16(v0[2], v0[3]); w.z = cvt_pk_bf16(v1[0], v1[1]); w.w = cvt_pk_bf16(v1[2], v1[3]);
        *(LAS v4u*)(wp + bj * 256) = w; }
      asm volatile("s_waitcnt lgkmcnt(0)" ::: "memory"); __builtin_amdgcn_s_barrier(); asm volatile("" ::: "memory");
#pragma unroll
      for (int ps = 0; ps < 2; ++ps) { const int rl = ps * 16 + (tid >> 5); const v4u w = *(const LAS v4u*)(rp + ps * 16 * STG_PITCH);
        const int off = ((row_base + ai * 128 + (rl >> 4) * 64 + m * 16 + (rl & 15)) * ldc + col_base + (tid & 31) * 8) * 2;
        __builtin_amdgcn_raw_buffer_store_b128(w, rs, off, 0, SC1 ? 16 : 0); }
      asm volatile("s_waitcnt lgkmcnt(0)" ::: "memory"); __builtin_amdgcn_s_barrier(); asm volatile("" ::: "memory"); }
}
struct EpiStoreBf16 {
  static constexpr bool PERM = true;
  bf16* O; int ldc; int obytes; LAS unsigned char* stg;
  __device__ __forceinline__ void operator()(const f32x4 (&acc)[2][2][4][2], const Unit& u, int wr, int wc, int fr, int fq) const {
    store_tile_rows<false>(acc, stg, O, obytes, ldc, u.pm * 256, u.pn * 256, wr, wc, fr, fq);
  }
};

__device__ __forceinline__ int zmap(int n) {
  if (n < 768) return n;
  if (n < 896) return ZB_MKV + (n - 768);
  if (n < 928) return ZB_KPE + (n - 896);
  if (n < 1184) return ZB_CB + (n - 928);
  if (n < 1440) return ZB_CC + (n - 1184);
  if (n < 1696) return ZB_CX + (n - 1440);
  if (n < 1952) return ZB_GQ + (n - 1696);
  if (n < 2080) return ZB_GK + (n - 1952);
  return ZB_GV + (n - 2080);
}
__device__ __forceinline__ int gmap(int i, int c) { const int jp = c >> 6, cl = c & 63, wc = cl >> 4, h = (cl >> 3) & 1, n = (cl >> 2) & 1, e = cl & 3, bj = i >> 1, fq = 2 * h + (i & 1); return 256 * jp + 128 * bj + 32 * wc + 16 * n + 4 * fq + e; }
__device__ __forceinline__ int uqmap(int n) { const int h = n / 96, dd = n % 96; if (dd < 64) return 64 * h + dd; const int d = dd - 64; return 256 + 32 * h + 8 * ((d >> 2) & 3) + 4 * (d >> 4) + (d & 3); }
__device__ __forceinline__ int gumap(int n) { const int up = n >> 8, j = n & 255; return 256 * (j >> 7) + 128 * up + (j & 127); }

struct PrepItem { const float* W; bf16* dst; const float* kscale; int ldw, N, ldd, k0, n0, mt, mp; };
__device__ __forceinline__ int prep_map(int mt, int mp, int n) { return mt == 0 ? n : mt == 1 ? zmap(n) : mt == 2 ? gmap(mp, n) : mt == 3 ? uqmap(n) : gumap(n); }
__device__ __forceinline__ PrepItem prep_decode(const Args& A, unsigned char* ws, int it) {
  constexpr int I_IN = 16 * 9, I_G = 4 * 16 * 4, I_B = 4 * 4 * 4, I_O = 16 * 4, I_UQ = 4 * 2, I_UKV = 2 * 2, I_GU = NE * 16 * 2, I_DN = NE * 4 * 4;
  constexpr int I_L = I_IN + I_G + I_B + I_O + I_UQ + I_UKV + I_GU + I_DN;
  PrepItem p; const int l = it / I_L; int r = it % I_L; p.kscale = nullptr; p.mt = 0; p.mp = 0;
  if (r < I_IN) { const int kb = r / 9, nb = r % 9; p.W = A.in[6] + (size_t)l * D * DIN; p.ldw = DIN; p.N = DIN; p.dst = (bf16*)(ws + WS_WIN + l * SZ_WIN1); p.ldd = D; p.k0 = kb * 64; p.n0 = nb * 256; p.mt = 1; return p; } r -= I_IN;
  if (r < I_G) { const int i = r / 64, rr = r % 64, kb = rr / 4, nb = rr % 4; p.W = A.in[17] + ((size_t)l * 4 + i) * D * D; p.ldw = D; p.N = D; p.dst = (bf16*)(ws + WS_WG8 + l * SZ_WG81); p.ldd = D; p.k0 = kb * 64; p.n0 = nb * 256; p.mt = 2; p.mp = i; return p; } r -= I_G;
  if (r < I_B) { const int i = r / 16, rr = r % 16, kb = rr / 4, nb = rr % 4; p.W = A.in[19] + ((size_t)l * 4 + i) * 256 * D; p.ldw = D; p.N = D; p.dst = (bf16*)(ws + WS_WB + l * SZ_WB1) + (size_t)i * 1024 * 256; p.ldd = 256; p.k0 = kb * 64; p.n0 = nb * 256; return p; } r -= I_B;
  if (r < I_O) { const int kb = r / 4, nb = r % 4; p.W = A.in[20] + (size_t)l * D * D; p.ldw = D; p.N = D; p.dst = (bf16*)(ws + WS_WOUT + l * SZ_WOUT1); p.ldd = D; p.k0 = kb * 64; p.n0 = nb * 256; return p; } r -= I_O;
  if (r < I_UQ) { const int kb = r / 2, nb = r % 2; p.W = A.in[11] + (size_t)l * 256 * 384; p.ldw = 384; p.N = 384; p.dst = (bf16*)(ws + WS_WUQ + l * SZ_WUQ1); p.ldd = 256; p.kscale = A.in[10] + l * 256; p.k0 = kb * 64; p.n0 = nb * 256; p.mt = 3; return p; } r -= I_UQ;
  if (r < I_UKV) { const int kb = r / 2, nb = r % 2; p.W = A.in[13] + (size_t)l * 128 * 512; p.ldw = 512; p.N = 512; p.dst = (bf16*)(ws + WS_WUKV + l * SZ_WUKV1); p.ldd = 256; p.kscale = A.in[12] + l * 128; p.k0 = kb * 64; p.n0 = nb * 256; return p; } r -= I_UKV;
  if (r < I_GU) { const int e = r / 32, rr = r % 32, kb = rr / 2, nb = rr % 2; p.W = A.in[25] + ((size_t)l * NE + e) * D * 512; p.ldw = 512; p.N = 512; p.dst = (bf16*)(ws + WS_WGU + l * SZ_WGU1) + (size_t)e * 512 * D; p.ldd = D; p.k0 = kb * 64; p.n0 = nb * 256; p.mt = 4; return p; } r -= I_GU;
  { const int e = r / 16, rr = r % 16, kb = rr / 4, nb = rr % 4; p.W = A.in[26] + ((size_t)l * NE + e) * 256 * D; p.ldw = D; p.N = D; p.dst = (bf16*)(ws + WS_WDN + l * SZ_WDN1) + (size_t)e * D * 256; p.ldd = 256; p.k0 = kb * 64; p.n0 = nb * 256; return p; }
}
__device__ __forceinline__ void prep_load(const PrepItem& p, int tid, float4 (&v)[8]) {
#pragma unroll
  for (int i = 0; i < 8; ++i) { const int idx = tid + i * NTHR, kk = idx >> 6, c4 = (idx & 63) * 4; v[i] = make_float4(0.f, 0.f, 0.f, 0.f);
    if (p.n0 + c4 < p.N) v[i] = *(const float4*)(p.W + (size_t)(p.k0 + kk) * p.ldw + p.n0 + c4); }
}
__device__ __forceinline__ void phase_prep(Ctx& F, const Args& A) {
  const int lane = F.lane;
  const float* w_sgu = A.in[8];
  { const float* c = A.in[1]; const float* c_ctx = A.in[3]; const float* w_ada = A.in[4]; const float* b_ada = A.in[5]; float* mod = (float*)(F.ws + WS_MOD);
    LAS float* sil = (LAS float*)F.lds; LAS float* red = sil + 9 * D;
    if (F.vcu < L * 96) {
      for (int i = F.tid; i < 9 * D; i += NTHR) { const int r = i / D, k = i % D; sil[i] = siluf(r < 8 ? c[r * D + k] : c_ctx[k]); }
      __syncthreads();
      for (int it = F.vcu; it < L * 96; it += F.G) { const int l = it / 96, n = (it % 96) * 64 + lane; float acc[9];
#pragma unroll
        for (int r = 0; r < 9; ++r) acc[r] = 0.f;
        const float* w = w_ada + (size_t)l * D * 6 * D + n;
#pragma unroll 8
        for (int kk = 0; kk < 128; ++kk) { const int k = F.wave * 128 + kk; const float wv = w[(size_t)k * 6 * D];
#pragma unroll
          for (int r = 0; r < 9; ++r) acc[r] += sil[r * D + k] * wv; }
        __syncthreads();
#pragma unroll
        for (int r = 0; r < 9; ++r) red[(F.wave * 9 + r) * 64 + lane] = acc[r];
        __syncthreads();
        if (F.wave == 0) { const float bv = b_ada[l * 6 * D + n];
#pragma unroll
          for (int r = 0; r < 9; ++r) { float s = 0.f;
#pragma unroll
            for (int w8 = 0; w8 < 8; ++w8) s += red[(w8 * 9 + r) * 64 + lane];
            mod[((size_t)l * 9 + r) * 6 * D + n] = s + bv; } }
      }
      __syncthreads(); } }
  constexpr int I_LT = 16 * 9 + 4 * 16 * 4 + 4 * 4 * 4 + 16 * 4 + 4 * 2 + 2 * 2 + NE * 16 * 2 + NE * 4 * 4;
  { LAS float* scr = (LAS float*)F.lds; const int tid = F.tid;
    int it = F.vcu; float4 v[8]; PrepItem cur;
    if (it < L * I_LT) { cur = prep_decode(A, F.ws, it); prep_load(cur, tid, v); }
    while (it < L * I_LT) {
#pragma unroll
      for (int i = 0; i < 8; ++i) { const int idx = tid + i * NTHR, kk = idx >> 6, c4 = (idx & 63) * 4; float4 x = v[i];
        if (cur.kscale) { const float s = cur.kscale[cur.k0 + kk]; x.x *= s; x.y *= s; x.z *= s; x.w *= s; }
        *(LAS f32x4*)(scr + kk * 260 + c4) = (f32x4){x.x, x.y, x.z, x.w}; }
      const int nit = it + F.G; PrepItem nxt = cur;
      if (nit < L * I_LT) { nxt = prep_decode(A, F.ws, nit); prep_load(nxt, tid, v); }
      __syncthreads();
#pragma unroll
      for (int i = 0; i < 4; ++i) { const int idx = tid + i * NTHR, n = idx & 255, c = idx >> 8; const LAS float* s = scr + (8 * c) * 260 + n;
        if (cur.n0 + n < cur.N) {
          if (cur.mt == 2) { int w0 = 0, w1 = 0;
            w0 = __builtin_amdgcn_cvt_pk_fp8_f32(32.f * s[0 * 260], 32.f * s[1 * 260], w0, false); w0 = __builtin_amdgcn_cvt_pk_fp8_f32(32.f * s[2 * 260], 32.f * s[3 * 260], w0, true);
            w1 = __builtin_amdgcn_cvt_pk_fp8_f32(32.f * s[4 * 260], 32.f * s[5 * 260], w1, false); w1 = __builtin_amdgcn_cvt_pk_fp8_f32(32.f * s[6 * 260], 32.f * s[7 * 260], w1, true);
            v2u o; o.x = (unsigned)w0; o.y = (unsigned)w1; *(v2u*)((unsigned char*)cur.dst + (size_t)prep_map(cur.mt, cur.mp, cur.n0 + n) * cur.ldd + cur.k0 + 8 * c) = o; }
          else { v4u o; o.x = pk2(s[0 * 260], s[1 * 260]); o.y = pk2(s[2 * 260], s[3 * 260]); o.z = pk2(s[4 * 260], s[5 * 260]); o.w = pk2(s[6 * 260], s[7 * 260]);
            *(v4u*)(cur.dst + (size_t)prep_map(cur.mt, cur.mp, cur.n0 + n) * cur.ldd + cur.k0 + 8 * c) = o; } } }
      __syncthreads();
      cur = nxt; it = nit;
    }
  }
  const size_t gt = (size_t)F.vcu * NTHR + F.tid, NGT = (size_t)F.G * NTHR;
  for (int l = 0; l < L; ++l) {
    v4u z4 = {0u, 0u, 0u, 0u};
    { v4u* p = (v4u*)(F.ws + WS_WIN + l * SZ_WIN1 + (size_t)DIN * D * 2); for (size_t i = gt; i < (size_t)(ZBW - DIN) * D * 2 / 16; i += NGT) p[i] = z4; }
    { v4u* p = (v4u*)(F.ws + WS_WUQ + l * SZ_WUQ1 + (size_t)384 * 256 * 2); for (size_t i = gt; i < (size_t)128 * 256 * 2 / 16; i += NGT) p[i] = z4; }
    { for (size_t i = gt; i < (size_t)512 * 16; i += NGT) { const size_t row = i / 16, c = i % 16; *(v4u*)(F.ws + WS_WUKV + l * SZ_WUKV1 + row * 512 + 256 + c * 16) = z4; } }
    { const float* s = w_sgu + (size_t)l * 4 * 128 * 128; bf16* d = (bf16*)(F.ws + WS_WSGU + l * SZ_WSGU1); for (size_t i = gt; i < (size_t)4 * 128 * 128 / 2; i += NGT) ((unsigned*)d)[i] = pk2(s[2 * i], s[2 * i + 1]); }
  }
}
}
namespace mk {
constexpr int CW_CNT = 8192, CW_PANEL = 32768, CW_TILE = 65536, CW_BAR_TMO = 16384 + 128;
constexpr size_t SZ_ZB_BYTES = (size_t)T * ZBW * 2;
struct EpiZ {
  static constexpr bool PERM = true;
  bf16* O; float* rss; int mode; LAS unsigned char* stg;
  __device__ __forceinline__ void operator()(const f32x4 (&acc)[2][2][4][2], const Unit& u, int wr, int wc, int fr, int fq) const {
    if (mode) return;
    const int row0 = u.pm * 256 + wr * 64 + fr;
    store_tile_rows<false>(acc, stg, O, (int)SZ_ZB_BYTES, ZBW, u.pm * 256, u.pn * 256, wr, wc, fr, fq);
    if (u.pn == 2 || u.pn == 8) { const int which = u.pn == 2 ? 0 : 1;
#pragma unroll
      for (int ai = 0; ai < 2; ++ai)
#pragma unroll
        for (int m = 0; m < 4; ++m) { float s = 0.f;
#pragma unroll
          for (int n = 0; n < 2; ++n) { const f32x4 a0 = acc[ai][0][m][n]; s += a0[0] * a0[0] + a0[1] * a0[1] + a0[2] * a0[2] + a0[3] * a0[3];
            if (which == 0) { const f32x4 a1 = acc[ai][1][m][n]; s += a1[0] * a1[0] + a1[1] * a1[1] + a1[2] * a1[2] + a1[3] * a1[3]; } }
          s = sum_x16(s); s = sum_x32(s);
          if (fq == 0) rss[((size_t)(row0 + ai * 128 + m * 16) * 2 + which) * 4 + wc] = s; } }
  }
};
__device__ __forceinline__ void phase_zgemm(Ctx& F, const Args& A, int l, int mode = 0) {
  PlainSched S; S.o.init(NROWT, ZBW / 256, F.G, (int)blockIdx.x, 0, 9); S.A = (const char*)(F.ws + WS_HN); S.B = (const char*)(F.ws + WS_WIN + l * SZ_WIN1); S.aTile = (size_t)256 * D * 2; S.bTile = (size_t)256 * D * 2;
  EpiZ E{(bf16*)(F.ws + WS_ARENA), (float*)(F.ws + WS_RSS), mode, F.lds + RING_BYTES};
  gemm_phase<EpiZ, PlainSched, true>(F.lds, F.tid, D * 2, D * 2, D, S, E);
}
constexpr size_t WS_ZB = WS_ARENA, SZ_ZB = (size_t)T * ZBW * 2;
constexpr size_t WS_Y = WS_ZB + SZ_ZB, SZ_Y = (size_t)T * D * 2;
constexpr size_t WS_Z4 = WS_Y + SZ_Y, SZ_Z4 = (size_t)T * 4096 * 2;
constexpr size_t WS_MG = WS_Z4 + SZ_Z4, SZ_MG = (size_t)T * D * 2;
constexpr size_t WS_END1 = WS_MG + SZ_MG;
struct BranchSched {
  TileOrder o; const char* Y; const char* WB;
  __device__ __forceinline__ bool next(int i, Unit& u) const { int pm, pn; if (!o.tile(i, pm, pn)) return false; u.pm = pm; u.pn = pn; u.aux = 0; const int br = pn >> 2;
    u.a = Y + (size_t)pm * 256 * D * 2 + br * 512; u.b = WB + (size_t)br * 1024 * 512 + (size_t)(pn & 3) * 256 * 512; return true; }
  __device__ __forceinline__ void a_ready(const Unit&, int) const {}
};
constexpr int CW_BRC = 98304;
__device__ __forceinline__ bool wait_counter(const unsigned* cnt, unsigned need, unsigned* tmo, int tid) {
  if (tid < 64) { unsigned sp = 0;
    while ((unsigned)__builtin_amdgcn_readfirstlane((int)__hip_atomic_load(cnt, __ATOMIC_RELAXED, __HIP_MEMORY_SCOPE_AGENT)) < need) { __builtin_amdgcn_s_sleep(2);
      if ((++sp & 255u) == 0u) { if (__hip_atomic_load(tmo, __ATOMIC_RELAXED, __HIP_MEMORY_SCOPE_AGENT)) break; if (sp > (1u << 18)) { atomicAdd(tmo, 1u); break; } } }
    __builtin_amdgcn_fence(__ATOMIC_ACQUIRE, "agent");
    asm volatile("s_waitcnt vmcnt(0)" ::: "memory"); }
  asm volatile("" ::: "memory"); __builtin_amdgcn_s_barrier(); asm volatile("" ::: "memory"); return true;
}
struct BranchSched2 {
  int x, j; bool skip; const char* Y; const char* WB;
  __device__ __forceinline__ bool next(int i, Unit& u) const { int w;
    if (i < 4) w = 32 * i + j;
    else if (skip || j < 20) return false;
    else if (i == 4) w = j >= 28 ? 136 + 2 * (j - 28) : j >= 24 ? 128 + (j - 24) : 132 + (j - 20);
    else if (i == 5 && j >= 28) w = 137 + 2 * (j - 28); else return false;
    u.pn = w & 15; u.pm = 9 * x + (skip ? 1 : 0) + (w >> 4); u.aux = 0; u.rows = nullptr; const int br = u.pn >> 2;
    u.a = Y + (size_t)u.pm * 256 * D * 2 + br * 512; u.b = WB + (size_t)br * 1024 * 512 + (size_t)(u.pn & 3) * 256 * 512; return true; }
  __device__ __forceinline__ void a_ready(const Unit&, int) const {}
};
struct EpiZ4 {
  static constexpr bool PERM = true;
  bf16* O; unsigned* cnt; LAS unsigned char* stg;
  __device__ __forceinline__ void operator()(const f32x4 (&acc)[2][2][4][2], const Unit& u, int wr, int wc, int fr, int fq) const {
    store_tile_rows<true>(acc, stg, O, (int)SZ_Z4, 4096, u.pm * 256, u.pn * 256, wr, wc, fr, fq);
    if (cnt) { asm volatile("s_waitcnt vmcnt(0)" ::: "memory"); if (fr == 0 && fq == 0) __hip_atomic_fetch_add(cnt + (u.pm * 4 + (u.pn & 3)) * 64, 1u, __ATOMIC_RELAXED, __HIP_MEMORY_SCOPE_AGENT); }
  }
};
__device__ __forceinline__ void phase_branch(Ctx& F, const Args& A, int l, bool skipctx = false) {
  if (F.G == 256) { BranchSched2 S; S.x = (int)blockIdx.x & 7; S.j = (int)blockIdx.x >> 3; S.skip = skipctx; S.Y = (const char*)(F.ws + WS_Y); S.WB = (const char*)(F.ws + WS_WB + l * SZ_WB1);
    EpiZ4 E{(bf16*)(F.ws + WS_Z4), (unsigned*)(F.ws + WS_CTL) + CW_BRC + l * (72 * 4 * 64), F.lds + RING_BYTES};
    gemm_phase<EpiZ4, BranchSched2, true>(F.lds, F.tid, D * 2, 512, 256, S, E); return; }
  BranchSched S; S.o.init(skipctx ? NB * 8 : NROWT, 16, F.G, (int)blockIdx.x, skipctx ? 1 : 0, skipctx ? 8 : 9); S.Y = (const char*)(F.ws + WS_Y); S.WB = (const char*)(F.ws + WS_WB + l * SZ_WB1);
  EpiStoreBf16 E{(bf16*)(F.ws + WS_Z4), 4096, (int)SZ_Z4, F.lds + RING_BYTES};
  gemm_phase<EpiStoreBf16, BranchSched, true>(F.lds, F.tid, D * 2, 512, 256, S, E);
}
template <int MODE> struct EpiMergeT {
  static constexpr bool PERM = false;
  const bf16* Z4; const float* bg; bf16* M; unsigned* panel; LAS unsigned char* stg;
  static constexpr float L2E = 1.4426950408889634f;
  __device__ __forceinline__ void acc_init(f32x4 (&acc)[2][2][4][2], const Unit& u, int wr, int wc, int fr, int fq) const {
    const int pq = fq & 1, c0 = u.pn * 64 + wc * 16 + (fq >> 1) * 8;
#pragma unroll
    for (int bj = 0; bj < 2; ++bj)
#pragma unroll
      for (int n = 0; n < 2; ++n) { const f32x4 b32 = *(const f32x4*)(bg + (2 * bj + pq) * D + c0 + 4 * n) * 32.f;
#pragma unroll
        for (int ai = 0; ai < 2; ++ai)
#pragma unroll
          for (int m = 0; m < 4; ++m) acc[ai][bj][m][n] = b32; }
  }
  __device__ __forceinline__ void operator()(const f32x4 (&acc)[2][2][4][2], const Unit& u, int wr, int wc, int fr, int fq) const {
    const int pq = fq & 1, c0 = u.pn * 64 + wc * 16 + (fq >> 1) * 8;
    const GAS bf16* Zg = (const GAS bf16*)Z4 + pq * D + c0;
    const __amdgpu_buffer_rsrc_t rs = __builtin_amdgcn_make_buffer_rsrc(M, 0, (int)SZ_MG, 0x00020000);
    const int tid = (wr * 4 + wc) * 64 + fq * 16 + fr;
    v4u zz[2][4][2];
#pragma unroll
    for (int ai = 0; ai < 2; ++ai)
#pragma unroll
      for (int m = 0; m < 4; ++m) { const size_t r = (size_t)u.pm * 256 + ai * 128 + wr * 64 + m * 16 + fr;
#pragma unroll
        for (int bj = 0; bj < 2; ++bj) { if (MODE == 1) zz[ai][m][bj] = (v4u){0x3f803f80u + (unsigned)fr, 0x3f803f80u, 0x3f803f80u, 0x3f803f80u}; else zz[ai][m][bj] = *(const GAS v4u*)(Zg + r * 4096 + 2 * bj * D); } }
#pragma unroll
    for (int ai = 0; ai < 2; ++ai) {
#pragma unroll
      for (int m = 0; m < 4; ++m) { f32x2 sa = {0.f, 0.f}, sb = sa, sc = sa, sd = sa;
#pragma unroll
        for (int bj = 0; bj < 2; ++bj) { const v4u z2 = zz[ai][m][bj]; const f32x4 t0 = acc[ai][bj][m][0] * (L2E / 32.f), t1 = acc[ai][bj][m][1] * (L2E / 32.f);
#define SIG2(S, TA, TB, ZW) do { const f32x2 d_ = (f32x2){__builtin_amdgcn_exp2f(-(TA)), __builtin_amdgcn_exp2f(-(TB))} + 1.f; const f32x2 r_ = {__builtin_amdgcn_rcpf(d_[0]), __builtin_amdgcn_rcpf(d_[1])}; \
            S += (f32x2){bflo(ZW), bfhi(ZW)} * r_; } while (0)
          SIG2(sa, t0[0], t0[1], z2.x); SIG2(sb, t0[2], t0[3], z2.y); SIG2(sc, t1[0], t1[1], z2.z); SIG2(sd, t1[2], t1[3], z2.w);
#undef SIG2
        }
        const f32x4 s0 = {sa[0], sa[1], sb[0], sb[1]}, s1 = {sc[0], sc[1], sd[0], sd[1]};
        float t[4];
#pragma unroll
        for (int e = 0; e < 4; ++e) { const float lo = s0[e], hi = s1[e]; auto rr = __builtin_amdgcn_permlane16_swap(__float_as_uint(lo), __float_as_uint(hi), false, false); const unsigned r0 = rr[0], r1 = rr[1]; t[e] = __uint_as_float(r0) + __uint_as_float(r1); }
        v2u o2; o2.x = cvt_pk_bf16(t[0], t[1]); o2.y = cvt_pk_bf16(t[2], t[3]);
        *(LAS v2u*)(stg + (wr * 64 + m * 16 + fr) * 144 + (wc * 16 + (fq >> 1) * 8 + 4 * pq) * 2) = o2; }
      asm volatile("s_waitcnt lgkmcnt(0)" ::: "memory"); __builtin_amdgcn_s_barrier(); asm volatile("" ::: "memory");
#pragma unroll
      for (int ps = 0; ps < 2; ++ps) { const int row = ps * 64 + (tid >> 3), ch = tid & 7; const v4u w = *(const LAS v4u*)(stg + row * 144 + ch * 16);
        if (MODE != 2 || w.x == 0x12345678u) __builtin_amdgcn_raw_buffer_store_b128(w, rs, (int)(((size_t)u.pm * 256 + ai * 128 + row) * D + u.pn * 64) * 2 + ch * 16, 0, 16); }
      asm volatile("s_waitcnt lgkmcnt(0)" ::: "memory"); __builtin_amdgcn_s_barrier(); asm volatile("" ::: "memory"); }
    if (panel) { asm volatile("s_waitcnt vmcnt(0)" ::: "memory"); if (fr == 0 && fq == 0) __hip_atomic_fetch_add(panel + 64 * u.pm, 1u, __ATOMIC_RELAXED, __HIP_MEMORY_SCOPE_AGENT); }
  }
};
using EpiMerge = EpiMergeT<0>;
struct GateSched {
  int x, j; bool skip; const char* A; const char* B; const unsigned* brc; unsigned* tmo;
  __device__ __forceinline__ bool next(int i, Unit& u) const { int w;
    if (skip) { if (i >= 4) return false; w = 32 * i + j; }
    else if (j < 20) { if (i >= 5) return false; w = (i == 4 ? 124 : 32 * i) + j; }
    else if (j < 28) { const int k = j - 20; if (i < 3) w = 20 + 32 * i + k; else if (i == 3 && k < 4) w = 116 + k; else return false; }
    else { const int k = j - 28; if (i < 3) w = 28 + 32 * i + k; else if (i == 3) w = 120 + k; else return false; }
    u.pn = w & 15; u.pm = 9 * x + (skip ? 1 : 0) + (w >> 4); u.aux = 0; u.rows = nullptr; u.a = A + (size_t)u.pm * 256 * D; u.b = B + (size_t)u.pn * 256 * D; return true; }
  __device__ __forceinline__ void a_ready(const Unit& u, int tid) const { if (brc) wait_counter(brc + (u.pm * 4 + (u.pn >> 2)) * 64, 32u, tmo, tid); }
};
template <int MODE = 0> __device__ __forceinline__ void phase_gate(Ctx& F, const Args& A, int l, bool skipctx = false, int cbase = CW_PANEL) {
  if (F.G == 256) { GateSched S; S.x = (int)blockIdx.x & 7; S.j = (int)blockIdx.x >> 3; S.skip = skipctx; S.A = (const char*)(F.ws + WS_HN8); S.B = (const char*)(F.ws + WS_WG8 + l * SZ_WG81); S.brc = cbase == CW_PANEL ? (const unsigned*)(F.ws + WS_CTL) + CW_BRC + l * (72 * 4 * 64) : nullptr; S.tmo = (unsigned*)(F.ws + WS_CTL) + CW_BAR_TMO;
    EpiMergeT<MODE> E{(const bf16*)(F.ws + WS_Z4), A.in[18] + (size_t)l * 4 * D, (bf16*)(F.ws + WS_MG), (unsigned*)(F.ws + WS_CTL) + cbase + l * (72 * 64), F.lds + RING_BYTES};
    gemm_phase<EpiMergeT<MODE>, GateSched, true, false, true>(F.lds, F.tid, D, D, D / 2, S, E); return; }
  PlainSched S; S.o.init(skipctx ? NB * 8 : NROWT, 16, F.G, (int)blockIdx.x, skipctx ? 1 : 0, skipctx ? 8 : 9); S.A = (const char*)(F.ws + WS_HN8); S.B = (const char*)(F.ws + WS_WG8 + l * SZ_WG81); S.aTile = (size_t)256 * D; S.bTile = (size_t)256 * D;
  EpiMergeT<MODE> E{(const bf16*)(F.ws + WS_Z4), A.in[18] + (size_t)l * 4 * D, (bf16*)(F.ws + WS_MG), F.G == 256 ? (unsigned*)(F.ws + WS_CTL) + CW_PANEL + l * (72 * 64) : nullptr};
  gemm_phase<EpiMergeT<MODE>, PlainSched, true, false, true>(F.lds, F.tid, D, D, D / 2, S, E);
}
struct EpiResid {
  static constexpr bool PERM = true;
  bf16* hs; const float* mod; float gs;
  __device__ __forceinline__ void operator()(const f32x4 (&acc)[2][2][4][2], const Unit& u, int wr, int wc, int fr, int fq) const {
    const int b = u.pm / 9, rm = (u.pm % 9 == 0) ? 8 : b; const float* gv = mod + (size_t)rm * 6 * D + 2 * D;
    const int col0 = u.pn * 256 + wc * 32 + fq * 8;
    GAS bf16* hg = (GAS bf16*)hs;
#pragma unroll
    for (int bj = 0; bj < 2; ++bj) { v4u w[2][4]; const int c = col0 + bj * 128;
      const f32x4 g0 = *(const f32x4*)(gv + c) * gs, g1 = *(const f32x4*)(gv + c + 4) * gs;
#pragma unroll
      for (int ai = 0; ai < 2; ++ai)
#pragma unroll
        for (int m = 0; m < 4; ++m) w[ai][m] = *(const GAS v4u*)(hg + ((size_t)u.pm * 256 + ai * 128 + wr * 64 + m * 16 + fr) * D + c);
#pragma unroll
      for (int ai = 0; ai < 2; ++ai)
#pragma unroll
        for (int m = 0; m < 4; ++m) { const v4u ww = w[ai][m]; const f32x4 h0 = {bflo(ww.x), bfhi(ww.x), bflo(ww.y), bfhi(ww.y)}, h1 = {bflo(ww.z), bfhi(ww.z), bflo(ww.w), bfhi(ww.w)};
          const f32x4 o0 = h0 + g0 * acc[ai][bj][m][0], o1 = h1 + g1 * acc[ai][bj][m][1];
          v4u ow; ow.x = cvt_pk_bf16(o0[0], o0[1]); ow.y = cvt_pk_bf16(o0[2], o0[3]); ow.z = cvt_pk_bf16(o1[0], o1[1]); ow.w = cvt_pk_bf16(o1[2], o1[3]);
          *(GAS v4u*)(hg + ((size_t)u.pm * 256 + ai * 128 + wr * 64 + m * 16 + fr) * D + c) = ow; } }
  }
};
struct OutSched {
  int c; const char* A; const char* B; unsigned* panel; unsigned* tmo; bool counted; bool skip;
  __device__ __forceinline__ bool next(int i, Unit& u) const { const int x = c & 7, j = c >> 3; int o;
    if (skip) { if (i > 0) return false; o = j; }
    else if (j >= 24 && j < 28) { if (i > 1) return false; o = 2 * (j - 24) + i; }
    else if (i > 0) return false; else if (j >= 28) o = 12 + (j - 28); else if (j >= 20) o = 8 + (j - 20); else o = 16 + j;
    u.pm = 9 * x + (skip ? 1 : 0) + (o >> 2); u.pn = o & 3;
    u.aux = 0; u.rows = nullptr; u.a = A + (size_t)u.pm * 256 * D * 2; u.b = B + (size_t)u.pn * 256 * D * 2; return true; }
  __device__ __forceinline__ void a_ready(const Unit& u, int tid) const {
    if (!counted) return;
    if (tid < 64) { unsigned sp = 0;
      while ((unsigned)__builtin_amdgcn_readfirstlane((int)__hip_atomic_load(panel + 64 * u.pm, __ATOMIC_RELAXED, __HIP_MEMORY_SCOPE_AGENT)) < 128u) { __builtin_amdgcn_s_sleep(2);
        if ((++sp & 255u) == 0u) { if (__hip_atomic_load(tmo, __ATOMIC_RELAXED, __HIP_MEMORY_SCOPE_AGENT)) break; if (sp > (1u << 18)) { atomicAdd(tmo, 1u); break; } } }
      __builtin_amdgcn_fence(__ATOMIC_ACQUIRE, "agent");
      asm volatile("s_waitcnt vmcnt(0)" ::: "memory"); }
    asm volatile("" ::: "memory"); __builtin_amdgcn_s_barrier(); asm volatile("" ::: "memory");
  }
};
__device__ __forceinline__ void phase_out(Ctx& F, const Args& A, int l, float gs = 1.f, bool counted = false, bool skipctx = false, int cbase = CW_PANEL) {
  EpiResid E{(bf16*)(F.ws + WS_HS), (const float*)(F.ws + WS_MOD) + (size_t)l * 9 * 6 * D, gs};
  if (F.G == 256) { OutSched S; S.c = (int)blockIdx.x; S.A = (const char*)(F.ws + WS_MG); S.B = (const char*)(F.ws + WS_WOUT + l * SZ_WOUT1); S.panel = (unsigned*)(F.ws + WS_CTL) + cbase + l * (72 * 64); S.tmo = (unsigned*)(F.ws + WS_CTL) + CW_BAR_TMO; S.counted = counted; S.skip = skipctx;
    gemm_phase<EpiResid, OutSched, true>(F.lds, F.tid, D * 2, D * 2, D, S, E); }
  else { PlainSched S; S.o.init(skipctx ? NB * 8 : NROWT, 4, F.G, (int)blockIdx.x, skipctx ? 1 : 0); S.A = (const char*)(F.ws + WS_MG); S.B = (const char*)(F.ws + WS_WOUT + l * SZ_WOUT1); S.aTile = (size_t)256 * D * 2; S.bTile = (size_t)256 * D * 2;
    gemm_phase<EpiResid, PlainSched, true>(F.lds, F.tid, D * 2, D * 2, D, S, E); }
}
constexpr int CAP2 = 2 * T + NE * 256, NT_MOE = CAP2 / 256;
constexpr size_t WS_XG = WS_ARENA, SZ_XG = (size_t)CAP2 * D * 2;
constexpr size_t WS_HE = WS_XG + SZ_XG, SZ_HE = (size_t)CAP2 * 256 * 2;
constexpr size_t WS_FS = WS_HE + SZ_HE, SZ_FS = (size_t)CAP2 * D * 2;
static_assert(WS_FS + SZ_FS <= WS_END1, "moe arena fits in the mixer arena");
constexpr size_t WS_TOKE = WS_END1, WS_TOKW = WS_TOKE + (size_t)2 * T * 4, WS_TOKR = WS_TOKW + (size_t)2 * T * 4, WS_TOKS = WS_TOKR + (size_t)2 * T * 4, WS_END2 = WS_TOKS + (size_t)2 * T * 4;
constexpr size_t WS_SLOT = WS_END2;
constexpr size_t WS_CJ = WS_SLOT + (size_t)CAP2 * 4;
constexpr size_t WS_SLSP = WS_CJ + 8192;
constexpr size_t WS_END2B = WS_SLSP + (size_t)NE * T * 4;
__device__ __forceinline__ void phase_norm_router(Ctx& F, const Args& A, int l, bool skip_ctx, bool dry = false) {
  const int gw = F.vcu * NWAVES + F.wave, NGW = F.G * NWAVES, lane = F.lane;
  const bf16* hs = (const bf16*)(F.ws + WS_HS); bf16* hn = (bf16*)(F.ws + WS_HN); const float* mod = (const float*)(F.ws + WS_MOD) + (size_t)l * 9 * 6 * D;
  const float* wgr = A.in[21] + (size_t)l * D * 4; const float* bgr = A.in[22] + l * 4; const float* wer = A.in[23] + (size_t)l * D * 32; const float* ber = A.in[24] + l * 32;
  int* tok_e = (int*)(F.ws + WS_TOKE); float* tok_w = (float*)(F.ws + WS_TOKW); int* tok_r = (int*)(F.ws + WS_TOKR);
  unsigned* counts = (unsigned*)(F.ws + WS_CTL) + CW_CNT + l * 64;
  if (dry) { tok_e = (int*)A.out; tok_w = A.out + (1 << 20); tok_r = (int*)A.out + (2 << 20); counts += 32; }
  constexpr int WPB = 2064;
  LAS unsigned char* Wh = F.lds; LAS unsigned char* Wl = F.lds + 36 * WPB; const float* cj = (const float*)(F.ws + WS_CJ) + l * (9 * 36); LAS unsigned* lcnt = (LAS unsigned*)(F.lds + 72 * WPB); LAS unsigned* lbase = lcnt + 32; LAS unsigned* rowctr = lbase + 32;
  __syncthreads();
  { float4 w[18];
#pragma unroll
    for (int it = 0; it < 16; ++it) w[it] = ((const float4*)wer)[F.tid + NTHR * it];
#pragma unroll
    for (int it = 0; it < 2; ++it) w[16 + it] = ((const float4*)wgr)[F.tid + NTHR * it];
#define WSPLIT(J, K, V) do { const float v_ = (V); const unsigned h_ = f2bf(v_); const unsigned l_ = f2bf(v_ - __uint_as_float(h_ << 16)); *(LAS unsigned short*)(Wh + (J) * WPB + (K) * 2) = (unsigned short)h_; *(LAS unsigned short*)(Wl + (J) * WPB + (K) * 2) = (unsigned short)l_; } while (0)
#pragma unroll
    for (int it = 0; it < 16; ++it) { const int i4 = F.tid + NTHR * it, k = i4 >> 3, j = 4 + 4 * (i4 & 7); WSPLIT(j, k, w[it].x); WSPLIT(j + 1, k, w[it].y); WSPLIT(j + 2, k, w[it].z); WSPLIT(j + 3, k, w[it].w); }
#pragma unroll
    for (int it = 0; it < 2; ++it) { const int k = F.tid + NTHR * it; WSPLIT(0, k, w[16 + it].x); WSPLIT(1, k, w[16 + it].y); WSPLIT(2, k, w[16 + it].z); WSPLIT(3, k, w[16 + it].w); }
#undef WSPLIT
  }
  if (F.tid < 32) lcnt[F.tid] = 0u;
  if (F.tid == 32) rowctr[0] = 0u;
  __syncthreads();
  refresh_ctx(F, A);
  const int NR = skip_ctx ? NB * NLAT : T;
  const int lane2 = F.lane; const int g16 = F.wave * F.G + F.vcu, NG = NR / 16; const int fr = lane2 & 15, fq = lane2 >> 4;
  int myE0 = -1, myE1 = -1, mym = 0, myR0 = 0, myR1 = 0; int* slsp = (int*)(F.ws + WS_SLSP); if (dry) slsp = (int*)A.out + (3 << 20);
  if (g16 < NG) {
    const int r0 = g16 * 16 + fr; const int m = skip_ctx ? (r0 / NLAT) * NTOK + NCTX + (r0 % NLAT) : r0; const int b = m / NTOK, t = m % NTOK, r = t < NCTX ? 8 : b; mym = m;
    const bf16* xrow = hs + (size_t)m * D + 16 * fq; const float* scr = mod + (size_t)r * 6 * D + 4 * D + 16 * fq;
    const int j2 = fr < 4 ? 32 + fr : 35;
    const LAS unsigned char* ah0 = Wh + fr * WPB + 32 * fq; const LAS unsigned char* ah1 = Wh + (16 + fr) * WPB + 32 * fq; const LAS unsigned char* ah2 = Wh + j2 * WPB + 32 * fq;
    const LAS unsigned char* al0 = Wl + fr * WPB + 32 * fq; const LAS unsigned char* al1 = Wl + (16 + fr) * WPB + 32 * fq; const LAS unsigned char* al2 = Wl + j2 * WPB + 32 * fq;
    f32x4 acc0 = {0.f, 0.f, 0.f, 0.f}, acc1 = acc0, acc2 = acc0; float ss = 0.f;
#pragma unroll 2
    for (int g = 0; g < 16; ++g) { const uint4 xw0 = *(const uint4*)(xrow + 64 * g), xw1 = *(const uint4*)(xrow + 64 * g + 8);
      float xa[16] = {bflo(xw0.x), bfhi(xw0.x), bflo(xw0.y), bfhi(xw0.y), bflo(xw0.z), bfhi(xw0.z), bflo(xw0.w), bfhi(xw0.w), bflo(xw1.x), bfhi(xw1.x), bflo(xw1.y), bfhi(xw1.y), bflo(xw1.z), bfhi(xw1.z), bflo(xw1.w), bfhi(xw1.w)};
#pragma unroll
      for (int q = 0; q < 4; ++q) { const float4 s4 = *(const float4*)(scr + 64 * g + 4 * q);
        ss += (xa[4 * q] * xa[4 * q] + xa[4 * q + 1] * xa[4 * q + 1]) + (xa[4 * q + 2] * xa[4 * q + 2] + xa[4 * q + 3] * xa[4 * q + 3]);
        xa[4 * q] *= 1.f + s4.x; xa[4 * q + 1] *= 1.f + s4.y; xa[4 * q + 2] *= 1.f + s4.z; xa[4 * q + 3] *= 1.f + s4.w; }
#pragma unroll
      for (int s = 0; s < 2; ++s) {
        v4u xh, xl;
#pragma unroll
        for (int e2 = 0; e2 < 4; ++e2) { const float a = xa[8 * s + 2 * e2], b2 = xa[8 * s + 2 * e2 + 1]; const unsigned h = cvt_pk_bf16(a, b2); const unsigned lo = cvt_pk_bf16(a - bflo(h), b2 - bfhi(h)); xh[e2] = h; xl[e2] = lo; }
        const bf16x8 bh = __builtin_bit_cast(bf16x8, xh), bl = __builtin_bit_cast(bf16x8, xl);
        const bf16x8 h0 = *(const LAS bf16x8*)(ah0 + 128 * g + 16 * s), h1 = *(const LAS bf16x8*)(ah1 + 128 * g + 16 * s), h2 = *(const LAS bf16x8*)(ah2 + 128 * g + 16 * s);
        const bf16x8 l0 = *(const LAS bf16x8*)(al0 + 128 * g + 16 * s), l1 = *(const LAS bf16x8*)(al1 + 128 * g + 16 * s), l2 = *(const LAS bf16x8*)(al2 + 128 * g + 16 * s);
        acc0 = __builtin_amdgcn_mfma_f32_16x16x32_bf16(h0, bh, acc0, 0, 0, 0); acc1 = __builtin_amdgcn_mfma_f32_16x16x32_bf16(h1, bh, acc1, 0, 0, 0); acc2 = __builtin_amdgcn_mfma_f32_16x16x32_bf16(h2, bh, acc2, 0, 0, 0);
        acc0 = __builtin_amdgcn_mfma_f32_16x16x32_bf16(l0, bh, acc0, 0, 0, 0); acc1 = __builtin_amdgcn_mfma_f32_16x16x32_bf16(l1, bh, acc1, 0, 0, 0); acc2 = __builtin_amdgcn_mfma_f32_16x16x32_bf16(l2, bh, acc2, 0, 0, 0);
        acc0 = __builtin_amdgcn_mfma_f32_16x16x32_bf16(h0, bl, acc0, 0, 0, 0); acc1 = __builtin_amdgcn_mfma_f32_16x16x32_bf16(h1, bl, acc1, 0, 0, 0); acc2 = __builtin_amdgcn_mfma_f32_16x16x32_bf16(h2, bl, acc2, 0, 0, 0); } }
    ss = sum_x16(ss); ss = sum_x32(ss);
    const float rinv = rsqrtf(ss * (1.f / D) + EPS);
    float lg[36];
#pragma unroll
    for (int e = 0; e < 4; ++e) { lg[e] = acc0[e]; lg[16 + e] = acc1[e]; lg[32 + e] = acc2[e]; }
#pragma unroll
    for (int q = 1; q < 4; ++q)
#pragma unroll
      for (int e = 0; e < 4; ++e) { const float a0 = acc0[e], a1 = acc1[e];
        lg[4 * q + e] = __int_as_float(__builtin_amdgcn_ds_bpermute((fr + 16 * q) << 2, __float_as_int(a0))); lg[16 + 4 * q + e] = __int_as_float(__builtin_amdgcn_ds_bpermute((fr + 16 * q) << 2, __float_as_int(a1))); }
    if (fq == 0) {
      const float* cr = cj + r * 36;
      float mxg = -1e30f; int g = 0; float gl[4];
#pragma unroll
      for (int j = 0; j < 4; ++j) { gl[j] = rinv * lg[j] + cr[j]; if (gl[j] > mxg) { mxg = gl[j]; g = j; } }
      float sg = 0.f;
#pragma unroll
      for (int j = 0; j < 4; ++j) sg += __expf(gl[j] - mxg);
      const float pg = 1.f / sg;
      float v0 = -1e30f, v1 = -1e30f; int e0 = 0, e1 = 0;
#pragma unroll
      for (int j = 0; j < 8; ++j) { float le = 0.f;
#pragma unroll
        for (int gg = 0; gg < 4; ++gg) if (gg == g) le = lg[4 + gg * 8 + j];
        le = rinv * le + cr[4 + g * 8 + j];
        if (le > v0) { v1 = v0; e1 = e0; v0 = le; e0 = j; } else if (le > v1) { v1 = le; e1 = j; } }
      const float p1 = __expf(v1 - v0); const float inv = pg / (1.f + p1);
      myE0 = g * 8 + e0; myE1 = g * 8 + e1;
      tok_e[2 * m] = myE0; tok_e[2 * m + 1] = myE1; tok_w[2 * m] = inv; tok_w[2 * m + 1] = p1 * inv;
      myR0 = (int)__hip_atomic_fetch_add(&lcnt[myE0], 1u, __ATOMIC_RELAXED, __HIP_MEMORY_SCOPE_WORKGROUP); myR1 = (int)__hip_atomic_fetch_add(&lcnt[myE1], 1u, __ATOMIC_RELAXED, __HIP_MEMORY_SCOPE_WORKGROUP);
    }
  }
  { const int NR2 = skip_ctx ? NB * NLAT : T; const int rpb = NR2 / F.G;
    for (;;) { unsigned q = 0; if (lane2 == 0) q = __hip_atomic_fetch_add(rowctr, 1u, __ATOMIC_RELAXED, __HIP_MEMORY_SCOPE_WORKGROUP); q = (unsigned)__builtin_amdgcn_readfirstlane((int)q); if ((int)q >= rpb) break;
      const int r0 = F.vcu * NWAVES + (int)(q & 7) + (int)(q >> 3) * NGW; const int m = skip_ctx ? (r0 / NLAT) * NTOK + NCTX + (r0 % NLAT) : r0; const int b = m / NTOK, t = m % NTOK, r = t < NCTX ? 8 : b;
      const float4* sh = (const float4*)(mod + (size_t)r * 6 * D + 3 * D); const float4* sc = sh + D / 4; const v2u* xr = (const v2u*)(hs + (size_t)m * D); float4 v[4]; float ss = 0.f;
#pragma unroll
      for (int j = 0; j < 4; ++j) { const v2u w = xr[lane2 + 64 * j]; v[j] = make_float4(bflo(w.x), bfhi(w.x), bflo(w.y), bfhi(w.y)); ss += v[j].x * v[j].x + v[j].y * v[j].y + v[j].z * v[j].z + v[j].w * v[j].w; }
      const float rinv = rsqrtf(wave_sum(ss) * (1.f / D) + EPS);
#pragma unroll
      for (int j = 0; j < 4; ++j) { const float4 a = sc[lane2 + 64 * j], s4 = sh[lane2 + 64 * j];
        v2u o; o.x = pk2(v[j].x * rinv * (1.f + a.x) + s4.x, v[j].y * rinv * (1.f + a.y) + s4.y); o.y = pk2(v[j].z * rinv * (1.f + a.z) + s4.z, v[j].w * rinv * (1.f + a.w) + s4.w);
        ((v2u*)(hn + (size_t)m * D))[lane2 + 64 * j] = o; } } }
  if (skip_ctx) { int neg1 = -1; asm volatile("" : "+v"(neg1)); for (int m = gw; m < T; m += NGW) if ((m % NTOK) < NCTX && lane < 2) tok_e[2 * m + lane] = neg1; }
  __syncthreads();
  if (F.tid < 32) { const unsigned c = lcnt[F.tid]; lbase[F.tid] = c ? atomicAdd(&counts[F.tid], c) : 0u; }
  __syncthreads();
  if (myE0 >= 0) { const int r0 = myR0 + (int)lbase[myE0], r1 = myR1 + (int)lbase[myE1]; tok_r[2 * mym] = r0; tok_r[2 * mym + 1] = r1; slsp[myE0 * T + r0] = mym; slsp[myE1 * T + r1] = mym; }
  __syncthreads();
}
__device__ __forceinline__ void moe_tables(Ctx& F, const Args& A, int l) {
  LAS int* ps = (LAS int*)(F.lds + XSCR_OFF); LAS int* te = ps + 64; LAS int* cn = ps + 256;
  const unsigned* counts = (const unsigned*)(F.ws + WS_CTL) + CW_CNT + l * 64;
  __syncthreads();
  if (F.tid < NE) cn[F.tid] = (int)__hip_atomic_load(counts + F.tid, __ATOMIC_RELAXED, __HIP_MEMORY_SCOPE_AGENT);
  __syncthreads();
  if (F.tid == 0) { int a = 0; for (int e = 0; e < NE; ++e) { ps[e] = a; a += (cn[e] + 255) / 256 * 256; } ps[NE] = a; }
  __syncthreads();
  for (int i = F.tid; i < NT_MOE; i += NTHR) { int e = -1;
    for (int j = 0; j < NE; ++j) if (i * 256 >= ps[j] && i * 256 < ps[j + 1]) e = j;
    if (e >= 0) { const int off = i * 256 - ps[e]; int nv = cn[e] - off; nv = nv > 256 ? 256 : nv; e |= ((nv - 1) << 5) | ((off >> 8) << 13); }
    te[i] = e; }
  __syncthreads();
}
struct MoeSched {
  int G, c, npn, ntile; const char* A; const char* W; size_t aTile, wExp, wTile; const LAS int* te; const int* slot_tok;
  __device__ __forceinline__ bool next(int i, Unit& u) const { const int Lx = i * G + c; if (Lx >= ntile * npn) return false; const int rt = Lx / npn, pn = Lx % npn; const int w = te[rt], e = w & 31;
    u.pm = rt; u.pn = pn; u.aux = e; u.a = A + (size_t)rt * aTile; u.b = W + (size_t)e * wExp + (size_t)pn * wTile; u.rows = slot_tok + e * T + (w >> 13) * 256; u.nv = ((w >> 5) & 255) + 1; return true; }
  __device__ __forceinline__ void a_ready(const Unit&, int) const {}
};
struct EpiSwiGLU {
  static constexpr bool PERM = true;
  bf16* H;
  __device__ __forceinline__ void operator()(const f32x4 (&acc)[2][2][4][2], const Unit& u, int wr, int wc, int fr, int fq) const {
#pragma unroll
    for (int ai = 0; ai < 2; ++ai)
#pragma unroll
      for (int m = 0; m < 4; ++m) { const size_t r = (size_t)u.pm * 256 + ai * 128 + wr * 64 + m * 16 + fr; float h[8];
#pragma unroll
        for (int n = 0; n < 2; ++n)
#pragma unroll
          for (int e = 0; e < 4; ++e) { const float g = acc[ai][0][m][n][e]; h[4 * n + e] = g * __builtin_amdgcn_rcpf(1.f + __expf(-g)) * acc[ai][1][m][n][e]; }
        v4u w; w.x = cvt_pk_bf16(h[0], h[1]); w.y = cvt_pk_bf16(h[2], h[3]); w.z = cvt_pk_bf16(h[4], h[5]); w.w = cvt_pk_bf16(h[6], h[7]);
        *(v4u*)(H + r * 256 + u.pn * 128 + wc * 32 + fq * 8) = w; }
  }
};
__device__ __forceinline__ void phase_moe_gu(Ctx& F, const Args& A, int l) {
  moe_tables(F, A, l);
  const LAS int* ps = (const LAS int*)(F.lds + XSCR_OFF);
  MoeSched S; S.G = F.G; S.c = (int)blockIdx.x; S.npn = 2; S.ntile = ps[NE] / 256; S.A = (const char*)(F.ws + WS_HN); S.slot_tok = (const int*)(F.ws + WS_SLSP); S.W = (const char*)(F.ws + WS_WGU + l * SZ_WGU1); S.aTile = 0; S.wExp = (size_t)512 * D * 2; S.wTile = (size_t)256 * D * 2; S.te = ps + 64;
  EpiSwiGLU E{(bf16*)(F.ws + WS_HE)};
  gemm_phase<EpiSwiGLU, MoeSched, true, true>(F.lds, F.tid, D * 2, D * 2, D, S, E);
}
__device__ __forceinline__ void phase_moe_dn(Ctx& F, const Args& A, int l) {
  moe_tables(F, A, l);
  const LAS int* ps = (const LAS int*)(F.lds + XSCR_OFF);
  MoeSched S; S.G = F.G; S.c = (int)blockIdx.x; S.npn = 4; S.ntile = ps[NE] / 256; S.slot_tok = (const int*)(F.ws + WS_SLSP); S.A = (const char*)(F.ws + WS_HE); S.W = (const char*)(F.ws + WS_WDN + l * SZ_WDN1); S.aTile = (size_t)256 * 256 * 2; S.wExp = (size_t)D * 256 * 2; S.wTile = (size_t)256 * 256 * 2; S.te = ps + 64;
  EpiStoreBf16 E{(bf16*)(F.ws + WS_FS), D, (int)SZ_FS, F.lds + RING_BYTES};
  gemm_phase<EpiStoreBf16, MoeSched, true>(F.lds, F.tid, 512, 512, 256, S, E);
}
__device__ __forceinline__ void phase_moe_combine(Ctx& F, const Args& A, int l) {
  const int gw = F.vcu * NWAVES + F.wave, NGW = F.G * NWAVES, lane = F.lane;
  float* hs = (float*)(F.ws + WS_HS); const float* mod = (const float*)(F.ws + WS_MOD) + (size_t)l * 9 * 6 * D;
  const int* tok_s = (const int*)(F.ws + WS_TOKS); const float* tok_w = (const float*)(F.ws + WS_TOKW); const bf16* fs = (const bf16*)(F.ws + WS_FS);
  for (int m = gw; m < T; m += NGW) { const int s0 = tok_s[2 * m], s1 = tok_s[2 * m + 1]; if (s0 < 0) continue;
    const int b = m / NTOK, t = m % NTOK, r = t < NCTX ? 8 : b; const float w0 = tok_w[2 * m], w1 = tok_w[2 * m + 1];
    const float4* g5 = (const float4*)(mod + (size_t)r * 6 * D + 5 * D);
#pragma unroll
    for (int j = 0; j < 4; ++j) { const int c4 = lane + 64 * j; const v2u a = ((const v2u*)(fs + (size_t)s0 * D))[c4], bq = ((const v2u*)(fs + (size_t)s1 * D))[c4]; const float4 g = g5[c4];
      float4 h = ((float4*)(hs + (size_t)m * D))[c4];
      h.x += g.x * (w0 * bflo(a.x) + w1 * bflo(bq.x)); h.y += g.y * (w0 * bfhi(a.x) + w1 * bfhi(bq.x)); h.z += g.z * (w0 * bflo(a.y) + w1 * bflo(bq.y)); h.w += g.w * (w0 * bfhi(a.y) + w1 * bfhi(bq.y));
      ((float4*)(hs + (size_t)m * D))[c4] = h; } }
}
}
namespace mk {
constexpr int NKT = NTOK / 64;
constexpr size_t WS_QM = WS_END2B, SZ_QM = (size_t)NB * 4 * NTOK * 96 * 2;
constexpr size_t WS_QD = WS_QM + SZ_QM, SZ_QD = (size_t)NB * 4 * NTOK * 64 * 2;
constexpr size_t WS_KM = WS_QD + SZ_QD, SZ_KM = (size_t)NB * 4 * NKT * 12288;
constexpr size_t WS_KD = WS_KM + SZ_KM, SZ_KD = (size_t)NB * 2 * NKT * 8192;
constexpr size_t WS_VM = WS_KD + SZ_KD, SZ_VM = (size_t)NB * 4 * NKT * 8192;
constexpr size_t WS_VD = WS_VM + SZ_VM, SZ_VD = (size_t)NB * 2 * NKT * 8192;
constexpr size_t WS_END3 = WS_VD + SZ_VD;
constexpr float QSCALE_M = 0.10206207261596577f * 1.4426950408889634f, QSCALE_D = 0.125f * 1.4426950408889634f;

template <int NCB> __device__ __forceinline__ int v_st(int k, int c) { const int kk = (k & ~0xC) | ((k & 4) << 1) | ((k & 8) >> 1); return ((kk >> 3) * NCB + (c >> 5)) * 512 + ((kk & 7) * 32 + (c & 31)) * 2; }
__device__ __forceinline__ int v_rd_base(int lane) { return ((lane & 3) << 3) | (((lane >> 2) & 3) << 6) | (((lane >> 4) & 1) << 5) | (((lane >> 5) & 1) << 8); }
template <int NCB> constexpr int v_rd_off(int d0, int ks, int half) { return d0 * 512 + ks * (2 * NCB * 512) + half * (NCB * 512); }
typedef short s16x4 __attribute__((ext_vector_type(4)));
typedef float f32x16 __attribute__((ext_vector_type(16)));
template <int OFF> __device__ __forceinline__ s16x4 tr_read(int vb) { s16x4 r; asm volatile("ds_read_b64_tr_b16 %0, %1 offset:%2" : "=&v"(r) : "v"(vb), "i"(OFF) : "memory"); return r; }
__device__ __forceinline__ int crow(int r, int hi) { return (r & 3) + 8 * (r >> 2) + 4 * hi; }
#define SBAR() __builtin_amdgcn_sched_barrier(0)

template <int ROT> __device__ __forceinline__ void rope_cs(int t, int i, float& cs, float& sn) {
  constexpr int NF = ROT / 4;
  if (t < NCTX) { cs = 1.f; sn = 0.f; return; }
  const int tl = t - NCTX; const float pos = (i < NF) ? (float)(tl >> 6) : (float)(tl & 63); const int fi = i % NF;
  const float fr = exp2f(-(float)fi * (13.287712379549449f / (float)NF));
  float rev = pos * fr * 0.15915494309189535f; rev = rev - floorf(rev);
  cs = __builtin_amdgcn_cosf(rev); sn = __builtin_amdgcn_sinf(rev);
}

__device__ __forceinline__ void phase_b_rows(Ctx& F, const Args& A, int l) {
  const int gw = F.vcu * NWAVES + F.wave, NGW = F.G * NWAVES, lane = F.lane;
  const bf16* zb = (const bf16*)(F.ws + WS_ZB); bf16* Y = (bf16*)(F.ws + WS_Y);
  const float* gq_gain = A.in[15] + l * 64; const float* gk_gain = A.in[16] + l * 64; const float* w_conv = A.in[14] + l * 3 * 256;
  const float gq = gq_gain[lane], gk = gk_gain[lane];
  float wcv[3][4];
#pragma unroll
  for (int j = 0; j < 3; ++j)
#pragma unroll
    for (int e = 0; e < 4; ++e) wcv[j][e] = w_conv[j * 256 + 4 * lane + e];
  constexpr int RB = 3;
  for (int m0 = gw; m0 < T; m0 += RB * NGW) {
    int mr[RB]; bool ok[RB];
#pragma unroll
    for (int i = 0; i < RB; ++i) { const int mi = m0 + i * NGW; ok[i] = mi < T; mr[i] = ok[i] ? mi : m0; }
    bf16 kpe[RB], gqv[RB][4], gkv[RB][2], gvv[RB][2]; v2u cc[RB][3], cx[RB][3], cb[RB]; float cmask[RB][3];
#pragma unroll
    for (int i = 0; i < RB; ++i) { const int m = mr[i], t = m % NTOK; const bf16* zr = zb + (size_t)m * ZBW;
      kpe[i] = zr[ZB_KPE + (lane & 31)];
#pragma unroll
      for (int h = 0; h < 4; ++h) gqv[i][h] = zr[ZB_GQ + h * 64 + lane];
#pragma unroll
      for (int h = 0; h < 2; ++h) { gkv[i][h] = zr[ZB_GK + h * 64 + lane]; gvv[i][h] = zr[ZB_GV + h * 64 + lane]; }
      const int lo = t < NCTX ? 0 : NCTX, hi = t < NCTX ? NCTX : NTOK;
#pragma unroll
      for (int j = 0; j < 3; ++j) { const int tt = t + j - 1; const bool in = tt >= lo && tt < hi; cmask[i][j] = in ? 1.f : 0.f; const bf16* z2 = zb + (size_t)(in ? m + j - 1 : m) * ZBW;
        cc[i][j] = *(const v2u*)(z2 + ZB_CC + 4 * lane); cx[i][j] = *(const v2u*)(z2 + ZB_CX + 4 * lane); }
      cb[i] = *(const v2u*)(zr + ZB_CB + 4 * lane); }
#pragma unroll
    for (int i = 0; i < RB; ++i) { const int m = mr[i]; const int b = m / NTOK, t = m % NTOK, tile = t >> 6, rr = t & 63; const bool okr = ok[i];
      { const float xv = bf2f(kpe[i]); const float xp = get_x16(xv, lane); float cs, sn; rope_cs<32>(t, lane & 15, cs, sn);
        const float o = (lane & 16) ? (xp * sn + xv * cs) : (xv * cs - xp * sn); const bf16 ob = (bf16)f2bf(o);
        if (lane < 32 && okr) {
#pragma unroll
          for (int h = 0; h < 4; ++h) ((bf16*)(F.ws + WS_KM + ((size_t)(b * 4 + h) * NKT + tile) * 12288))[(8 + (lane >> 3)) * 512 + rr * 8 + (lane & 7)] = ob; } }
      float cs64, sn64; rope_cs<64>(t, lane & 31, cs64, sn64);
#pragma unroll
      for (int h = 0; h < 4; ++h) { const float x0 = bf2f(gqv[i][h]); const float rinv = rsqrtf(wave_sum(x0 * x0) * (1.f / 64.f) + EPS); const float xv = x0 * rinv * gq;
        const float xp = get_x32(xv, lane); const float o = ((lane & 32) ? (xp * sn64 + xv * cs64) : (xv * cs64 - xp * sn64)) * QSCALE_D;
        if (okr) ((bf16*)(F.ws + WS_QD))[((size_t)(b * 4 + h) * NTOK + t) * 64 + lane] = (bf16)f2bf(o); }
#pragma unroll
      for (int h = 0; h < 2; ++h) { const float x0 = bf2f(gkv[i][h]); const float rinv = rsqrtf(wave_sum(x0 * x0) * (1.f / 64.f) + EPS); const float xv = x0 * rinv * gk;
        const float xp = get_x32(xv, lane); const float o = (lane & 32) ? (xp * sn64 + xv * cs64) : (xv * cs64 - xp * sn64);
        if (okr) { ((bf16*)(F.ws + WS_KD + ((size_t)(b * 2 + h) * NKT + tile) * 8192))[(lane >> 3) * 512 + rr * 8 + (lane & 7)] = (bf16)f2bf(o);
          *(bf16*)(F.ws + WS_VD + ((size_t)(b * 2 + h) * NKT + tile) * 8192 + v_st<2>(rr, lane)) = gvv[i][h]; } }
      { float a[4] = {0.f, 0.f, 0.f, 0.f};
#pragma unroll
        for (int j = 0; j < 3; ++j) { const float mk_ = cmask[i][j]; const v2u c1 = cc[i][j], c2 = cx[i][j];
          a[0] += mk_ * wcv[j][0] * bflo(c1.x) * bflo(c2.x); a[1] += mk_ * wcv[j][1] * bfhi(c1.x) * bfhi(c2.x); a[2] += mk_ * wcv[j][2] * bflo(c1.y) * bflo(c2.y); a[3] += mk_ * wcv[j][3] * bfhi(c1.y) * bfhi(c2.y); }
        v2u o; o.x = pk2(bflo(cb[i].x) * a[0], bfhi(cb[i].x) * a[1]); o.y = pk2(bflo(cb[i].y) * a[2], bfhi(cb[i].y) * a[3]);
        if (okr) *(v2u*)(Y + (size_t)m * D + 512 + 4 * lane) = o; } }
  }
}
template <int NWID> __device__ __forceinline__ float seg_rinv(const bf16* seg, int fq) {
  float ss = 0.f;
#pragma unroll
  for (int i = 0; i < NWID / 32; ++i) { const v4u w = *(const v4u*)(seg + fq * (NWID / 4) + i * 8);
    ss += bflo(w.x) * bflo(w.x) + bfhi(w.x) * bfhi(w.x) + bflo(w.y) * bflo(w.y) + bfhi(w.y) * bfhi(w.y) + bflo(w.z) * bflo(w.z) + bfhi(w.z) * bfhi(w.z) + bflo(w.w) * bflo(w.w) + bfhi(w.w) * bfhi(w.w); }
  ss = sum_x16(ss); ss = sum_x32(ss);
  return rsqrtf(ss * (1.f / NWID) + EPS);
}
struct EpiQm {
  static constexpr bool PERM = true;
  const float* rss; bf16* QM;
  __device__ __forceinline__ void operator()(const f32x4 (&acc)[2][2][4][2], const Unit& u, int wr, int wc, int fr, int fq) const {
    if (u.pn == 0) {
#pragma unroll
      for (int ai = 0; ai < 2; ++ai)
#pragma unroll
        for (int m = 0; m < 4; ++m) { const int r = u.pm * 256 + ai * 128 + wr * 64 + m * 16 + fr; const int b = r / NTOK, t = r % NTOK;
          const f32x4 p4 = *(const f32x4*)(rss + (size_t)r * 8); const float sc = rsqrtf(((p4[0] + p4[1]) + (p4[2] + p4[3])) * (1.f / 256.f) + EPS) * QSCALE_M;
#pragma unroll
          for (int bj = 0; bj < 2; ++bj) { const int h = 2 * bj + (wc >> 1), d = 32 * (wc & 1) + 8 * fq; const f32x4 v0 = acc[ai][bj][m][0] * sc, v1 = acc[ai][bj][m][1] * sc;
            v4u w; w.x = cvt_pk_bf16(v0[0], v0[1]); w.y = cvt_pk_bf16(v0[2], v0[3]); w.z = cvt_pk_bf16(v1[0], v1[1]); w.w = cvt_pk_bf16(v1[2], v1[3]);
            *(v4u*)(QM + ((size_t)(b * 4 + h) * NTOK + t) * 96 + d) = w; } }
    } else {
#pragma unroll
      for (int ai = 0; ai < 2; ++ai)
#pragma unroll
        for (int m = 0; m < 4; ++m) { const int r = u.pm * 256 + ai * 128 + wr * 64 + m * 16 + fr; const int b = r / NTOK, t = r % NTOK;
          const f32x4 p4 = *(const f32x4*)(rss + (size_t)r * 8); const float sc = rsqrtf(((p4[0] + p4[1]) + (p4[2] + p4[3])) * (1.f / 256.f) + EPS) * QSCALE_M;
          const int h = wc; const f32x4 x1 = acc[ai][0][m][0] * sc, x2 = acc[ai][0][m][1] * sc; float o1[4], o2[4];
#pragma unroll
          for (int e = 0; e < 4; ++e) { float cs, sn; rope_cs<32>(t, 4 * fq + e, cs, sn); o1[e] = x1[e] * cs - x2[e] * sn; o2[e] = x1[e] * sn + x2[e] * cs; }
          bf16* q = QM + ((size_t)(b * 4 + h) * NTOK + t) * 96 + 64 + 4 * fq;
          v2u w1; w1.x = cvt_pk_bf16(o1[0], o1[1]); w1.y = cvt_pk_bf16(o1[2], o1[3]); *(v2u*)q = w1;
          v2u w2; w2.x = cvt_pk_bf16(o2[0], o2[1]); w2.y = cvt_pk_bf16(o2[2], o2[3]); *(v2u*)(q + 16) = w2; }
    }
  }
};
struct EpiKVm {
  static constexpr bool PERM = true;
  const float* rss; unsigned char* ws;
  __device__ __forceinline__ void operator()(const f32x4 (&acc)[2][2][4][2], const Unit& u, int wr, int wc, int fr, int fq) const {
    const bool isk = __builtin_amdgcn_readfirstlane(wc) < 2;
    const size_t tileB = isk ? 12288 : 8192; unsigned char* base = ws + (isk ? WS_KM : WS_VM);
#pragma unroll
    for (int ai = 0; ai < 2; ++ai)
#pragma unroll
      for (int m = 0; m < 4; ++m) { const int r = u.pm * 256 + ai * 128 + wr * 64 + m * 16 + fr; const int b = r / NTOK, t = r % NTOK, tile = t >> 6, rr = t & 63;
        const f32x4 p4 = *(const f32x4*)(rss + (size_t)r * 8 + 4); const float sc = rsqrtf(((p4[0] + p4[1]) + (p4[2] + p4[3])) * (1.f / 128.f) + EPS);
        const int inoff = isk ? (4 * wc + fq) * 1024 + rr * 16 : v_st<2>(rr, 32 * (wc - 2) + 8 * fq);
#pragma unroll
        for (int bj = 0; bj < 2; ++bj) { const int h = 2 * u.pn + bj; const f32x4 v0 = acc[ai][bj][m][0] * sc, v1 = acc[ai][bj][m][1] * sc;
          v4u w; w.x = cvt_pk_bf16(v0[0], v0[1]); w.y = cvt_pk_bf16(v0[2], v0[3]); w.z = cvt_pk_bf16(v1[0], v1[1]); w.w = cvt_pk_bf16(v1[2], v1[3]);
          *(v4u*)(base + ((size_t)(b * 4 + h) * NKT + tile) * tileB + inoff) = w; } }
  }
};
struct SliceSched {
  TileOrder o; const char* A; const char* B;
  __device__ __forceinline__ bool next(int i, Unit& u) const { int pm, pn; if (!o.tile(i, pm, pn)) return false; u.pm = pm; u.pn = pn; u.aux = 0; u.a = A + (size_t)pm * 256 * ZBW * 2; u.b = B + (size_t)pn * 256 * 512; return true; }
  __device__ __forceinline__ void a_ready(const Unit&, int) const {}
};
__device__ __forceinline__ void phase_b_chunkmix(Ctx& F, const Args& A, int l, const int widx, const int nw) {
  const int lane = F.lane, wave = F.wave, r32 = lane & 31, hi = lane >> 5;
  const bf16* zb = (const bf16*)(F.ws + WS_ZB); bf16* Y = (bf16*)(F.ws + WS_Y); const bf16* wsg = (const bf16*)(F.ws + WS_WSGU + l * SZ_WSGU1);
  const float* sgu_gain = A.in[7] + l * 256; const float* b_s = A.in[9] + l * 4 * 128;
  const float g0 = sgu_gain[4 * lane], g1 = sgu_gain[4 * lane + 1], g2 = sgu_gain[4 * lane + 2], g3 = sgu_gain[4 * lane + 3];
  LAS unsigned char* img = F.lds;
  const int g = wave >> 1, ph = wave & 1;
  for (int ch = widx; ch < T / 128; ch += nw) {
    const int m0 = ch * 128;
    __syncthreads();
    for (int q = wave; q < 128; q += NWAVES) { const v2u w = *(const v2u*)(zb + (size_t)(m0 + q) * ZBW + ZB_AV + 4 * lane);
      const float a0 = gelu_tanh(bflo(w.x)), a1 = gelu_tanh(bfhi(w.x)), a2 = gelu_tanh(bflo(w.y)), a3 = gelu_tanh(bfhi(w.y));
      const float rinv = rsqrtf(wave_sum(a0 * a0 + a1 * a1 + a2 * a2 + a3 * a3) * (1.f / 256.f) + EPS);
      v2u o; o.x = pk2(a0 * rinv * g0, a1 * rinv * g1); o.y = pk2(a2 * rinv * g2, a3 * rinv * g3);
      *(LAS v2u*)(img + v_st<8>(q, 4 * lane)) = o; }
    __syncthreads();
    f32x16 acc[2][2];
#pragma unroll
    for (int a = 0; a < 2; ++a)
#pragma unroll
      for (int c = 0; c < 2; ++c) acc[a][c] = f32x16{};
    const int vb = (int)(uintptr_t)img + v_rd_base(lane) + (2 * g) * 512;
    const bf16* wrow = wsg + ((size_t)g * 128 + 64 * ph + r32) * 128 + 8 * hi;
#define CM_STEP(KS) do { const bf16x8 a0 = *(const bf16x8*)(wrow + 16 * (KS)), a1 = *(const bf16x8*)(wrow + 32 * 128 + 16 * (KS)); \
      const s16x4 l0 = tr_read<v_rd_off<8>(0, KS, 0)>(vb), h0 = tr_read<v_rd_off<8>(0, KS, 1)>(vb), l1 = tr_read<v_rd_off<8>(1, KS, 0)>(vb), h1 = tr_read<v_rd_off<8>(1, KS, 1)>(vb); \
      asm volatile("s_waitcnt lgkmcnt(0)" ::: "memory"); SBAR(); \
      const bf16x8 b0 = (bf16x8){l0[0], l0[1], l0[2], l0[3], h0[0], h0[1], h0[2], h0[3]}, b1 = (bf16x8){l1[0], l1[1], l1[2], l1[3], h1[0], h1[1], h1[2], h1[3]}; \
      acc[0][0] = __builtin_amdgcn_mfma_f32_32x32x16_bf16(a0, b0, acc[0][0], 0, 0, 0); acc[0][1] = __builtin_amdgcn_mfma_f32_32x32x16_bf16(a0, b1, acc[0][1], 0, 0, 0); \
      acc[1][0] = __builtin_amdgcn_mfma_f32_32x32x16_bf16(a1, b0, acc[1][0], 0, 0, 0); acc[1][1] = __builtin_amdgcn_mfma_f32_32x32x16_bf16(a1, b1, acc[1][1], 0, 0, 0); } while (0)
    CM_STEP(0); CM_STEP(1); CM_STEP(2); CM_STEP(3); CM_STEP(4); CM_STEP(5); CM_STEP(6); CM_STEP(7);
#undef CM_STEP
#pragma unroll
    for (int pt = 0; pt < 2; ++pt)
#pragma unroll
      for (int r = 0; r < 16; ++r) { const int p = 64 * ph + 32 * pt + crow(r, hi); const float bs = b_s[g * 128 + p];
#pragma unroll
        for (int cb = 0; cb < 2; ++cb) { const int c = 64 * g + 32 * cb + r32; const float au = gelu_tanh(bf2f(zb[(size_t)(m0 + p) * ZBW + ZB_AU + c]));
          Y[(size_t)(m0 + p) * D + c] = (bf16)f2bf(au * (acc[pt][cb][r] + bs)); } }
  }
  __syncthreads();
}
constexpr float ATT_THR = 8.f;
template <bool FIRST> __device__ __forceinline__ void att_partialSM(f32x16& p0, f32x16& p1, float& m_reg, float& alpha, f32x16& nm) {
  float pmax = p0[0];
#pragma unroll
  for (int r = 1; r < 16; ++r) pmax = fmaxf(pmax, p0[r]);
#pragma unroll
  for (int r = 0; r < 16; ++r) pmax = fmaxf(pmax, p1[r]);
  { auto rr = __builtin_amdgcn_permlane32_swap(__float_as_uint(pmax), opq(__float_as_uint(pmax)), false, false); const unsigned r0 = rr[0], r1 = rr[1]; pmax = fmaxf(__uint_as_float(r0), __uint_as_float(r1)); }
  if (FIRST) { m_reg = pmax; alpha = 1.f;
#pragma unroll
    for (int r = 0; r < 16; ++r) { p0[r] -= pmax; p1[r] -= pmax; nm[r] = -pmax; } }
  else if (__builtin_expect(__all(pmax <= ATT_THR), 1)) { alpha = 1.f; }
  else { const float d = fmaxf(pmax, 0.f); alpha = __builtin_amdgcn_exp2f(-d); m_reg += d; const float nmv = -m_reg;
#pragma unroll
    for (int r = 0; r < 16; ++r) { p0[r] -= d; p1[r] -= d; nm[r] = nmv; } }
#pragma unroll
  for (int r = 0; r < 16; ++r) p0[r] = __builtin_amdgcn_exp2f(p0[r]);
}
__device__ __forceinline__ void att_finishSM(f32x16& p0, f32x16& p1, float alpha, float& l_reg, bf16x8& pa0, bf16x8& pa1, bf16x8& pa2, bf16x8& pa3) {
#pragma unroll
  for (int r = 0; r < 16; ++r) p1[r] = __builtin_amdgcn_exp2f(p1[r]);
  f32x2 ps2 = {0.f, 0.f};
#pragma unroll
  for (int r = 0; r < 16; r += 2) { ps2 += (f32x2){p0[r], p0[r + 1]}; ps2 += (f32x2){p1[r], p1[r + 1]}; }
  float ps = ps2[0] + ps2[1];
  { auto rr = __builtin_amdgcn_permlane32_swap(__float_as_uint(ps), opq(__float_as_uint(ps)), false, false); const unsigned r0 = rr[0], r1 = rr[1]; ps = __uint_as_float(r0) + __uint_as_float(r1); }
  l_reg = l_reg * alpha + ps;
#define PK4(P, BASE, OUT) do { unsigned a0 = cvt_pk_bf16(P[BASE + 0], P[BASE + 1]), a1 = cvt_pk_bf16(P[BASE + 2], P[BASE + 3]);   \
    unsigned b0 = cvt_pk_bf16(P[BASE + 4], P[BASE + 5]), b1 = cvt_pk_bf16(P[BASE + 6], P[BASE + 7]);                              \
    auto r0 = __builtin_amdgcn_permlane32_swap(a0, b0, false, false); auto r1 = __builtin_amdgcn_permlane32_swap(a1, b1, false, false); \
    v4u w = {r0[0], r1[0], r0[1], r1[1]}; OUT = __builtin_bit_cast(bf16x8, w); } while (0)
  PK4(p0, 0, pa0); PK4(p0, 8, pa1); PK4(p1, 0, pa2); PK4(p1, 8, pa3);
#undef PK4
}
template <int DK> __device__ __forceinline__ void att_qkt(f32x16& p0, f32x16& p1, const LAS unsigned char* Ks, const bf16x8* qr, int r32, int hi, const f32x16& nm) {
#pragma unroll
  for (int d0 = 0; d0 < DK / 16; ++d0) { const LAS unsigned char* kb = Ks + (2 * d0 + hi) * 1024 + r32 * 16;
    const bf16x8 b0 = *(const LAS bf16x8*)kb, b1 = *(const LAS bf16x8*)(kb + 512);
    if (d0 == 0) { p0 = __builtin_amdgcn_mfma_f32_32x32x16_bf16(b0, qr[d0], nm, 0, 0, 0); p1 = __builtin_amdgcn_mfma_f32_32x32x16_bf16(b1, qr[d0], nm, 0, 0, 0); }
    else { p0 = __builtin_amdgcn_mfma_f32_32x32x16_bf16(b0, qr[d0], p0, 0, 0, 0); p1 = __builtin_amdgcn_mfma_f32_32x32x16_bf16(b1, qr[d0], p1, 0, 0, 0); } }
}
template <int D0> __device__ __forceinline__ void att_pv_one(f32x16& od, int vb, bf16x8 pa0, bf16x8 pa1, bf16x8 pa2, bf16x8 pa3) {
  const s16x4 l0 = tr_read<v_rd_off<2>(D0, 0, 0)>(vb), h0 = tr_read<v_rd_off<2>(D0, 0, 1)>(vb), l1 = tr_read<v_rd_off<2>(D0, 1, 0)>(vb), h1 = tr_read<v_rd_off<2>(D0, 1, 1)>(vb);
  const s16x4 l2 = tr_read<v_rd_off<2>(D0, 2, 0)>(vb), h2 = tr_read<v_rd_off<2>(D0, 2, 1)>(vb), l3 = tr_read<v_rd_off<2>(D0, 3, 0)>(vb), h3 = tr_read<v_rd_off<2>(D0, 3, 1)>(vb);
  asm volatile("s_waitcnt lgkmcnt(0)" ::: "memory"); SBAR();
#define PK(Lx, Hx) (bf16x8){Lx[0], Lx[1], Lx[2], Lx[3], Hx[0], Hx[1], Hx[2], Hx[3]}
  od = __builtin_amdgcn_mfma_f32_32x32x16_bf16(pa0, PK(l0, h0), od, 0, 0, 0);
  od = __builtin_amdgcn_mfma_f32_32x32x16_bf16(pa1, PK(l1, h1), od, 0, 0, 0);
  od = __builtin_amdgcn_mfma_f32_32x32x16_bf16(pa2, PK(l2, h2), od, 0, 0, 0);
  od = __builtin_amdgcn_mfma_f32_32x32x16_bf16(pa3, PK(l3, h3), od, 0, 0, 0);
#undef PK
}
template <int DK>
__device__ __forceinline__ void attn_unit(LAS unsigned char* lds, const int tid, const bf16* __restrict__ Qb, const unsigned char* __restrict__ Kt, const unsigned char* __restrict__ Vt, const int NT, bf16* Ob) {
  constexpr int KB = DK * 128, ND = DK / 16;
  const int wid = __builtin_amdgcn_readfirstlane(tid >> 6), lane = tid & 63, r32 = lane & 31, hi = lane >> 5;
  LAS unsigned char* Vl = lds; LAS unsigned char* Kl = lds + 16384; LAS float* wsf = (LAS float*)(lds + 16384 + 2 * KB) + wid * 64; LAS float* li_l = wsf; LAS float* al_l = wsf + 32;
  LAS bf16* stg = (LAS bf16*)(lds + 16384 + 2 * KB + 2048) + wid * 2048;
  float m_reg = 0.f, l_reg = 0.f; f32x16 o[2] = {f32x16{}, f32x16{}}; f32x16 nm = f32x16{}; bf16x8 qr[ND];
  const bf16* Qw = Qb + (size_t)(wid * 32 + r32) * DK + hi * 8;
#pragma unroll
  for (int d0 = 0; d0 < ND; ++d0) qr[d0] = *(const bf16x8*)(Qw + d0 * 16);
  const bool has2 = (DK == 96) && (wid < 4);
  const int vb0 = (int)(uintptr_t)Vl + v_rd_base(lane);
  struct { v4u k0, k1, v; } sr_[2];
#define SLOAD(i, tl) do { const unsigned char* kp_ = Kt + (size_t)(tl) * KB + tid * 16; sr_[i].k0 = *(const v4u*)kp_; if (has2) sr_[i].k1 = *(const v4u*)(kp_ + 8192); sr_[i].v = *(const v4u*)(Vt + (size_t)(tl) * 8192 + tid * 16); } while (0)
#define SWRITE(b, i) do { *(LAS v4u*)(Kl + (b) * KB + tid * 16) = sr_[i].k0; if (has2) *(LAS v4u*)(Kl + (b) * KB + 8192 + tid * 16) = sr_[i].k1; *(LAS v4u*)(Vl + (b) * 8192 + tid * 16) = sr_[i].v; } while (0)
#define RESC(a) do { if (__any((a) < 1.f)) { if (hi == 0) al_l[r32] = (a); asm volatile("s_waitcnt lgkmcnt(0)" ::: "memory"); \
    _Pragma("unroll") for (int d = 0; d < 2; ++d) _Pragma("unroll") for (int r = 0; r < 16; ++r) o[d][r] *= al_l[crow(r, hi)]; } } while (0)
  f32x16 pA0, pA1, pB0, pB1; float alA, alB; bf16x8 pa0, pa1, pa2, pa3;
  SLOAD(0, 0); SWRITE(0, 0); __syncthreads();
  att_qkt<DK>(pA0, pA1, Kl, qr, r32, hi, nm); att_partialSM<true>(pA0, pA1, m_reg, alA, nm);
  SLOAD(1, 1); SLOAD(0, 2);
  SWRITE(1, 1); __syncthreads();
#pragma unroll 1
  for (int j = 1; j + 1 < NT; j += 2) {
    SBAR(); att_qkt<DK>(pB0, pB1, Kl + KB, qr, r32, hi, nm);
    att_finishSM(pA0, pA1, alA, l_reg, pa0, pa1, pa2, pa3); SBAR();
    SLOAD(1, j + 2); SBAR();
    att_pv_one<0>(o[0], vb0, pa0, pa1, pa2, pa3); att_pv_one<1>(o[1], vb0, pa0, pa1, pa2, pa3); att_partialSM<false>(pB0, pB1, m_reg, alB, nm);
    __syncthreads(); SWRITE(0, 0);
    RESC(alB); __syncthreads();
    SBAR(); att_qkt<DK>(pA0, pA1, Kl, qr, r32, hi, nm);
    att_finishSM(pB0, pB1, alB, l_reg, pa0, pa1, pa2, pa3); SBAR();
    if (j + 3 < NT) SLOAD(0, j + 3); SBAR();
    att_pv_one<0>(o[0], vb0 + 8192, pa0, pa1, pa2, pa3); att_pv_one<1>(o[1], vb0 + 8192, pa0, pa1, pa2, pa3); att_partialSM<false>(pA0, pA1, m_reg, alA, nm);
    __syncthreads(); SWRITE(1, 1);
    RESC(alA); __syncthreads();
  }
  SBAR(); att_qkt<DK>(pB0, pB1, Kl + KB, qr, r32, hi, nm);
  att_finishSM(pA0, pA1, alA, l_reg, pa0, pa1, pa2, pa3); SBAR();
  att_pv_one<0>(o[0], vb0, pa0, pa1, pa2, pa3); att_pv_one<1>(o[1], vb0, pa0, pa1, pa2, pa3); att_partialSM<false>(pB0, pB1, m_reg, alB, nm);
  __syncthreads(); RESC(alB);
  att_finishSM(pB0, pB1, alB, l_reg, pa0, pa1, pa2, pa3); SBAR();
  att_pv_one<0>(o[0], vb0 + 8192, pa0, pa1, pa2, pa3); att_pv_one<1>(o[1], vb0 + 8192, pa0, pa1, pa2, pa3);
  if (hi == 0) li_l[r32] = l_reg; asm volatile("s_waitcnt lgkmcnt(0)" ::: "memory");
#pragma unroll
  for (int r = 0; r < 16; ++r) { const float rl = __builtin_amdgcn_rcpf(li_l[crow(r, hi)]); const int orow = crow(r, hi);
    stg[orow * 64 + r32] = (bf16)f2bf(o[0][r] * rl); stg[orow * 64 + 32 + r32] = (bf16)f2bf(o[1][r] * rl); }
  asm volatile("s_waitcnt lgkmcnt(0)" ::: "memory");
#pragma unroll
  for (int i = 0; i < 4; ++i) { const int row = i * 8 + (lane >> 3), ch = lane & 7; const v4u v = *(const LAS v4u*)(stg + row * 64 + ch * 8); *(v4u*)(Ob + (size_t)(wid * 32 + row) * D + ch * 8) = v; }
#undef SLOAD
#undef SWRITE
#undef RESC
}
__device__ __forceinline__ void phase_attn(Ctx& F, const Args& A, bool skipctx = false) {
  for (int i = 0;; ++i) {
    const int Lx = i * F.G + (int)blockIdx.x; if (Lx >= (skipctx ? 512 : 576)) break;
    int kind, b, h, qb;
    if (Lx < 512) { kind = Lx >> 8; const int rem = Lx & 255; b = rem & 7; const int idx = rem >> 3; h = idx >> 3; qb = 1 + (idx & 7); }
    else { const int ll = Lx - 512; b = ll & 7; const int j = ll >> 3; kind = j >> 2; h = j & 3; qb = 0; }
    const int NT = qb == 0 ? 4 : NKT;
    bf16* Ob = (bf16*)(F.ws + WS_Y) + (size_t)(b * NTOK + qb * 256) * D + (kind == 0 ? 256 : 768) + h * 64;
    if (kind == 0) attn_unit<96>(F.lds, F.tid, (const bf16*)(F.ws + WS_QM) + ((size_t)(b * 4 + h) * NTOK + qb * 256) * 96, F.ws + WS_KM + (size_t)(b * 4 + h) * NKT * 12288, F.ws + WS_VM + (size_t)(b * 4 + h) * NKT * 8192, NT, Ob);
    else attn_unit<64>(F.lds, F.tid, (const bf16*)(F.ws + WS_QD) + ((size_t)(b * 4 + h) * NTOK + qb * 256) * 64, F.ws + WS_KD + (size_t)(b * 2 + (h >> 1)) * NKT * 8192, F.ws + WS_VD + (size_t)(b * 2 + (h >> 1)) * NKT * 8192, NT, Ob);
  }
  __syncthreads();
}
__device__ __forceinline__ void phase_b(Ctx& F, const Args& A, int l) {
  phase_b_rows(F, A, l);
  refresh_ctx(F, A);
  const bool split = F.G >= 200; const int c = (int)blockIdx.x;
  if (!split || c >= 144) {
    const int gsub = split ? F.G - 144 : F.G, csub = split ? c - 144 : c;
    { SliceSched S; S.o.init(NROWT, 2, gsub, csub); S.A = (const char*)(F.ws + WS_ZB) + ZB_MQ * 2; S.B = (const char*)(F.ws + WS_WUQ + l * SZ_WUQ1);
      EpiQm E{(const float*)(F.ws + WS_RSS), (bf16*)(F.ws + WS_QM)}; gemm_phase<EpiQm, SliceSched, true>(F.lds, F.tid, ZBW * 2, 512, 256, S, E); }
    refresh_ctx(F, A);
    { SliceSched S; S.o.init(NROWT, 2, gsub, csub); S.A = (const char*)(F.ws + WS_ZB) + ZB_MKV * 2; S.B = (const char*)(F.ws + WS_WUKV + l * SZ_WUKV1);
      EpiKVm E{(const float*)(F.ws + WS_RSS), F.ws}; gemm_phase<EpiKVm, SliceSched, true>(F.lds, F.tid, ZBW * 2, 512, 256, S, E); }
    refresh_ctx(F, A);
  }
  if (!split) phase_b_chunkmix(F, A, l, c, F.G); else if (c < 144) phase_b_chunkmix(F, A, l, c, 144);
}
}
namespace mk {
__device__ __forceinline__ void phase_norm_mod(Ctx& F, const Args& A, int l, bool dry = false) {
  const int gw = F.vcu * NWAVES + F.wave, NGW = F.G * NWAVES, lane = F.lane;
  if (F.vcu < 9 && !dry) {
    const int r = F.vcu; const float* sh = (const float*)(F.ws + WS_MOD) + (size_t)l * 9 * 6 * D + (size_t)r * 6 * D + 3 * D;
    const float* wgr = A.in[21] + (size_t)l * D * 4; const float* bgr = A.in[22] + l * 4; const float* wer = A.in[23] + (size_t)l * D * 32; const float* ber = A.in[24] + l * 32;
    for (int j = F.wave; j < 36; j += NWAVES) { float s = 0.f;
#pragma unroll 4
      for (int i = 0; i < 16; ++i) { const int k = lane + 64 * i; s += sh[k] * (j < 4 ? wgr[k * 4 + j] : wer[k * 32 + (j - 4)]); }
      s = wave_sum(s); if (lane == 0) ((float*)(F.ws + WS_CJ))[l * (9 * 36) + r * 36 + j] = s + (j < 4 ? bgr[j] : ber[j - 4]); } }
  bf16* hs = (bf16*)(F.ws + WS_HS); bf16* hn = (bf16*)(F.ws + WS_HN); const float* mod = (const float*)(F.ws + WS_MOD) + (size_t)l * 9 * 6 * D;
  const int* tok_e = (const int*)(F.ws + WS_TOKE); const int* tok_r = (const int*)(F.ws + WS_TOKR); const float* tok_w = (const float*)(F.ws + WS_TOKW); const bf16* fs = (const bf16*)(F.ws + WS_FS);
  const LAS int* ps = (const LAS int*)(F.lds + XSCR_OFF); if (l > 0 && !dry) moe_tables(F, A, l - 1);
  for (int m = gw; m < T; m += NGW) {
    const int b = m / NTOK, t = m % NTOK, r = t < NCTX ? 8 : b;
    const float4* xr = t < NCTX ? (const float4*)(A.in[2] + ((size_t)b * NCTX + t) * D) : (const float4*)(A.in[0] + ((size_t)b * NLAT + (t - NCTX)) * D); const v2u* hr = (const v2u*)(hs + (size_t)m * D);
    const float4* sh = (const float4*)(mod + (size_t)r * 6 * D); const float4* sc = sh + D / 4;
    float4 v[4]; float ss = 0.f;
    if (l == 0 && !dry) {
#pragma unroll
      for (int j = 0; j < 4; ++j) v[j] = xr[lane + 64 * j]; }
    else {
#pragma unroll
      for (int j = 0; j < 4; ++j) { const v2u w = hr[lane + 64 * j]; v[j] = make_float4(bflo(w.x), bfhi(w.x), bflo(w.y), bfhi(w.y)); } }
    if (l > 0 && !dry) { const int s0 = ps[tok_e[2 * m]] + tok_r[2 * m], s1 = ps[tok_e[2 * m + 1]] + tok_r[2 * m + 1]; const float w0 = tok_w[2 * m], w1 = tok_w[2 * m + 1]; const float4* g5 = (const float4*)(mod - (size_t)9 * 6 * D + (size_t)r * 6 * D + 5 * D);
#pragma unroll
      for (int j = 0; j < 4; ++j) { const int c4 = lane + 64 * j; const v2u a = ((const v2u*)(fs + (size_t)s0 * D))[c4], bq = ((const v2u*)(fs + (size_t)s1 * D))[c4]; const float4 g = g5[c4];
        v[j].x += g.x * (w0 * bflo(a.x) + w1 * bflo(bq.x)); v[j].y += g.y * (w0 * bfhi(a.x) + w1 * bfhi(bq.x)); v[j].z += g.z * (w0 * bflo(a.y) + w1 * bflo(bq.y)); v[j].w += g.w * (w0 * bfhi(a.y) + w1 * bfhi(bq.y)); } }
#pragma unroll
    for (int j = 0; j < 4; ++j) { v2u w; w.x = pk2(v[j].x, v[j].y); w.y = pk2(v[j].z, v[j].w); ((v2u*)(hs + (size_t)m * D))[lane + 64 * j] = w;
      v[j] = make_float4(bflo(w.x), bfhi(w.x), bflo(w.y), bfhi(w.y)); ss += v[j].x * v[j].x + v[j].y * v[j].y + v[j].z * v[j].z + v[j].w * v[j].w; }
    const float rinv = rsqrtf(wave_sum(ss) * (1.f / D) + EPS);
#pragma unroll
    for (int j = 0; j < 4; ++j) { const float4 a = sc[lane + 64 * j], s4 = sh[lane + 64 * j];
      v2u o; o.x = pk2(v[j].x * rinv * (1.f + a.x) + s4.x, v[j].y * rinv * (1.f + a.y) + s4.y); o.y = pk2(v[j].z * rinv * (1.f + a.z) + s4.z, v[j].w * rinv * (1.f + a.w) + s4.w);
      ((v2u*)(hn + (size_t)m * D))[lane + 64 * j] = o;
      { const float h0 = v[j].x * rinv * (1.f + a.x) + s4.x, h1 = v[j].y * rinv * (1.f + a.y) + s4.y, h2 = v[j].z * rinv * (1.f + a.z) + s4.z, h3 = v[j].w * rinv * (1.f + a.w) + s4.w;
        int w8 = 0; w8 = __builtin_amdgcn_cvt_pk_fp8_f32(h0, h1, w8, false); w8 = __builtin_amdgcn_cvt_pk_fp8_f32(h2, h3, w8, true); ((int*)(F.ws + WS_HN8 + (size_t)m * D))[lane + 64 * j] = w8; } }
  }
}
__device__ __forceinline__ void phase_final(Ctx& F, const Args& A) {
  const int gw = F.vcu * NWAVES + F.wave, NGW = F.G * NWAVES, lane = F.lane;
  const bf16* hs = (const bf16*)(F.ws + WS_HS); const float* mod = (const float*)(F.ws + WS_MOD) + (size_t)(L - 1) * 9 * 6 * D; const float4* fg = (const float4*)A.in[27];
  const int* tok_e = (const int*)(F.ws + WS_TOKE); const int* tok_r = (const int*)(F.ws + WS_TOKR); const float* tok_w = (const float*)(F.ws + WS_TOKW); const bf16* fs = (const bf16*)(F.ws + WS_FS);
  const LAS int* ps = (const LAS int*)(F.lds + XSCR_OFF); moe_tables(F, A, L - 1);
  for (int rI = gw; rI < NB * NLAT; rI += NGW) {
    const int b = rI / NLAT, tl = rI % NLAT; const size_t m = (size_t)b * NTOK + NCTX + tl;
    const v2u* xr = (const v2u*)(hs + m * D); float4 v[4]; float ss = 0.f;
    const int s0 = ps[tok_e[2 * m]] + tok_r[2 * m], s1 = ps[tok_e[2 * m + 1]] + tok_r[2 * m + 1]; const float w0 = tok_w[2 * m], w1 = tok_w[2 * m + 1]; const float4* g5 = (const float4*)(mod + (size_t)b * 6 * D + 5 * D);
#pragma unroll
    for (int j = 0; j < 4; ++j) { const int c4 = lane + 64 * j; { const v2u w = xr[c4]; v[j] = make_float4(bflo(w.x), bfhi(w.x), bflo(w.y), bfhi(w.y)); } const v2u a = ((const v2u*)(fs + (size_t)s0 * D))[c4], bq = ((const v2u*)(fs + (size_t)s1 * D))[c4]; const float4 g = g5[c4];
      v[j].x += g.x * (w0 * bflo(a.x) + w1 * bflo(bq.x)); v[j].y += g.y * (w0 * bfhi(a.x) + w1 * bfhi(bq.x)); v[j].z += g.z * (w0 * bflo(a.y) + w1 * bflo(bq.y)); v[j].w += g.w * (w0 * bfhi(a.y) + w1 * bfhi(bq.y));
      ss += v[j].x * v[j].x + v[j].y * v[j].y + v[j].z * v[j].z + v[j].w * v[j].w; }
    const float rinv = rsqrtf(wave_sum(ss) * (1.f / D) + EPS);
#pragma unroll
    for (int j = 0; j < 4; ++j) { const float4 g = fg[lane + 64 * j]; float4 o; o.x = v[j].x * rinv * g.x; o.y = v[j].y * rinv * g.y; o.z = v[j].z * rinv * g.z; o.w = v[j].w * rinv * g.w; ((float4*)(A.out + (size_t)rI * D))[lane + 64 * j] = o; }
  }
}
constexpr int CW_BAR = 16384;
__global__ void __launch_bounds__(NTHR, 2) mk_kernel(Args a) {
  extern __shared__ __attribute__((aligned(16))) unsigned char lds_raw[];
  Ctx F; F.lds = (LAS unsigned char*)lds_raw; F.ws = a.ws;
  { const int t0 = threadIdx.x; F.wave = __builtin_amdgcn_readfirstlane(t0 >> 6); }
  F.lane = (int)__builtin_amdgcn_mbcnt_hi(~0u, __builtin_amdgcn_mbcnt_lo(~0u, 0u)); F.tid = F.wave * 64 + F.lane;
  F.G = gridDim.x; { const int bx = blockIdx.x; F.vcu = (F.G % 8 == 0) ? (bx % 8) * (F.G / 8) + bx / 8 : bx; }
  volatile LAS unsigned* st = (volatile LAS unsigned*)(F.lds + MISC_OFF);
  if (F.tid < 4) st[F.tid] = 0u;
  __syncthreads();
  XcdBarrier bar = xcd_barrier_post((unsigned*)(F.ws + WS_CTL) + CW_BAR, st, F.tid == 0);
#define GRID_BAR() do { { unsigned char* w_ = a.ws; asm volatile("" : "+s"(w_)); unsigned x_ = bar.x; asm volatile("" : "+s"(x_)); bar.x = x_; bar.bar = (unsigned*)(w_ + WS_CTL) + CW_BAR; xcd_barrier(bar, F.tid == 0); F.ws = w_; } \
    int wv_ = F.wave; asm volatile("" : "+s"(wv_)); F.wave = wv_; unsigned z_ = 0u; asm volatile("" : "+v"(z_)); const int l_ = (int)__builtin_amdgcn_mbcnt_hi(~0u, __builtin_amdgcn_mbcnt_lo(~0u, z_)); F.lane = l_; F.tid = wv_ * 64 + l_; } while (0)
#ifndef DUP
#define DUP 0
#endif
#ifndef GPM
#define GPM 0
#endif
  phase_prep(F, a); GRID_BAR();
  if (DUP & 256) { phase_prep(F, a); GRID_BAR(); }
#pragma unroll 1
  for (int l = 0; l < L; ++l) {
    phase_norm_mod(F, a, l); GRID_BAR();
    phase_zgemm(F, a, l); GRID_BAR();
    if (DUP & 1) { phase_zgemm(F, a, l, GPM); GRID_BAR(); }
    phase_b(F, a, l); GRID_BAR();
    if (DUP & 2) { phase_b(F, a, l); GRID_BAR(); }
    if (DUP & 8192) { phase_b_rows(F, a, l); GRID_BAR(); }
    if (DUP & 16384) { const int c = (int)blockIdx.x; if (c < 144) phase_b_chunkmix(F, a, l, c, 144); GRID_BAR(); }
    const bool lastl = l == L - 1;
    phase_attn(F, a, lastl); GRID_BAR();
    phase_branch(F, a, l, lastl);
    if (F.G == 256) refresh_ctx(F, a); else GRID_BAR();
    phase_gate(F, a, l, lastl);
    if (F.G == 256) refresh_ctx(F, a); else GRID_BAR();
    phase_out(F, a, l, 1.f, F.G == 256, lastl); GRID_BAR();
    phase_norm_router(F, a, l, l == L - 1); GRID_BAR();
    phase_moe_gu(F, a, l); GRID_BAR();
    phase_moe_dn(F, a, l); GRID_BAR();
    if (DUP & 1024) { phase_norm_mod(F, a, l, true); GRID_BAR(); }
    if (DUP & 2048) { phase_out(F, a, l, 0.f, false); GRID_BAR(); }
    if (DUP & 128) { phase_gate<GPM>(F, a, l, lastl, CW_TILE); GRID_BAR(); }
    if (DUP & 64) { phase_gate(F, a, l, lastl, CW_TILE); refresh_ctx(F, a); phase_out(F, a, l, 0.f, true, lastl, CW_TILE); GRID_BAR(); }
    if (DUP & 4096) { phase_norm_router(F, a, l, l == L - 1, true); GRID_BAR(); }
    if (DUP & 512) { GRID_BAR(); GRID_BAR(); GRID_BAR(); GRID_BAR(); GRID_BAR(); GRID_BAR(); GRID_BAR(); GRID_BAR(); GRID_BAR(); GRID_BAR(); }
  }
  phase_final(F, a);
}
}

extern "C" void kernel_launch(void* const* d_in, const int* in_sizes, int n_in, void* d_out, int out_size, void* d_ws, size_t ws_size, hipStream_t stream) {
  using namespace mk;
  static int grid = 0;
  if (grid == 0) {
    int dev = 0, cus = 0, per_cu = 0;
    hipGetDevice(&dev); hipDeviceGetAttribute(&cus, hipDeviceAttributeMultiprocessorCount, dev);
    hipFuncSetAttribute((const void*)mk_kernel, hipFuncAttributeMaxDynamicSharedMemorySize, LDS_BYTES);
    hipOccupancyMaxActiveBlocksPerMultiprocessor(&per_cu, (const void*)mk_kernel, NTHR, LDS_BYTES);
    grid = per_cu >= 1 ? cus : -1;
  }
  if (grid < 0 || WS_END3 > ws_size) { fprintf(stderr, "kernel_launch: cannot run (grid %d, ws need %zu have %zu)\n", grid, (size_t)WS_END3, ws_size); (void)hipMemsetAsync(d_out, 0xFF, (size_t)out_size * 4, stream); return; }
  Args a{}; for (int i = 0; i < 28; ++i) a.in[i] = (const float*)d_in[i]; a.out = (float*)d_out; a.ws = (unsigned char*)d_ws;
  (void)hipMemsetAsync(d_ws, 0, CTL_BYTES, stream);
  void* args[] = {&a};
  hipError_t e = hipLaunchCooperativeKernel((const void*)mk_kernel, dim3(grid), dim3(NTHR), args, LDS_BYTES, stream);
  if (e != hipSuccess) fprintf(stderr, "kernel_launch: cooperative launch failed: %s (grid %d)\n", hipGetErrorString(e), grid);
}
```

```cpp
#include <hip/hip_runtime.h>
#include <cstdio>
#include <cstdint>
namespace g8 {
#define G8_LAS __attribute__((address_space(3)))
typedef unsigned short bf16_t;
typedef short bf16x8 __attribute__((ext_vector_type(8)));
typedef float f32x4 __attribute__((ext_vector_type(4)));
typedef float f32x2 __attribute__((ext_vector_type(2)));
typedef unsigned u32x4 __attribute__((ext_vector_type(4)));
typedef unsigned u32x2 __attribute__((ext_vector_type(2)));
typedef int i32x4 __attribute__((ext_vector_type(4)));
typedef int i32x8 __attribute__((ext_vector_type(8)));
constexpr int BM = 256, BK = 64, HALF = 128, HTB = HALF * BK * 2, STAGE_BYTES = 8 * HTB;

__host__ __device__ __forceinline__ int lds_byte(int r, int c) { const int st = (r >> 4) * 2 + (c >> 5), rr = r & 15, cc = c & 31, ob = rr * 64 + cc * 2; return st * 1024 + (ob ^ (((ob >> 9) & 1) << 5)); }
__host__ __device__ __forceinline__ void stage_rc(int b, int& R, int& C) { const int st = b / 1024, sb = b % 1024, swz = sb ^ (((sb >> 9) & 1) << 5); R = (st >> 1) * 16 + swz / 64; C = (st & 1) * 32 + (swz % 64) / 2; }
__host__ __device__ __forceinline__ int perm32(int rho) { const int n = rho >> 4, i = rho & 15; return 8 * (i >> 2) + 4 * n + (i & 3); }

struct Unit { const char* a; const char* b; const int* rows; int pm, pn, aux, nv; };

__device__ __forceinline__ unsigned cvt_pk_bf16(float lo, float hi) { unsigned r; asm volatile("v_cvt_pk_bf16_f32 %0, %1, %2" : "=v"(r) : "v"(lo), "v"(hi)); return r; }

template <class...> using void_tt = void;
template <class E, class = void> struct has_acc_init { static constexpr bool value = false; };
template <class E> struct has_acc_init<E, void_tt<decltype(&E::acc_init)>> { static constexpr bool value = true; };
template <class Epi, class Sched, bool ALIGN_EPI, bool GATHER = false, bool FP8 = false>
__device__ __forceinline__ void gemm_phase(G8_LAS unsigned char* lds, const int tid, const int ldaB, const int ldbB, const int K, const Sched& S, const Epi& E) {
    const int wid = __builtin_amdgcn_readfirstlane(tid >> 6), lane = tid & 63, wr = wid >> 2, wc = wid & 3, fr = lane & 15, fq = lane >> 4;
    const int nt = K / BK;
    unsigned voffA[2], voffB[2]; int Rr[2], Cc2[2];
#pragma unroll
    for (int i = 0; i < 2; ++i) { int R, C; stage_rc(tid * 16 + i * 8192, R, C); const int Rb = Epi::PERM ? ((R & ~31) + perm32(R & 31)) : R; Rr[i] = R; Cc2[i] = C * 2;
        voffA[i] = (unsigned)(R * ldaB + C * 2); voffB[i] = (unsigned)(Rb * ldbB + C * 2); }
    const size_t kstep = (size_t)(BK * 2);
    const size_t hstepA = (size_t)HALF * ldaB, hstepB = (size_t)HALF * ldbB;
    const unsigned ldsw = (unsigned)wid * 1024u;
    const G8_LAS unsigned char* abase = lds + (FP8 ? lds_byte(wr * 64 + fr, fq * 16) : lds_byte(wr * 64 + fr, fq * 8));
    const G8_LAS unsigned char* bbase = lds + 4 * HTB + (FP8 ? lds_byte(wc * 32 + fr, fq * 16) : lds_byte(wc * 32 + fr, fq * 8));
#define G8_SA(b, h) (((b) * 2 + (h)) * HTB)
#define G8_SB(b, h) ((4 + (b) * 2 + (h)) * HTB)
#define G8_STAGE(bufoff, gbase, voff) do { _Pragma("unroll") for (int _i = 0; _i < 2; ++_i) \
        __builtin_amdgcn_global_load_lds((const unsigned*)((const char*)(gbase) + (voff)[_i]), (G8_LAS unsigned*)(lds + (bufoff) + ldsw + _i * 8192), 16, 0, 0); } while (0)
#define G8_STAGE_A(bufoff, h, base, nx) do { if constexpr (GATHER) { unsigned vo_[2] = {(nx) ? gvN[h][0] : gvC[h][0], (nx) ? gvN[h][1] : gvC[h][1]}; G8_STAGE(bufoff, base, vo_); } else { G8_STAGE(bufoff, (base) + ((h) ? hstepA : 0), voffA); } } while (0)
#define G8_LDA(dst, b, h) do { if constexpr (FP8) { _Pragma("unroll") for (int m = 0; m < 4; ++m) dst##8[m] = *(const G8_LAS i32x8*)(abase + (G8_SA(b, h) + m * 2048)); } \
      else { _Pragma("unroll") for (int m = 0; m < 4; ++m) _Pragma("unroll") for (int k = 0; k < 2; ++k) dst[m][k] = *(const G8_LAS bf16x8*)(abase + (G8_SA(b, h) + m * 2048 + k * 1024)); } } while (0)
#define G8_LDB(dst, b, h) do { if constexpr (FP8) { _Pragma("unroll") for (int n = 0; n < 2; ++n) dst##8[n] = *(const G8_LAS i32x8*)(bbase + (((b) * 2 + (h)) * HTB + n * 2048)); } \
      else { _Pragma("unroll") for (int n = 0; n < 2; ++n) _Pragma("unroll") for (int k = 0; k < 2; ++k) dst[n][k] = *(const G8_LAS bf16x8*)(bbase + (((b) * 2 + (h)) * HTB + n * 2048 + k * 1024)); } } while (0)
#define G8_MMA(ai, bj, At, Bt) do { __builtin_amdgcn_s_setprio(1); if constexpr (FP8) { _Pragma("unroll") for (int m = 0; m < 4; ++m) _Pragma("unroll") for (int n = 0; n < 2; ++n) \
        asm volatile("v_mfma_scale_f32_16x16x128_f8f6f4 %0, %1, %2, %0, %3, %3 op_sel_hi:[0,0,0]" : "+v"(acc[ai][bj][m][n]) : "v"(Bt##8[n]), "v"(At##8[m]), "v"(sc1f8)); } \
      else { _Pragma("unroll") for (int m = 0; m < 4; ++m) _Pragma("unroll") for (int n = 0; n < 2; ++n) _Pragma("unroll") for (int k = 0; k < 2; ++k) \
        acc[ai][bj][m][n] = __builtin_amdgcn_mfma_f32_16x16x32_bf16(Bt[n][k], At[m][k], acc[ai][bj][m][n], 0, 0, 0); } __builtin_amdgcn_s_setprio(0); } while (0)
#define G8_WAIT_V(n) asm volatile("s_waitcnt vmcnt(" #n ")" ::: "memory")
#define G8_WAIT_L(n) asm volatile("s_waitcnt lgkmcnt(" #n ")" ::: "memory")
#define G8_BAR __builtin_amdgcn_s_barrier()
#define G8_SCHED __builtin_amdgcn_sched_barrier(0)
    Unit cur, nxt; int ui = 0;
    if (!S.next(0, cur)) return;
    f32x4 acc[2][2][4][2];
#pragma unroll
    for (int a = 0; a < 2; ++a)
#pragma unroll
        for (int b = 0; b < 2; ++b)
#pragma unroll
            for (int m = 0; m < 4; ++m)
#pragma unroll
                for (int n = 0; n < 2; ++n) acc[a][b][m][n] = (f32x4){0.f, 0.f, 0.f, 0.f};
    if constexpr (has_acc_init<Epi>::value) E.acc_init(acc, cur, wr, wc, fr, fq);
    bf16x8 At[4][2], B0[2][2], B1[2][2]; i32x8 At8[4], B08[2], B18[2];
    int sc1f8 = 0x7F7F7F7F; if constexpr (FP8) asm volatile("" : "+v"(sc1f8));
    const char* cA = cur.a; const char* cB = cur.b;
    S.a_ready(cur, tid);
    unsigned gvC[2][2], gvN[2][2];
    if constexpr (GATHER) {
#pragma unroll
        for (int h = 0; h < 2; ++h)
#pragma unroll
            for (int i = 0; i < 2; ++i) { gvC[h][i] = (h * 128 + Rr[i] < cur.nv ? (unsigned)cur.rows[h * 128 + Rr[i]] : 0u) * (unsigned)ldaB + (unsigned)Cc2[i]; gvN[h][i] = gvC[h][i]; } }
    G8_STAGE(G8_SB(0, 0), cB, voffB); G8_STAGE(G8_SB(0, 1), cB + hstepB, voffB); G8_STAGE_A(G8_SA(0, 0), 0, cA, false); G8_STAGE_A(G8_SA(0, 1), 1, cA, false);
    if (wr == 1) G8_BAR;
    G8_WAIT_V(2); G8_BAR;
    G8_STAGE(G8_SB(1, 0), cB + kstep, voffB); G8_STAGE_A(G8_SA(1, 0), 0, cA + kstep, false); G8_STAGE(G8_SB(1, 1), cB + hstepB + kstep, voffB);
    G8_WAIT_V(6); G8_BAR;
#pragma unroll 1
    for (;;) {
        const bool has_next = S.next(ui + 1, nxt);
        const char* nA = has_next ? nxt.a : cA; const char* nB = has_next ? nxt.b : cB;
        if constexpr (GATHER) { if (has_next) {
#pragma unroll
            for (int h = 0; h < 2; ++h)
#pragma unroll
                for (int i = 0; i < 2; ++i) gvN[h][i] = (h * 128 + Rr[i] < nxt.nv ? (unsigned)nxt.rows[h * 128 + Rr[i]] : 0u) * (unsigned)ldaB + (unsigned)Cc2[i]; } }
#pragma unroll 1
        for (int t = 0; t < nt; t += 2) {
            const bool last = (t == nt - 2);
            if (last && has_next) S.a_ready(nxt, tid);
            const char* a1 = cA + (size_t)(t + 1) * kstep;
            const char* a2 = last ? nA : cA + (size_t)(t + 2) * kstep; const char* b2 = last ? nB : cB + (size_t)(t + 2) * kstep;
            const char* a3 = a2 + kstep; const char* b3 = b2 + kstep;
            G8_LDB(B0, 0, 0); G8_LDB(B1, 0, 1); G8_SCHED; G8_LDA(At, 0, 0); G8_STAGE_A(G8_SA(1, 1), 1, a1, false);
            G8_WAIT_V(8); G8_WAIT_L(0); G8_BAR; G8_MMA(0, 0, At, B0); G8_MMA(0, 1, At, B1); G8_BAR; G8_SCHED;
            G8_LDA(At, 0, 1); G8_STAGE(G8_SB(0, 0), b2, voffB); G8_STAGE(G8_SB(0, 1), b2 + hstepB, voffB); G8_STAGE_A(G8_SA(0, 0), 0, a2, last);
            G8_WAIT_V(8); G8_WAIT_L(0); G8_BAR; G8_MMA(1, 0, At, B0); G8_MMA(1, 1, At, B1); G8_BAR; G8_SCHED;
            G8_LDB(B0, 1, 0); G8_LDB(B1, 1, 1); G8_SCHED; G8_LDA(At, 1, 0); G8_STAGE_A(G8_SA(0, 1), 1, a2, last);
            G8_WAIT_V(8); G8_WAIT_L(0); G8_BAR; G8_MMA(0, 0, At, B0); G8_MMA(0, 1, At, B1); G8_BAR; G8_SCHED;
            G8_LDA(At, 1, 1); G8_STAGE(G8_SB(1, 0), b3, voffB); G8_STAGE(G8_SB(1, 1), b3 + hstepB, voffB); G8_STAGE_A(G8_SA(1, 0), 0, a3, last);
            G8_WAIT_V(8); G8_WAIT_L(0); G8_BAR; G8_MMA(1, 0, At, B0); G8_MMA(1, 1, At, B1); G8_BAR; G8_SCHED;
        }
        if constexpr (FP8) asm volatile("s_nop 15\n\ts_nop 7" ::: "memory");
        if constexpr (ALIGN_EPI) { if (wr == 0) G8_BAR; }
        E(acc, cur, wr, wc, fr, fq);
        if (!has_next) break;
#pragma unroll
        for (int a = 0; a < 2; ++a)
#pragma unroll
            for (int b = 0; b < 2; ++b)
#pragma unroll
                for (int m = 0; m < 4; ++m)
#pragma unroll
                    for (int n = 0; n < 2; ++n) acc[a][b][m][n] = (f32x4){0.f, 0.f, 0.f, 0.f};
        if constexpr (has_acc_init<Epi>::value) E.acc_init(acc, nxt, wr, wc, fr, fq);
        cur = nxt; cA = nA; cB = nB; ++ui;
        if constexpr (GATHER) {
#pragma unroll
            for (int h = 0; h < 2; ++h)
#pragma unroll
                for (int i = 0; i < 2; ++i) gvC[h][i] = gvN[h][i]; }
        if constexpr (ALIGN_EPI) { if (wr == 1) G8_BAR; }
    }
    G8_WAIT_V(0);
    if constexpr (!ALIGN_EPI) { if (wr == 0) G8_BAR; }
    G8_BAR;
#undef G8_SA
#undef G8_SB
#undef G8_STAGE
#undef G8_STAGE_A
#undef G8_LDA
#undef G8_LDB
#undef G8_MMA
#undef G8_WAIT_V
#undef G8_WAIT_L
#undef G8_BAR
#undef G8_SCHED
}
}
namespace mk {
using namespace g8;
constexpr int NB = 8, NCTX = 256, NLAT = 2048, NTOK = NCTX + NLAT, T = NB * NTOK, D = 1024, L = 4, NE = 32;
constexpr int NWAVES = 8, NTHR = 512;
constexpr float EPS = 1e-6f;
constexpr int NROWT = T / 256;
constexpr int ZBW = 2304, ZB_AU = 0, ZB_AV = 256, ZB_MQ = 512, ZB_CB = 768, ZB_CC = 1024, ZB_CX = 1280, ZB_GQ = 1536, ZB_GK = 1792, ZB_GV = 1920, ZB_MKV = 2048, ZB_KPE = 2176;
constexpr int DIN = 2208;
constexpr int RING_BYTES = 131072, MISC_OFF = 153600, XSCR_OFF = MISC_OFF + 1024, LDS_BYTES = 163840 - 4096;
constexpr size_t MiB = 1u << 20;
constexpr size_t al(size_t x) { return (x + 255) / 256 * 256; }
constexpr size_t WS_CTL = 0, CTL_BYTES = 1 * MiB;
constexpr size_t WS_MOD = WS_CTL + CTL_BYTES, SZ_MOD = al((size_t)L * 9 * 6 * D * 4);
constexpr size_t WS_WIN = WS_MOD + SZ_MOD, SZ_WIN1 = (size_t)ZBW * D * 2;
constexpr size_t WS_WG = WS_WIN + L * SZ_WIN1, SZ_WG1 = (size_t)4096 * D * 2;
constexpr size_t WS_WB = WS_WG + L * SZ_WG1, SZ_WB1 = (size_t)4 * 1024 * 256 * 2;
constexpr size_t WS_WOUT = WS_WB + L * SZ_WB1, SZ_WOUT1 = (size_t)D * D * 2;
constexpr size_t WS_WUQ = WS_WOUT + L * SZ_WOUT1, SZ_WUQ1 = (size_t)512 * 256 * 2;
constexpr size_t WS_WUKV = WS_WUQ + L * SZ_WUQ1, SZ_WUKV1 = (size_t)512 * 256 * 2;
constexpr size_t WS_WSGU = WS_WUKV + L * SZ_WUKV1, SZ_WSGU1 = (size_t)4 * 128 * 128 * 2;
constexpr size_t WS_WGU = WS_WSGU + L * SZ_WSGU1, SZ_WGU1 = (size_t)NE * 512 * D * 2;
constexpr size_t WS_WDN = WS_WGU + L * SZ_WGU1, SZ_WDN1 = (size_t)NE * D * 256 * 2;
constexpr size_t WS_WG8 = WS_WDN + L * SZ_WDN1, SZ_WG81 = (size_t)4096 * D;
constexpr size_t WS_HS = WS_WG8 + L * SZ_WG81, SZ_HS = (size_t)T * D * 2;
constexpr size_t WS_HN = WS_HS + SZ_HS, SZ_HN = (size_t)T * D * 2;
constexpr size_t WS_HN8 = WS_HN + SZ_HN, SZ_HN8 = (size_t)T * D;
constexpr size_t WS_RSS = WS_HN8 + SZ_HN8, SZ_RSS = (size_t)T * 2 * 4 * 4;
constexpr size_t WS_ARENA = WS_RSS + SZ_RSS;

#define GAS __attribute__((address_space(1)))
#define LAS __attribute__((address_space(3)))
typedef unsigned short bf16;
typedef unsigned v4u __attribute__((ext_vector_type(4)));
typedef unsigned v2u __attribute__((ext_vector_type(2)));
#define LDS_WAIT() asm volatile("s_waitcnt lgkmcnt(0)" ::: "memory")
#define VM_WAIT() asm volatile("s_waitcnt vmcnt(0)" ::: "memory")
__device__ __forceinline__ unsigned f2bf(float f) { unsigned u = __builtin_bit_cast(unsigned, f); return (u + 0x7fffu + ((u >> 16) & 1u)) >> 16; }
__device__ __forceinline__ unsigned pk2(float lo, float hi) { return f2bf(lo) | (f2bf(hi) << 16); }
__device__ __forceinline__ float bf2f(unsigned short h) { return __builtin_bit_cast(float, (unsigned)h << 16); }
__device__ __forceinline__ float bflo(unsigned w) { return __builtin_bit_cast(float, w << 16); }
__device__ __forceinline__ float bfhi(unsigned w) { return __builtin_bit_cast(float, w & 0xffff0000u); }
template <int CTRL> __device__ __forceinline__ float dppf(float v) { return __builtin_bit_cast(float, __builtin_amdgcn_update_dpp(0, __builtin_bit_cast(int, v), CTRL, 0xF, 0xF, true)); }
__device__ __forceinline__ unsigned opq(unsigned x) { asm volatile("" : "+v"(x)); return x; }
__device__ __forceinline__ float sum_x16(float v) { const unsigned a = __float_as_uint(v); auto rr = __builtin_amdgcn_permlane16_swap(a, opq(a), false, false); const unsigned r0 = rr[0], r1 = rr[1]; return __uint_as_float(r0) + __uint_as_float(r1); }
__device__ __forceinline__ float sum_x32(float v) { const unsigned a = __float_as_uint(v); auto rr = __builtin_amdgcn_permlane32_swap(a, opq(a), false, false); const unsigned r0 = rr[0], r1 = rr[1]; return __uint_as_float(r0) + __uint_as_float(r1); }
__device__ __forceinline__ float get_x16(float v, int lane) { const unsigned a = __float_as_uint(v); auto rr = __builtin_amdgcn_permlane16_swap(a, opq(a), false, false); const unsigned r0 = rr[0], r1 = rr[1]; return __uint_as_float((lane & 16) ? r0 : r1); }
__device__ __forceinline__ float get_x32(float v, int lane) { const unsigned a = __float_as_uint(v); auto rr = __builtin_amdgcn_permlane32_swap(a, opq(a), false, false); const unsigned r0 = rr[0], r1 = rr[1]; return __uint_as_float((lane & 32) ? r0 : r1); }
__device__ __forceinline__ float wave_sum(float v) {
  v += dppf<0xB1>(v);
  v += dppf<0x4E>(v);
  v += dppf<0x141>(v);
  v += dppf<0x140>(v);
  v = sum_x16(v);
  return sum_x32(v);
}
__device__ __forceinline__ float siluf(float x) { return x / (1.f + __expf(-x)); }
__device__ __forceinline__ float sigmoidf(float x) { return 1.f / (1.f + __expf(-x)); }
__device__ __forceinline__ float gelu_tanh(float x) { const float u = 0.7978845608028654f * (x + 0.044715f * x * x * x); const float e = __expf(2.f * u); return x - x * __builtin_amdgcn_rcpf(e + 1.f); }

#define XB_TMO      128
#define XB_XCNT(j)  (256  + 64 * (j))
#define XB_XSUB(j)  (1280 + 64 * (j))
#define XB_XGEN(j)  (2304 + 64 * (j))
#define XB_TOP      3328
#define XB_TOPGEN   3392
#define XCD_BAR_WORDS 3456
#define XB_SPIN_CAP (1u << 18)
__device__ __forceinline__ unsigned xb_ld(unsigned* p)              { return __hip_atomic_load(p, __ATOMIC_RELAXED, __HIP_MEMORY_SCOPE_AGENT); }
__device__ __forceinline__ unsigned xb_add(unsigned* p, unsigned v) { return __hip_atomic_fetch_add(p, v, __ATOMIC_RELAXED, __HIP_MEMORY_SCOPE_AGENT); }
__device__ __forceinline__ unsigned xb_xcc_id() { return (unsigned)__builtin_amdgcn_s_getreg((3 << 11) | 20) & 0xFu; }
#define XB_SPIN(cond, bar) do { unsigned _sp = 0; while (cond) { __builtin_amdgcn_s_sleep(1); \
    if ((++_sp & 255u) == 0u) { if (xb_ld(&(bar)[XB_TMO])) break; if (_sp > XB_SPIN_CAP) { atomicAdd(&(bar)[XB_TMO], 1u); break; } } } } while (0)
struct XcdBarrier { unsigned* bar; unsigned x; volatile LAS unsigned* st; };
__device__ __forceinline__ XcdBarrier xcd_barrier_post(unsigned* bar, volatile LAS unsigned* st, const bool leader) {
    XcdBarrier b; b.bar = bar; b.x = xb_xcc_id(); b.st = st;
    if (leader) (void)xb_add(&bar[XB_XCNT(b.x)], 1u);
    return b;
}
__device__ __forceinline__ void xcd_barrier_complete(unsigned* bar, unsigned x, unsigned& nloc, unsigned& nx) {
    const unsigned G = gridDim.x * gridDim.y * gridDim.z;
    unsigned sum, cnt, mine, sp = 0u;
    for (;;) {
        sum = 0u; cnt = 0u; mine = 0u;
#pragma unroll
        for (unsigned j = 0; j < 16; ++j) { const unsigned c = xb_ld(&bar[XB_XCNT(j)]); sum += c; cnt += (c > 0u) ? 1u : 0u; mine = (j == x) ? c : mine; }
        if (sum == G) break;
        __builtin_amdgcn_s_sleep(1);
        if ((++sp & 255u) == 0u) { if (xb_ld(&bar[XB_TMO])) break; if (sp > XB_SPIN_CAP) { atomicAdd(&bar[XB_TMO], 1u); break; } }
    }
    nloc = mine > 0u ? mine : 1u; nx = cnt > 0u ? cnt : 1u;
}
__device__ __forceinline__ void xcd_barrier(const XcdBarrier& b, const bool leader) {
    asm volatile("s_waitcnt vmcnt(0)" ::: "memory");
    __syncthreads();
    if (leader) {
        unsigned* bar = b.bar;
        __builtin_amdgcn_s_waitcnt(0);
        unsigned nloc = b.st[0], nx = b.st[1];
        if (nloc == 0u) { xcd_barrier_complete(bar, b.x, nloc, nx); b.st[0] = nloc; b.st[1] = nx; }
        const unsigned old = xb_add(&bar[XB_XSUB(b.x)], 1u);
        const unsigned gen = old / nloc;
        if (old + 1u == (gen + 1u) * nloc) {
            __builtin_amdgcn_fence(__ATOMIC_RELEASE, "agent");
            asm volatile("s_waitcnt vmcnt(0)" ::: "memory");
            const unsigned og = xb_add(&bar[XB_TOP], 1u);
            const unsigned tg = og / nx;
            if (og + 1u == (tg + 1u) * nx) xb_add(&bar[XB_TOPGEN], 1u);
            else XB_SPIN(xb_ld(&bar[XB_TOPGEN]) == tg, bar);
            __builtin_amdgcn_fence(__ATOMIC_ACQUIRE, "agent");
            xb_add(&bar[XB_XGEN(b.x)], 1u);
            asm volatile("s_waitcnt vmcnt(0)" ::: "memory");
        } else {
            XB_SPIN(xb_ld(&bar[XB_XGEN(b.x)]) == gen, bar);
            __builtin_amdgcn_fence(__ATOMIC_ACQUIRE, "agent");
            asm volatile("s_waitcnt vmcnt(0)" ::: "memory");
        }
    }
    __syncthreads();
}

struct Args { const float* in[28]; float* out; unsigned char* ws; int phase, layer, flag, pad; };
struct Ctx {
  LAS unsigned char* lds; unsigned char* ws; int tid, lane, wave, vcu, G;
};

__device__ __forceinline__ void refresh_ctx(Ctx& F, const Args& A) {
  unsigned char* w_ = A.ws; asm volatile("" : "+s"(w_)); F.ws = w_;
  int wv_ = F.wave; asm volatile("" : "+s"(wv_)); F.wave = wv_; unsigned z_ = 0u; asm volatile("" : "+v"(z_)); const int l_ = (int)__builtin_amdgcn_mbcnt_hi(~0u, __builtin_amdgcn_mbcnt_lo(~0u, z_)); F.lane = l_; F.tid = wv_ * 64 + l_;
}
struct TileOrder {
  int nM, nN, nwg, G, c, skip, wgm;
  __device__ void init(int nM_, int nN_, int G_, int c_, int skip_ = 0, int wgm_ = 8) { nM = nM_; nN = nN_; nwg = nM * nN; G = G_; c = c_; skip = skip_; wgm = wgm_; }
  __device__ __forceinline__ bool tile(int i, int& pm, int& pn) const {
    const long Lx = (long)i * G + c; if (Lx >= nwg) return false;
    int wgid = (int)Lx; { const int q = nwg / 8, r = nwg % 8, xcd = wgid % 8, off = wgid / 8; wgid = (xcd < r ? xcd * (q + 1) : r * (q + 1) + (xcd - r) * q) + off; }
    const int WGM = wgm; const int nig = WGM * nN, gid = wgid / nig, fm = gid * WGM, gsz = (nM - fm) < WGM ? (nM - fm) : WGM;
    pm = fm + ((wgid % nig) % gsz); pn = (wgid % nig) / gsz; if (skip) pm += pm / 8 + 1; return true;
  }
};
struct PlainSched {
  TileOrder o; const char* A; const char* B; size_t aTile, bTile;
  __device__ __forceinline__ bool next(int i, Unit& u) const { int pm, pn; if (!o.tile(i, pm, pn)) return false; u.pm = pm; u.pn = pn; u.aux = 0; u.a = A + (size_t)pm * aTile; u.b = B + (size_t)pn * bTile; return true; }
  __device__ __forceinline__ void a_ready(const Unit&, int) const {}
};
constexpr int STG_PITCH = 528;
template <bool SC1> __device__ __forceinline__ void store_tile_rows(const f32x4 (&acc)[2][2][4][2], LAS unsigned char* stg, bf16* O, int obytes, int ldc, int row_base, int col_base, int wr, int wc, int fr, int fq) {
  const int tid = (wr * 4 + wc) * 64 + fq * 16 + fr;
  const __amdgpu_buffer_rsrc_t rs = __builtin_amdgcn_make_buffer_rsrc(O, 0, obytes, 0x00020000);
  LAS unsigned char* wp = stg + (wr * 16 + fr) * STG_PITCH + (wc * 32 + fq * 8) * 2; const LAS unsigned char* rp = stg + (tid >> 5) * STG_PITCH + (tid & 31) * 16;
#pragma unroll
  for (int ai = 0; ai < 2; ++ai)
#pragma unroll
    for (int m = 0; m < 4; ++m) {
#pragma unroll
      for (int bj = 0; bj < 2; ++bj) { const f32x4 v0 = acc[ai][bj][m][0], v1 = acc[ai][bj][m][1];
        v4u w; w.x = cvt_pk_bf16(v0[0], v0[1]); w.y = cvt_pk_bf16(v0[2], v0[3]); w.z = cvt_pk_bf16(v1[0], v1[1]); w.w = cvt_pk_bf16(v1[2], v1[3]);
        *(LAS v4u*)(wp + bj * 256) = w; }
      asm volatile("s_waitcnt lgkmcnt(0)" ::: "memory"); __builtin_amdgcn_s_barrier(); asm volatile("" ::: "memory");
#pragma unroll
      for (int ps = 0; ps < 2; ++ps) { const int rl = ps * 16 + (tid >> 5); const v4u w = *(const LAS v4u*)(rp + ps * 16 * STG_PITCH);
        const int off = ((row_base + ai * 128 + (rl >> 4) * 64 + m * 16 + (rl & 15)) * ldc + col_base + (tid & 31) * 8) * 2;
        __builtin_amdgcn_raw_buffer_store_b128(w, rs, off, 0, SC1 ? 16 : 0); }
      asm volatile("s_waitcnt lgkmcnt(0)" ::: "memory"); __builtin_amdgcn_s_barrier(); asm volatile("" ::: "memory"); }
}
struct EpiStoreBf16 {
  static constexpr bool PERM = true;
  bf16* O; int ldc; int obytes; LAS unsigned char* stg;
  __device__ __forceinline__ void operator()(const f32x4 (&acc)[2][2][4][2], const Unit& u, int wr, int wc, int fr, int fq) const {
    store_tile_rows<false>(acc, stg, O, obytes, ldc, u.pm * 256, u.pn * 256, wr, wc, fr, fq);
  }
};

__device__ __forceinline__ int zmap(int n) {
  if (n < 768) return n;
  if (n < 896) return ZB_MKV + (n - 768);
  if (n < 928) return ZB_KPE + (n - 896);
  if (n < 1184) return ZB_CB + (n - 928);
  if (n < 1440) return ZB_CC + (n - 1184);
  if (n < 1696) return ZB_CX + (n - 1440);
  if (n < 1952) return ZB_GQ + (n - 1696);
  if (n < 2080) return ZB_GK + (n - 1952);
  return ZB_GV + (n - 2080);
}
__device__ __forceinline__ int gmap(int i, int c) { const int jp = c >> 6, cl = c & 63, wc = cl >> 4, h = (cl >> 3) & 1, n = (cl >> 2) & 1, e = cl & 3, bj = i >> 1, fq = 2 * h + (i & 1); return 256 * jp + 128 * bj + 32 * wc + 16 * n + 4 * fq + e; }
__device__ __forceinline__ int uqmap(int n) { const int h = n / 96, dd = n % 96; if (dd < 64) return 64 * h + dd; const int d = dd - 64; return 256 + 32 * h + 8 * ((d >> 2) & 3) + 4 * (d >> 4) + (d & 3); }
__device__ __forceinline__ int gumap(int n) { const int up = n >> 8, j = n & 255; return 256 * (j >> 7) + 128 * up + (j & 127); }

struct PrepItem { const float* W; bf16* dst; const float* kscale; int ldw, N, ldd, k0, n0, mt, mp; };
__device__ __forceinline__ int prep_map(int mt, int mp, int n) { return mt == 0 ? n : mt == 1 ? zmap(n) : mt == 2 ? gmap(mp, n) : mt == 3 ? uqmap(n) : gumap(n); }
__device__ __forceinline__ PrepItem prep_decode(const Args& A, unsigned char* ws, int it) {
  constexpr int I_IN = 16 * 9, I_G = 4 * 16 * 4, I_B = 4 * 4 * 4, I_O = 16 * 4, I_UQ = 4 * 2, I_UKV = 2 * 2, I_GU = NE * 16 * 2, I_DN = NE * 4 * 4;
  constexpr int I_L = I_IN + I_G + I_B + I_O + I_UQ + I_UKV + I_GU + I_DN;
  PrepItem p; const int l = it / I_L; int r = it % I_L; p.kscale = nullptr; p.mt = 0; p.mp = 0;
  if (r < I_IN) { const int kb = r / 9, nb = r % 9; p.W = A.in[6] + (size_t)l * D * DIN; p.ldw = DIN; p.N = DIN; p.dst = (bf16*)(ws + WS_WIN + l * SZ_WIN1); p.ldd = D; p.k0 = kb * 64; p.n0 = nb * 256; p.mt = 1; return p; } r -= I_IN;
  if (r < I_G) { const int i = r / 64, rr = r % 64, kb = rr / 4, nb = rr % 4; p.W = A.in[17] + ((size_t)l * 4 + i) * D * D; p.ldw = D; p.N = D; p.dst = (bf16*)(ws + WS_WG8 + l * SZ_WG81); p.ldd = D; p.k0 = kb * 64; p.n0 = nb * 256; p.mt = 2; p.mp = i; return p; } r -= I_G;
  if (r < I_B) { const int i = r / 16, rr = r % 16, kb = rr / 4, nb = rr % 4; p.W = A.in[19] + ((size_t)l * 4 + i) * 256 * D; p.ldw = D; p.N = D; p.dst = (bf16*)(ws + WS_WB + l * SZ_WB1) + (size_t)i * 1024 * 256; p.ldd = 256; p.k0 = kb * 64; p.n0 = nb * 256; return p; } r -= I_B;
  if (r < I_O) { const int kb = r / 4, nb = r % 4; p.W = A.in[20] + (size_t)l * D * D; p.ldw = D; p.N = D; p.dst = (bf16*)(ws + WS_WOUT + l * SZ_WOUT1); p.ldd = D; p.k0 = kb * 64; p.n0 = nb * 256; return p; } r -= I_O;
  if (r < I_UQ) { const int kb = r / 2, nb = r % 2; p.W = A.in[11] + (size_t)l * 256 * 384; p.ldw = 384; p.N = 384; p.dst = (bf16*)(ws + WS_WUQ + l * SZ_WUQ1); p.ldd = 256; p.kscale = A.in[10] + l * 256; p.k0 = kb * 64; p.n0 = nb * 256; p.mt = 3; return p; } r -= I_UQ;
  if (r < I_UKV) { const int kb = r / 2, nb = r % 2; p.W = A.in[13] + (size_t)l * 128 * 512; p.ldw = 512; p.N = 512; p.dst = (bf16*)(ws + WS_WUKV + l * SZ_WUKV1); p.ldd = 256; p.kscale = A.in[12] + l * 128; p.k0 = kb * 64; p.n0 = nb * 256; return p; } r -= I_UKV;
  if (r < I_GU) { const int e = r / 32, rr = r % 32, kb = rr / 2, nb = rr % 2; p.W = A.in[25] + ((size_t)l * NE + e) * D * 512; p.ldw = 512; p.N = 512; p.dst = (bf16*)(ws + WS_WGU + l * SZ_WGU1) + (size_t)e * 512 * D; p.ldd = D; p.k0 = kb * 64; p.n0 = nb * 256; p.mt = 4; return p; } r -= I_GU;
  { const int e = r / 16, rr = r % 16, kb = rr / 4, nb = rr % 4; p.W = A.in[26] + ((size_t)l * NE + e) * 256 * D; p.ldw = D; p.N = D; p.dst = (bf16*)(ws + WS_WDN + l * SZ_WDN1) + (size_t)e * D * 256; p.ldd = 256; p.k0 = kb * 64; p.n0 = nb * 256; return p; }
}
__device__ __forceinline__ void prep_load(const PrepItem& p, int tid, float4 (&v)[8]) {
#pragma unroll
  for (int i = 0; i < 8; ++i) { const int idx = tid + i * NTHR, kk = idx >> 6, c4 = (idx & 63) * 4; v[i] = make_float4(0.f, 0.f, 0.f, 0.f);
    if (p.n0 + c4 < p.N) v[i] = *(const float4*)(p.W + (size_t)(p.k0 + kk) * p.ldw + p.n0 + c4); }
}
__device__ __forceinline__ void phase_prep(Ctx& F, const Args& A) {
  const int lane = F.lane;
  const float* w_sgu = A.in[8];
  { const float* c = A.in[1]; const float* c_ctx = A.in[3]; const float* w_ada = A.in[4]; const float* b_ada = A.in[5]; float* mod = (float*)(F.ws + WS_MOD);
    LAS float* sil = (LAS float*)F.lds; LAS float* red = sil + 9 * D;
    if (F.vcu < L * 96) {
      for (int i = F.tid; i < 9 * D; i += NTHR) { const int r = i / D, k = i % D; sil[i] = siluf(r < 8 ? c[r * D + k] : c_ctx[k]); }
      __syncthreads();
      for (int it = F.vcu; it < L * 96; it += F.G) { const int l = it / 96, n = (it % 96) * 64 + lane; float acc[9];
#pragma unroll
        for (int r = 0; r < 9; ++r) acc[r] = 0.f;
        const float* w = w_ada + (size_t)l * D * 6 * D + n;
#pragma unroll 8
        for (int kk = 0; kk < 128; ++kk) { const int k = F.wave * 128 + kk; const float wv = w[(size_t)k * 6 * D];
#pragma unroll
          for (int r = 0; r < 9; ++r) acc[r] += sil[r * D + k] * wv; }
        __syncthreads();
#pragma unroll
        for (int r = 0; r < 9; ++r) red[(F.wave * 9 + r) * 64 + lane] = acc[r];
        __syncthreads();
        if (F.wave == 0) { const float bv = b_ada[l * 6 * D + n];
#pragma unroll
          for (int r = 0; r < 9; ++r) { float s = 0.f;
#pragma unroll
            for (int w8 = 0; w8 < 8; ++w8) s += red[(w8 * 9 + r) * 64 + lane];
            mod[((size_t)l * 9 + r) * 6 * D + n] = s + bv; } }
      }
      __syncthreads(); } }
  constexpr int I_LT = 16 * 9 + 4 * 16 * 4 + 4 * 4 * 4 + 16 * 4 + 4 * 2 + 2 * 2 + NE * 16 * 2 + NE * 4 * 4;
  { LAS float* scr = (LAS float*)F.lds; const int tid = F.tid;
    int it = F.vcu; float4 v[8]; PrepItem cur;
    if (it < L * I_LT) { cur = prep_decode(A, F.ws, it); prep_load(cur, tid, v); }
    while (it < L * I_LT) {
#pragma unroll
      for (int i = 0; i < 8; ++i) { const int idx = tid + i * NTHR, kk = idx >> 6, c4 = (idx & 63) * 4; float4 x = v[i];
        if (cur.kscale) { const float s = cur.kscale[cur.k0 + kk]; x.x *= s; x.y *= s; x.z *= s; x.w *= s; }
        *(LAS f32x4*)(scr + kk * 260 + c4) = (f32x4){x.x, x.y, x.z, x.w}; }
      const int nit = it + F.G; PrepItem nxt = cur;
      if (nit < L * I_LT) { nxt = prep_decode(A, F.ws, nit); prep_load(nxt, tid, v); }
      __syncthreads();
#pragma unroll
      for (int i = 0; i < 4; ++i) { const int idx = tid + i * NTHR, n = idx & 255, c = idx >> 8; const LAS float* s = scr + (8 * c) * 260 + n;
        if (cur.n0 + n < cur.N) {
          if (cur.mt == 2) { int w0 = 0, w1 = 0;
            w0 = __builtin_amdgcn_cvt_pk_fp8_f32(32.f * s[0 * 260], 32.f * s[1 * 260], w0, false); w0 = __builtin_amdgcn_cvt_pk_fp8_f32(32.f * s[2 * 260], 32.f * s[3 * 260], w0, true);
            w1 = __builtin_amdgcn_cvt_pk_fp8_f32(32.f * s[4 * 260], 32.f * s[5 * 260], w1, false); w1 = __builtin_amdgcn_cvt_pk_fp8_f32(32.f * s[6 * 260], 32.f * s[7 * 260], w1, true);
            v2u o; o.x = (unsigned)w0; o.y = (unsigned)w1; *(v2u*)((unsigned char*)cur.dst + (size_t)prep_map(cur.mt, cur.mp, cur.n0 + n) * cur.ldd + cur.k0 + 8 * c) = o; }
          else { v4u o; o.x = pk2(s[0 * 260], s[1 * 260]); o.y = pk2(s[2 * 260], s[3 * 260]); o.z = pk2(s[4 * 260], s[5 * 260]); o.w = pk2(s[6 * 260], s[7 * 260]);
            *(v4u*)(cur.dst + (size_t)prep_map(cur.mt, cur.mp, cur.n0 + n) * cur.ldd + cur.k0 + 8 * c) = o; } } }
      __syncthreads();
      cur = nxt; it = nit;
    }
  }
  const size_t gt = (size_t)F.vcu * NTHR + F.tid, NGT = (size_t)F.G * NTHR;
  for (int l = 0; l < L; ++l) {
    v4u z4 = {0u, 0u, 0u, 0u};
    { v4u* p = (v4u*)(F.ws + WS_WIN + l * SZ_WIN1 + (size_t)DIN * D * 2); for (size_t i = gt; i < (size_t)(ZBW - DIN) * D * 2 / 16; i += NGT) p[i] = z4; }
    { v4u* p = (v4u*)(F.ws + WS_WUQ + l * SZ_WUQ1 + (size_t)384 * 256 * 2); for (size_t i = gt; i < (size_t)128 * 256 * 2 / 16; i += NGT) p[i] = z4; }
    { for (size_t i = gt; i < (size_t)512 * 16; i += NGT) { const size_t row = i / 16, c = i % 16; *(v4u*)(F.ws + WS_WUKV + l * SZ_WUKV1 + row * 512 + 256 + c * 16) = z4; } }
    { const float* s = w_sgu + (size_t)l * 4 * 128 * 128; bf16* d = (bf16*)(F.ws + WS_WSGU + l * SZ_WSGU1); for (size_t i = gt; i < (size_t)4 * 128 * 128 / 2; i += NGT) ((unsigned*)d)[i] = pk2(s[2 * i], s[2 * i + 1]); }
  }
}
}
namespace mk {
constexpr int CW_CNT = 8192, CW_PANEL = 32768, CW_TILE = 65536, CW_BAR_TMO = 16384 + 128;
constexpr size_t SZ_ZB_BYTES = (size_t)T * ZBW * 2;
struct EpiZ {
  static constexpr bool PERM = true;
  bf16* O; float* rss; int mode; LAS unsigned char* stg;
  __device__ __forceinline__ void operator()(const f32x4 (&acc)[2][2][4][2], const Unit& u, int wr, int wc, int fr, int fq) const {
    if (mode) return;
    const int row0 = u.pm * 256 + wr * 64 + fr;
    store_tile_rows<false>(acc, stg, O, (int)SZ_ZB_BYTES, ZBW, u.pm * 256, u.pn * 256, wr, wc, fr, fq);
    if (u.pn == 2 || u.pn == 8) { const int which = u.pn == 2 ? 0 : 1;
#pragma unroll
      for (int ai = 0; ai < 2; ++ai)
#pragma unroll
        for (int m = 0; m < 4; ++m) { float s = 0.f;
#pragma unroll
          for (int n = 0; n < 2; ++n) { const f32x4 a0 = acc[ai][0][m][n]; s += a0[0] * a0[0] + a0[1] * a0[1] + a0[2] * a0[2] + a0[3] * a0[3];
            if (which == 0) { const f32x4 a1 = acc[ai][1][m][n]; s += a1[0] * a1[0] + a1[1] * a1[1] + a1[2] * a1[2] + a1[3] * a1[3]; } }
          s = sum_x16(s); s = sum_x32(s);
          if (fq == 0) rss[((size_t)(row0 + ai * 128 + m * 16) * 2 + which) * 4 + wc] = s; } }
  }
};
__device__ __forceinline__ void phase_zgemm(Ctx& F, const Args& A, int l, int mode = 0) {
  PlainSched S; S.o.init(NROWT, ZBW / 256, F.G, (int)blockIdx.x, 0, 9); S.A = (const char*)(F.ws + WS_HN); S.B = (const char*)(F.ws + WS_WIN + l * SZ_WIN1); S.aTile = (size_t)256 * D * 2; S.bTile = (size_t)256 * D * 2;
  EpiZ E{(bf16*)(F.ws + WS_ARENA), (float*)(F.ws + WS_RSS), mode, F.lds + RING_BYTES};
  gemm_phase<EpiZ, PlainSched, true>(F.lds, F.tid, D * 2, D * 2, D, S, E);
}
constexpr size_t WS_ZB = WS_ARENA, SZ_ZB = (size_t)T * ZBW * 2;
constexpr size_t WS_Y = WS_ZB + SZ_ZB, SZ_Y = (size_t)T * D * 2;
constexpr size_t WS_Z4 = WS_Y + SZ_Y, SZ_Z4 = (size_t)T * 4096 * 2;
constexpr size_t WS_MG = WS_Z4 + SZ_Z4, SZ_MG = (size_t)T * D * 2;
constexpr size_t WS_END1 = WS_MG + SZ_MG;
struct BranchSched {
  TileOrder o; const char* Y; const char* WB;
  __device__ __forceinline__ bool next(int i, Unit& u) const { int pm, pn; if (!o.tile(i, pm, pn)) return false; u.pm = pm; u.pn = pn; u.aux = 0; const int br = pn >> 2;
    u.a = Y + (size_t)pm * 256 * D * 2 + br * 512; u.b = WB + (size_t)br * 1024 * 512 + (size_t)(pn & 3) * 256 * 512; return true; }
  __device__ __forceinline__ void a_ready(const Unit&, int) const {}
};
constexpr int CW_BRC = 98304;
__device__ __forceinline__ bool wait_counter(const unsigned* cnt, unsigned need, unsigned* tmo, int tid) {
  if (tid < 64) { unsigned sp = 0;
    while ((unsigned)__builtin_amdgcn_readfirstlane((int)__hip_atomic_load(cnt, __ATOMIC_RELAXED, __HIP_MEMORY_SCOPE_AGENT)) < need) { __builtin_amdgcn_s_sleep(2);
      if ((++sp & 255u) == 0u) { if (__hip_atomic_load(tmo, __ATOMIC_RELAXED, __HIP_MEMORY_SCOPE_AGENT)) break; if (sp > (1u << 18)) { atomicAdd(tmo, 1u); break; } } }
    __builtin_amdgcn_fence(__ATOMIC_ACQUIRE, "agent");
    asm volatile("s_waitcnt vmcnt(0)" ::: "memory"); }
  asm volatile("" ::: "memory"); __builtin_amdgcn_s_barrier(); asm volatile("" ::: "memory"); return true;
}
struct BranchSched2 {
  int x, j; bool skip; const char* Y; const char* WB;
  __device__ __forceinline__ bool next(int i, Unit& u) const { int w;
    if (i < 4) w = 32 * i + j;
    else if (skip || j < 20) return false;
    else if (i == 4) w = j >= 28 ? 136 + 2 * (j - 28) : j >= 24 ? 128 + (j - 24) : 132 + (j - 20);
    else if (i == 5 && j >= 28) w = 137 + 2 * (j - 28); else return false;
    u.pn = w & 15; u.pm = 9 * x + (skip ? 1 : 0) + (w >> 4); u.aux = 0; u.rows = nullptr; const int br = u.pn >> 2;
    u.a = Y + (size_t)u.pm * 256 * D * 2 + br * 512; u.b = WB + (size_t)br * 1024 * 512 + (size_t)(u.pn & 3) * 256 * 512; return true; }
  __device__ __forceinline__ void a_ready(const Unit&, int) const {}
};
struct EpiZ4 {
  static constexpr bool PERM = true;
  bf16* O; unsigned* cnt; LAS unsigned char* stg;
  __device__ __forceinline__ void operator()(const f32x4 (&acc)[2][2][4][2], const Unit& u, int wr, int wc, int fr, int fq) const {
    store_tile_rows<true>(acc, stg, O, (int)SZ_Z4, 4096, u.pm * 256, u.pn * 256, wr, wc, fr, fq);
    if (cnt) { asm volatile("s_waitcnt vmcnt(0)" ::: "memory"); if (fr == 0 && fq == 0) __hip_atomic_fetch_add(cnt + (u.pm * 4 + (u.pn & 3)) * 64, 1u, __ATOMIC_RELAXED, __HIP_MEMORY_SCOPE_AGENT); }
  }
};
__device__ __forceinline__ void phase_branch(Ctx& F, const Args& A, int l, bool skipctx = false) {
  if (F.G == 256) { BranchSched2 S; S.x = (int)blockIdx.x & 7; S.j = (int)blockIdx.x >> 3; S.skip = skipctx; S.Y = (const char*)(F.ws + WS_Y); S.WB = (const char*)(F.ws + WS_WB + l * SZ_WB1);
    EpiZ4 E{(bf16*)(F.ws + WS_Z4), (unsigned*)(F.ws + WS_CTL) + CW_BRC + l * (72 * 4 * 64), F.lds + RING_BYTES};
    gemm_phase<EpiZ4, BranchSched2, true>(F.lds, F.tid, D * 2, 512, 256, S, E); return; }
  BranchSched S; S.o.init(skipctx ? NB * 8 : NROWT, 16, F.G, (int)blockIdx.x, skipctx ? 1 : 0, skipctx ? 8 : 9); S.Y = (const char*)(F.ws + WS_Y); S.WB = (const char*)(F.ws + WS_WB + l * SZ_WB1);
  EpiStoreBf16 E{(bf16*)(F.ws + WS_Z4), 4096, (int)SZ_Z4, F.lds + RING_BYTES};
  gemm_phase<EpiStoreBf16, BranchSched, true>(F.lds, F.tid, D * 2, 512, 256, S, E);
}
template <int MODE> struct EpiMergeT {
  static constexpr bool PERM = false;
  const bf16* Z4; const float* bg; bf16* M; unsigned* panel; LAS unsigned char* stg;
  static constexpr float L2E = 1.4426950408889634f;
  __device__ __forceinline__ void acc_init(f32x4 (&acc)[2][2][4][2], const Unit& u, int wr, int wc, int fr, int fq) const {
    const int pq = fq & 1, c0 = u.pn * 64 + wc * 16 + (fq >> 1) * 8;
#pragma unroll
    for (int bj = 0; bj < 2; ++bj)
#pragma unroll
      for (int n = 0; n < 2; ++n) { const f32x4 b32 = *(const f32x4*)(bg + (2 * bj + pq) * D + c0 + 4 * n) * 32.f;
#pragma unroll
        for (int ai = 0; ai < 2; ++ai)
#pragma unroll
          for (int m = 0; m < 4; ++m) acc[ai][bj][m][n] = b32; }
  }
  __device__ __forceinline__ void operator()(const f32x4 (&acc)[2][2][4][2], const Unit& u, int wr, int wc, int fr, int fq) const {
    const int pq = fq & 1, c0 = u.pn * 64 + wc * 16 + (fq >> 1) * 8;
    const GAS bf16* Zg = (const GAS bf16*)Z4 + pq * D + c0;
    const __amdgpu_buffer_rsrc_t rs = __builtin_amdgcn_make_buffer_rsrc(M, 0, (int)SZ_MG, 0x00020000);
    const int tid = (wr * 4 + wc) * 64 + fq * 16 + fr;
    v4u zz[2][4][2];
#pragma unroll
    for (int ai = 0; ai < 2; ++ai)
#pragma unroll
      for (int m = 0; m < 4; ++m) { const size_t r = (size_t)u.pm * 256 + ai * 128 + wr * 64 + m * 16 + fr;
#pragma unroll
        for (int bj = 0; bj < 2; ++bj) { if (MODE == 1) zz[ai][m][bj] = (v4u){0x3f803f80u + (unsigned)fr, 0x3f803f80u, 0x3f803f80u, 0x3f803f80u}; else zz[ai][m][bj] = *(const GAS v4u*)(Zg + r * 4096 + 2 * bj * D); } }
#pragma unroll
    for (int ai = 0; ai < 2; ++ai) {
#pragma unroll
      for (int m = 0; m < 4; ++m) { f32x2 sa = {0.f, 0.f}, sb = sa, sc = sa, sd = sa;
#pragma unroll
        for (int bj = 0; bj < 2; ++bj) { const v4u z2 = zz[ai][m][bj]; const f32x4 t0 = acc[ai][bj][m][0] * (L2E / 32.f), t1 = acc[ai][bj][m][1] * (L2E / 32.f);
#define SIG2(S, TA, TB, ZW) do { const f32x2 d_ = (f32x2){__builtin_amdgcn_exp2f(-(TA)), __builtin_amdgcn_exp2f(-(TB))} + 1.f; const f32x2 r_ = {__builtin_amdgcn_rcpf(d_[0]), __builtin_amdgcn_rcpf(d_[1])}; \
            S += (f32x2){bflo(ZW), bfhi(ZW)} * r_; } while (0)
          SIG2(sa, t0[0], t0[1], z2.x); SIG2(sb, t0[2], t0[3], z2.y); SIG2(sc, t1[0], t1[1], z2.z); SIG2(sd, t1[2], t1[3], z2.w);
#undef SIG2
        }
        const f32x4 s0 = {sa[0], sa[1], sb[0], sb[1]}, s1 = {sc[0], sc[1], sd[0], sd[1]};
        float t[4];
#pragma unroll
        for (int e = 0; e < 4; ++e) { const float lo = s0[e], hi = s1[e]; auto rr = __builtin_amdgcn_permlane16_swap(__float_as_uint(lo), __float_as_uint(hi), false, false); const unsigned r0 = rr[0], r1 = rr[1]; t[e] = __uint_as_float(r0) + __uint_as_float(r1); }
        v2u o2; o2.x = cvt_pk_bf16(t[0], t[1]); o2.y = cvt_pk_bf16(t[2], t[3]);
        *(LAS v2u*)(stg + (wr * 64 + m * 16 + fr) * 144 + (wc * 16 + (fq >> 1) * 8 + 4 * pq) * 2) = o2; }
      asm volatile("s_waitcnt lgkmcnt(0)" ::: "memory"); __builtin_amdgcn_s_barrier(); asm volatile("" ::: "memory");
#pragma unroll
      for (int ps = 0; ps < 2; ++ps) { const int row = ps * 64 + (tid >> 3), ch = tid & 7; const v4u w = *(const LAS v4u*)(stg + row * 144 + ch * 16);
        if (MODE != 2 || w.x == 0x12345678u) __builtin_amdgcn_raw_buffer_store_b128(w, rs, (int)(((size_t)u.pm * 256 + ai * 128 + row) * D + u.pn * 64) * 2 + ch * 16, 0, 16); }
      asm volatile("s_waitcnt lgkmcnt(0)" ::: "memory"); __builtin_amdgcn_s_barrier(); asm volatile("" ::: "memory"); }
    if (panel) { asm volatile("s_waitcnt vmcnt(0)" ::: "memory"); if (fr == 0 && fq == 0) __hip_atomic_fetch_add(panel + 64 * u.pm, 1u, __ATOMIC_RELAXED, __HIP_MEMORY_SCOPE_AGENT); }
  }
};
using EpiMerge = EpiMergeT<0>;
struct GateSched {
  int x, j; bool skip; const char* A; const char* B; const unsigned* brc; unsigned* tmo;
  __device__ __forceinline__ bool next(int i, Unit& u) const { int w;
    if (skip) { if (i >= 4) return false; w = 32 * i + j; }
    else if (j < 20) { if (i >= 5) return false; w = (i == 4 ? 124 : 32 * i) + j; }
    else if (j < 28) { const int k = j - 20; if (i < 3) w = 20 + 32 * i + k; else if (i == 3 && k < 4) w = 116 + k; else return false; }
    else { const int k = j - 28; if (i < 3) w = 28 + 32 * i + k; else if (i == 3) w = 120 + k; else return false; }
    u.pn = w & 15; u.pm = 9 * x + (skip ? 1 : 0) + (w >> 4); u.aux = 0; u.rows = nullptr; u.a = A + (size_t)u.pm * 256 * D; u.b = B + (size_t)u.pn * 256 * D; return true; }
  __device__ __forceinline__ void a_ready(const Unit& u, int tid) const { if (brc) wait_counter(brc + (u.pm * 4 + (u.pn >> 2)) * 64, 32u, tmo, tid); }
};
template <int MODE = 0> __device__ __forceinline__ void phase_gate(Ctx& F, const Args& A, int l, bool skipctx = false, int cbase = CW_PANEL) {
  if (F.G == 256) { GateSched S; S.x = (int)blockIdx.x & 7; S.j = (int)blockIdx.x >> 3; S.skip = skipctx; S.A = (const char*)(F.ws + WS_HN8); S.B = (const char*)(F.ws + WS_WG8 + l * SZ_WG81); S.brc = cbase == CW_PANEL ? (const unsigned*)(F.ws + WS_CTL) + CW_BRC + l * (72 * 4 * 64) : nullptr; S.tmo = (unsigned*)(F.ws + WS_CTL) + CW_BAR_TMO;
    EpiMergeT<MODE> E{(const bf16*)(F.ws + WS_Z4), A.in[18] + (size_t)l * 4 * D, (bf16*)(F.ws + WS_MG), (unsigned*)(F.ws + WS_CTL) + cbase + l * (72 * 64), F.lds + RING_BYTES};
    gemm_phase<EpiMergeT<MODE>, GateSched, true, false, true>(F.lds, F.tid, D, D, D / 2, S, E); return; }
  PlainSched S; S.o.init(skipctx ? NB * 8 : NROWT, 16, F.G, (int)blockIdx.x, skipctx ? 1 : 0, skipctx ? 8 : 9); S.A = (const char*)(F.ws + WS_HN8); S.B = (const char*)(F.ws + WS_WG8 + l * SZ_WG81); S.aTile = (size_t)256 * D; S.bTile = (size_t)256 * D;
  EpiMergeT<MODE> E{(const bf16*)(F.ws + WS_Z4), A.in[18] + (size_t)l * 4 * D, (bf16*)(F.ws + WS_MG), F.G == 256 ? (unsigned*)(F.ws + WS_CTL) + CW_PANEL + l * (72 * 64) : nullptr};
  gemm_phase<EpiMergeT<MODE>, PlainSched, true, false, true>(F.lds, F.tid, D, D, D / 2, S, E);
}
struct EpiResid {
  static constexpr bool PERM = true;
  bf16* hs; const float* mod; float gs;
  __device__ __forceinline__ void operator()(const f32x4 (&acc)[2][2][4][2], const Unit& u, int wr, int wc, int fr, int fq) const {
    const int b = u.pm / 9, rm = (u.pm % 9 == 0) ? 8 : b; const float* gv = mod + (size_t)rm * 6 * D + 2 * D;
    const int col0 = u.pn * 256 + wc * 32 + fq * 8;
    GAS bf16* hg = (GAS bf16*)hs;
#pragma unroll
    for (int bj = 0; bj < 2; ++bj) { v4u w[2][4]; const int c = col0 + bj * 128;
      const f32x4 g0 = *(const f32x4*)(gv + c) * gs, g1 = *(const f32x4*)(gv + c + 4) * gs;
#pragma unroll
      for (int ai = 0; ai < 2; ++ai)
#pragma unroll
        for (int m = 0; m < 4; ++m) w[ai][m] = *(const GAS v4u*)(hg + ((size_t)u.pm * 256 + ai * 128 + wr * 64 + m * 16 + fr) * D + c);
#pragma unroll
      for (int ai = 0; ai < 2; ++ai)
#pragma unroll
        for (int m = 0; m < 4; ++m) { const v4u ww = w[ai][m]; const f32x4 h0 = {bflo(ww.x), bfhi(ww.x), bflo(ww.y), bfhi(ww.y)}, h1 = {bflo(ww.z), bfhi(ww.z), bflo(ww.w), bfhi(ww.w)};
          const f32x4 o0 = h0 + g0 * acc[ai][bj][m][0], o1 = h1 + g1 * acc[ai][bj][m][1];
          v4u ow; ow.x = cvt_pk_bf16(o0[0], o0[1]); ow.y = cvt_pk_bf16(o0[2], o0[3]); ow.z = cvt_pk_bf16(o1[0], o1[1]); ow.w = cvt_pk_bf16(o1[2], o1[3]);
          *(GAS v4u*)(hg + ((size_t)u.pm * 256 + ai * 128 + wr * 64 + m * 16 + fr) * D + c) = ow; } }
  }
};
struct OutSched {
  int c; const char* A; const char* B; unsigned* panel; unsigned* tmo; bool counted; bool skip;
  __device__ __forceinline__ bool next(int i, Unit& u) const { const int x = c & 7, j = c >> 3; int o;
    if (skip) { if (i > 0) return false; o = j; }
    else if (j >= 24 && j < 28) { if (i > 1) return false; o = 2 * (j - 24) + i; }
    else if (i > 0) return false; else if (j >= 28) o = 12 + (j - 28); else if (j >= 20) o = 8 + (j - 20); else o = 16 + j;
    u.pm = 9 * x + (skip ? 1 : 0) + (o >> 2); u.pn = o & 3;
    u.aux = 0; u.rows = nullptr; u.a = A + (size_t)u.pm * 256 * D * 2; u.b = B + (size_t)u.pn * 256 * D * 2; return true; }
  __device__ __forceinline__ void a_ready(const Unit& u, int tid) const {
    if (!counted) return;
    if (tid < 64) { unsigned sp = 0;
      while ((unsigned)__builtin_amdgcn_readfirstlane((int)__hip_atomic_load(panel + 64 * u.pm, __ATOMIC_RELAXED, __HIP_MEMORY_SCOPE_AGENT)) < 128u) { __builtin_amdgcn_s_sleep(2);
        if ((++sp & 255u) == 0u) { if (__hip_atomic_load(tmo, __ATOMIC_RELAXED, __HIP_MEMORY_SCOPE_AGENT)) break; if (sp > (1u << 18)) { atomicAdd(tmo, 1u); break; } } }
      __builtin_amdgcn_fence(__ATOMIC_ACQUIRE, "agent");
      asm volatile("s_waitcnt vmcnt(0)" ::: "memory"); }
    asm volatile("" ::: "memory"); __builtin_amdgcn_s_barrier(); asm volatile("" ::: "memory");
  }
};
__device__ __forceinline__ void phase_out(Ctx& F, const Args& A, int l, float gs = 1.f, bool counted = false, bool skipctx = false, int cbase = CW_PANEL) {
  EpiResid E{(bf16*)(F.ws + WS_HS), (const float*)(F.ws + WS_MOD) + (size_t)l * 9 * 6 * D, gs};
  if (F.G == 256) { OutSched S; S.c = (int)blockIdx.x; S.A = (const char*)(F.ws + WS_MG); S.B = (const char*)(F.ws + WS_WOUT + l * SZ_WOUT1); S.panel = (unsigned*)(F.ws + WS_CTL) + cbase + l * (72 * 64); S.tmo = (unsigned*)(F.ws + WS_CTL) + CW_BAR_TMO; S.counted = counted; S.skip = skipctx;
    gemm_phase<EpiResid, OutSched, true>(F.lds, F.tid, D * 2, D * 2, D, S, E); }
  else { PlainSched S; S.o.init(skipctx ? NB * 8 : NROWT, 4, F.G, (int)blockIdx.x, skipctx ? 1 : 0); S.A = (const char*)(F.ws + WS_MG); S.B = (const char*)(F.ws + WS_WOUT + l * SZ_WOUT1); S.aTile = (size_t)256 * D * 2; S.bTile = (size_t)256 * D * 2;
    gemm_phase<EpiResid, PlainSched, true>(F.lds, F.tid, D * 2, D * 2, D, S, E); }
}
constexpr int CAP2 = 2 * T + NE * 256, NT_MOE = CAP2 / 256;
constexpr size_t WS_XG = WS_ARENA, SZ_XG = (size_t)CAP2 * D * 2;
constexpr size_t WS_HE = WS_XG + SZ_XG, SZ_HE = (size_t)CAP2 * 256 * 2;
constexpr size_t WS_FS = WS_HE + SZ_HE, SZ_FS = (size_t)CAP2 * D * 2;
static_assert(WS_FS + SZ_FS <= WS_END1, "moe arena fits in the mixer arena");
constexpr size_t WS_TOKE = WS_END1, WS_TOKW = WS_TOKE + (size_t)2 * T * 4, WS_TOKR = WS_TOKW + (size_t)2 * T * 4, WS_TOKS = WS_TOKR + (size_t)2 * T * 4, WS_END2 = WS_TOKS + (size_t)2 * T * 4;
constexpr size_t WS_SLOT = WS_END2;
constexpr size_t WS_CJ = WS_SLOT + (size_t)CAP2 * 4;
constexpr size_t WS_SLSP = WS_CJ + 8192;
constexpr size_t WS_END2B = WS_SLSP + (size_t)NE * T * 4;
__device__ __forceinline__ void phase_norm_router(Ctx& F, const Args& A, int l, bool skip_ctx, bool dry = false) {
  const int gw = F.vcu * NWAVES + F.wave, NGW = F.G * NWAVES, lane = F.lane;
  const bf16* hs = (const bf16*)(F.ws + WS_HS); bf16* hn = (bf16*)(F.ws + WS_HN); const float* mod = (const float*)(F.ws + WS_MOD) + (size_t)l * 9 * 6 * D;
  const float* wgr = A.in[21] + (size_t)l * D * 4; const float* bgr = A.in[22] + l * 4; const float* wer = A.in[23] + (size_t)l * D * 32; const float* ber = A.in[24] + l * 32;
  int* tok_e = (int*)(F.ws + WS_TOKE); float* tok_w = (float*)(F.ws + WS_TOKW); int* tok_r = (int*)(F.ws + WS_TOKR);
  unsigned* counts = (unsigned*)(F.ws + WS_CTL) + CW_CNT + l * 64;
  if (dry) { tok_e = (int*)A.out; tok_w = A.out + (1 << 20); tok_r = (int*)A.out + (2 << 20); counts += 32; }
  constexpr int WPB = 2064;
  LAS unsigned char* Wh = F.lds; LAS unsigned char* Wl = F.lds + 36 * WPB; const float* cj = (const float*)(F.ws + WS_CJ) + l * (9 * 36); LAS unsigned* lcnt = (LAS unsigned*)(F.lds + 72 * WPB); LAS unsigned* lbase = lcnt + 32; LAS unsigned* rowctr = lbase + 32;
  __syncthreads();
  { float4 w[18];
#pragma unroll
    for (int it = 0; it < 16; ++it) w[it] = ((const float4*)wer)[F.tid + NTHR * it];
#pragma unroll
    for (int it = 0; it < 2; ++it) w[16 + it] = ((const float4*)wgr)[F.tid + NTHR * it];
#define WSPLIT(J, K, V) do { const float v_ = (V); const unsigned h_ = f2bf(v_); const unsigned l_ = f2bf(v_ - __uint_as_float(h_ << 16)); *(LAS unsigned short*)(Wh + (J) * WPB + (K) * 2) = (unsigned short)h_; *(LAS unsigned short*)(Wl + (J) * WPB + (K) * 2) = (unsigned short)l_; } while (0)
#pragma unroll
    for (int it = 0; it < 16; ++it) { const int i4 = F.tid + NTHR * it, k = i4 >> 3, j = 4 + 4 * (i4 & 7); WSPLIT(j, k, w[it].x); WSPLIT(j + 1, k, w[it].y); WSPLIT(j + 2, k, w[it].z); WSPLIT(j + 3, k, w[it].w); }
#pragma unroll
    for (int it = 0; it < 2; ++it) { const int k = F.tid + NTHR * it; WSPLIT(0, k, w[16 + it].x); WSPLIT(1, k, w[16 + it].y); WSPLIT(2, k, w[16 + it].z); WSPLIT(3, k, w[16 + it].w); }
#undef WSPLIT
  }
  if (F.tid < 32) lcnt[F.tid] = 0u;
  if (F.tid == 32) rowctr[0] = 0u;
  __syncthreads();
  refresh_ctx(F, A);
  const int NR = skip_ctx ? NB * NLAT : T;
  const int lane2 = F.lane; const int g16 = F.wave * F.G + F.vcu, NG = NR / 16; const int fr = lane2 & 15, fq = lane2 >> 4;
  int myE0 = -1, myE1 = -1, mym = 0, myR0 = 0, myR1 = 0; int* slsp = (int*)(F.ws + WS_SLSP); if (dry) slsp = (int*)A.out + (3 << 20);
  if (g16 < NG) {
    const int r0 = g16 * 16 + fr; const int m = skip_ctx ? (r0 / NLAT) * NTOK + NCTX + (r0 % NLAT) : r0; const int b = m / NTOK, t = m % NTOK, r = t < NCTX ? 8 : b; mym = m;
    const bf16* xrow = hs + (size_t)m * D + 16 * fq; const float* scr = mod + (size_t)r * 6 * D + 4 * D + 16 * fq;
    const int j2 = fr < 4 ? 32 + fr : 35;
    const LAS unsigned char* ah0 = Wh + fr * WPB + 32 * fq; const LAS unsigned char* ah1 = Wh + (16 + fr) * WPB + 32 * fq; const LAS unsigned char* ah2 = Wh + j2 * WPB + 32 * fq;
    const LAS unsigned char* al0 = Wl + fr * WPB + 32 * fq; const LAS unsigned char* al1 = Wl + (16 + fr) * WPB + 32 * fq; const LAS unsigned char* al2 = Wl + j2 * WPB + 32 * fq;
    f32x4 acc0 = {0.f, 0.f, 0.f, 0.f}, acc1 = acc0, acc2 = acc0; float ss = 0.f;
#pragma unroll 2
    for (int g = 0; g < 16; ++g) { const uint4 xw0 = *(const uint4*)(xrow + 64 * g), xw1 = *(const uint4*)(xrow + 64 * g + 8);
      float xa[16] = {bflo(xw0.x), bfhi(xw0.x), bflo(xw0.y), bfhi(xw0.y), bflo(xw0.z), bfhi(xw0.z), bflo(xw0.w), bfhi(xw0.w), bflo(xw1.x), bfhi(xw1.x), bflo(xw1.y), bfhi(xw1.y), bflo(xw1.z), bfhi(xw1.z), bflo(xw1.w), bfhi(xw1.w)};
#pragma unroll
      for (int q = 0; q < 4; ++q) { const float4 s4 = *(const float4*)(scr + 64 * g + 4 * q);
        ss += (xa[4 * q] * xa[4 * q] + xa[4 * q + 1] * xa[4 * q + 1]) + (xa[4 * q + 2] * xa[4 * q + 2] + xa[4 * q + 3] * xa[4 * q + 3]);
        xa[4 * q] *= 1.f + s4.x; xa[4 * q + 1] *= 1.f + s4.y; xa[4 * q + 2] *= 1.f + s4.z; xa[4 * q + 3] *= 1.f + s4.w; }
#pragma unroll
      for (int s = 0; s < 2; ++s) {
        v4u xh, xl;
#pragma unroll
        for (int e2 = 0; e2 < 4; ++e2) { const float a = xa[8 * s + 2 * e2], b2 = xa[8 * s + 2 * e2 + 1]; const unsigned h = cvt_pk_bf16(a, b2); const unsigned lo = cvt_pk_bf16(a - bflo(h), b2 - bfhi(h)); xh[e2] = h; xl[e2] = lo; }
        const bf16x8 bh = __builtin_bit_cast(bf16x8, xh), bl = __builtin_bit_cast(bf16x8, xl);
        const bf16x8 h0 = *(const LAS bf16x8*)(ah0 + 128 * g + 16 * s), h1 = *(const LAS bf16x8*)(ah1 + 128 * g + 16 * s), h2 = *(const LAS bf16x8*)(ah2 + 128 * g + 16 * s);
        const bf16x8 l0 = *(const LAS bf16x8*)(al0 + 128 * g + 16 * s), l1 = *(const LAS bf16x8*)(al1 + 128 * g + 16 * s), l2 = *(const LAS bf16x8*)(al2 + 128 * g + 16 * s);
        acc0 = __builtin_amdgcn_mfma_f32_16x16x32_bf16(h0, bh, acc0, 0, 0, 0); acc1 = __builtin_amdgcn_mfma_f32_16x16x32_bf16(h1, bh, acc1, 0, 0, 0); acc2 = __builtin_amdgcn_mfma_f32_16x16x32_bf16(h2, bh, acc2, 0, 0, 0);
        acc0 = __builtin_amdgcn_mfma_f32_16x16x32_bf16(l0, bh, acc0, 0, 0, 0); acc1 = __builtin_amdgcn_mfma_f32_16x16x32_bf16(l1, bh, acc1, 0, 0, 0); acc2 = __builtin_amdgcn_mfma_f32_16x16x32_bf16(l2, bh, acc2, 0, 0, 0);
        acc0 = __builtin_amdgcn_mfma_f32_16x16x32_bf16(h0, bl, acc0, 0, 0, 0); acc1 = __builtin_amdgcn_mfma_f32_16x16x32_bf16(h1, bl, acc1, 0, 0, 0); acc2 = __builtin_amdgcn_mfma_f32_16x16x32_bf16(h2, bl, acc2, 0, 0, 0); } }
    ss = sum_x16(ss); ss = sum_x32(ss);
    const float rinv = rsqrtf(ss * (1.f / D) + EPS);
    float lg[36];
#pragma unroll
    for (int e = 0; e < 4; ++e) { lg[e] = acc0[e]; lg[16 + e] = acc1[e]; lg[32 + e] = acc2[e]; }
#pragma unroll
    for (int q = 1; q < 4; ++q)
#pragma unroll
      for (int e = 0; e < 4; ++e) { const float a0 = acc0[e], a1 = acc1[e];
        lg[4 * q + e] = __int_as_float(__builtin_amdgcn_ds_bpermute((fr + 16 * q) << 2, __float_as_int(a0))); lg[16 + 4 * q + e] = __int_as_float(__builtin_amdgcn_ds_bpermute((fr + 16 * q) << 2, __float_as_int(a1))); }
    if (fq == 0) {
      const float* cr = cj + r * 36;
      float mxg = -1e30f; int g = 0; float gl[4];
#pragma unroll
      for (int j = 0; j < 4; ++j) { gl[j] = rinv * lg[j] + cr[j]; if (gl[j] > mxg) { mxg = gl[j]; g = j; } }
      float sg = 0.f;
#pragma unroll
      for (int j = 0; j < 4; ++j) sg += __expf(gl[j] - mxg);
      const float pg = 1.f / sg;
      float v0 = -1e30f, v1 = -1e30f; int e0 = 0, e1 = 0;
#pragma unroll
      for (int j = 0; j < 8; ++j) { float le = 0.f;
#pragma unroll
        for (int gg = 0; gg < 4; ++gg) if (gg == g) le = lg[4 + gg * 8 + j];
        le = rinv * le + cr[4 + g * 8 + j];
        if (le > v0) { v1 = v0; e1 = e0; v0 = le; e0 = j; } else if (le > v1) { v1 = le; e1 = j; } }
      const float p1 = __expf(v1 - v0); const float inv = pg / (1.f + p1);
      myE0 = g * 8 + e0; myE1 = g * 8 + e1;
      tok_e[2 * m] = myE0; tok_e[2 * m + 1] = myE1; tok_w[2 * m] = inv; tok_w[2 * m + 1] = p1 * inv;
      myR0 = (int)__hip_atomic_fetch_add(&lcnt[myE0], 1u, __ATOMIC_RELAXED, __HIP_MEMORY_SCOPE_WORKGROUP); myR1 = (int)__hip_atomic_fetch_add(&lcnt[myE1], 1u, __ATOMIC_RELAXED, __HIP_MEMORY_SCOPE_WORKGROUP);
    }
  }
  { const int NR2 = skip_ctx ? NB * NLAT : T; const int rpb = NR2 / F.G;
    for (;;) { unsigned q = 0; if (lane2 == 0) q = __hip_atomic_fetch_add(rowctr, 1u, __ATOMIC_RELAXED, __HIP_MEMORY_SCOPE_WORKGROUP); q = (unsigned)__builtin_amdgcn_readfirstlane((int)q); if ((int)q >= rpb) break;
      const int r0 = F.vcu * NWAVES + (int)(q & 7) + (int)(q >> 3) * NGW; const int m = skip_ctx ? (r0 / NLAT) * NTOK + NCTX + (r0 % NLAT) : r0; const int b = m / NTOK, t = m % NTOK, r = t < NCTX ? 8 : b;
      const float4* sh = (const float4*)(mod + (size_t)r * 6 * D + 3 * D); const float4* sc = sh + D / 4; const v2u* xr = (const v2u*)(hs + (size_t)m * D); float4 v[4]; float ss = 0.f;
#pragma unroll
      for (int j = 0; j < 4; ++j) { const v2u w = xr[lane2 + 64 * j]; v[j] = make_float4(bflo(w.x), bfhi(w.x), bflo(w.y), bfhi(w.y)); ss += v[j].x * v[j].x + v[j].y * v[j].y + v[j].z * v[j].z + v[j].w * v[j].w; }
      const float rinv = rsqrtf(wave_sum(ss) * (1.f / D) + EPS);
#pragma unroll
      for (int j = 0; j < 4; ++j) { const float4 a = sc[lane2 + 64 * j], s4 = sh[lane2 + 64 * j];
        v2u o; o.x = pk2(v[j].x * rinv * (1.f + a.x) + s4.x, v[j].y * rinv * (1.f + a.y) + s4.y); o.y = pk2(v[j].z * rinv * (1.f + a.z) + s4.z, v[j].w * rinv * (1.f + a.w) + s4.w);
        ((v2u*)(hn + (size_t)m * D))[lane2 + 64 * j] = o; } } }
  if (skip_ctx) { int neg1 = -1; asm volatile("" : "+v"(neg1)); for (int m = gw; m < T; m += NGW) if ((m % NTOK) < NCTX && lane < 2) tok_e[2 * m + lane] = neg1; }
  __syncthreads();
  if (F.tid < 32) { const unsigned c = lcnt[F.tid]; lbase[F.tid] = c ? atomicAdd(&counts[F.tid], c) : 0u; }
  __syncthreads();
  if (myE0 >= 0) { const int r0 = myR0 + (int)lbase[myE0], r1 = myR1 + (int)lbase[myE1]; tok_r[2 * mym] = r0; tok_r[2 * mym + 1] = r1; slsp[myE0 * T + r0] = mym; slsp[myE1 * T + r1] = mym; }
  __syncthreads();
}
__device__ __forceinline__ void moe_tables(Ctx& F, const Args& A, int l) {
  LAS int* ps = (LAS int*)(F.lds + XSCR_OFF); LAS int* te = ps + 64; LAS int* cn = ps + 256;
  const unsigned* counts = (const unsigned*)(F.ws + WS_CTL) + CW_CNT + l * 64;
  __syncthreads();
  if (F.tid < NE) cn[F.tid] = (int)__hip_atomic_load(counts + F.tid, __ATOMIC_RELAXED, __HIP_MEMORY_SCOPE_AGENT);
  __syncthreads();
  if (F.tid == 0) { int a = 0; for (int e = 0; e < NE; ++e) { ps[e] = a; a += (cn[e] + 255) / 256 * 256; } ps[NE] = a; }
  __syncthreads();
  for (int i = F.tid; i < NT_MOE; i += NTHR) { int e = -1;
    for (int j = 0; j < NE; ++j) if (i * 256 >= ps[j] && i * 256 < ps[j + 1]) e = j;
    if (e >= 0) { const int off = i * 256 - ps[e]; int nv = cn[e] - off; nv = nv > 256 ? 256 : nv; e |= ((nv - 1) << 5) | ((off >> 8) << 13); }
    te[i] = e; }
  __syncthreads();
}
struct MoeSched {
  int G, c, npn, ntile; const char* A; const char* W; size_t aTile, wExp, wTile; const LAS int* te; const int* slot_tok; const unsigned* hec; unsigned* tmo;
  __device__ __forceinline__ bool next(int i, Unit& u) const { int Lx = i * G + c;
    if (hec) { if (c >= 64) Lx = i == 0 ? c - 64 : i == 1 ? 128 + c : 384 + (i - 2) * 256 + (c - 64); else Lx = 576 + i * 256 + c; }
    if (Lx >= ntile * npn) return false; const int rt = Lx / npn, pn = Lx % npn; const int w = te[rt], e = w & 31;
    u.pm = rt; u.pn = pn; u.aux = e; u.a = A + (size_t)rt * aTile; u.b = W + (size_t)e * wExp + (size_t)pn * wTile; u.rows = slot_tok + e * T + (w >> 13) * 256; u.nv = ((w >> 5) & 255) + 1; return true; }
  __device__ __forceinline__ void a_ready(const Unit& u, int tid) const { if (hec) wait_counter(hec + u.pm * 16, 16u, tmo, tid); }
};
constexpr int CW_HEC = 200000;
struct EpiSwiGLU {
  static constexpr bool PERM = true;
  bf16* H; unsigned* cnt;
  __device__ __forceinline__ void operator()(const f32x4 (&acc)[2][2][4][2], const Unit& u, int wr, int wc, int fr, int fq) const {
    const __amdgpu_buffer_rsrc_t rs = __builtin_amdgcn_make_buffer_rsrc(H, 0, (int)SZ_HE, 0x00020000);
#pragma unroll
    for (int ai = 0; ai < 2; ++ai)
#pragma unroll
      for (int m = 0; m < 4; ++m) { const int r = u.pm * 256 + ai * 128 + wr * 64 + m * 16 + fr; float h[8];
#pragma unroll
        for (int n = 0; n < 2; ++n)
#pragma unroll
          for (int e = 0; e < 4; ++e) { const float g = acc[ai][0][m][n][e]; h[4 * n + e] = g * __builtin_amdgcn_rcpf(1.f + __expf(-g)) * acc[ai][1][m][n][e]; }
        v4u w; w.x = cvt_pk_bf16(h[0], h[1]); w.y = cvt_pk_bf16(h[2], h[3]); w.z = cvt_pk_bf16(h[4], h[5]); w.w = cvt_pk_bf16(h[6], h[7]);
        __builtin_amdgcn_raw_buffer_store_b128(w, rs, (r * 256 + u.pn * 128 + wc * 32 + fq * 8) * 2, 0, 16); }
    if (cnt) { asm volatile("s_waitcnt vmcnt(0)" ::: "memory"); if (fr == 0 && fq == 0) __hip_atomic_fetch_add(cnt + u.pm * 16, 1u, __ATOMIC_RELAXED, __HIP_MEMORY_SCOPE_AGENT); }
  }
};
__device__ __forceinline__ void phase_moe_gu(Ctx& F, const Args& A, int l) {
  moe_tables(F, A, l);
  const LAS int* ps = (const LAS int*)(F.lds + XSCR_OFF);
  MoeSched S; S.G = F.G; S.c = (int)blockIdx.x; S.npn = 2; S.ntile = ps[NE] / 256; S.A = (const char*)(F.ws + WS_HN); S.slot_tok = (const int*)(F.ws + WS_SLSP); S.W = (const char*)(F.ws + WS_WGU + l * SZ_WGU1); S.aTile = 0; S.wExp = (size_t)512 * D * 2; S.wTile = (size_t)256 * D * 2; S.te = ps + 64; S.hec = nullptr; S.tmo = nullptr;
  EpiSwiGLU E{(bf16*)(F.ws + WS_HE), F.G == 256 ? (unsigned*)(F.ws + WS_CTL) + CW_HEC + l * 4096 : nullptr};
  gemm_phase<EpiSwiGLU, MoeSched, true, true>(F.lds, F.tid, D * 2, D * 2, D, S, E);
}
__device__ __forceinline__ void phase_moe_dn(Ctx& F, const Args& A, int l) {
  moe_tables(F, A, l);
  const LAS int* ps = (const LAS int*)(F.lds + XSCR_OFF);
  MoeSched S; S.G = F.G; S.c = (int)blockIdx.x; S.npn = 4; S.ntile = ps[NE] / 256; S.slot_tok = (const int*)(F.ws + WS_SLSP); S.A = (const char*)(F.ws + WS_HE); S.W = (const char*)(F.ws + WS_WDN + l * SZ_WDN1); S.aTile = (size_t)256 * 256 * 2; S.wExp = (size_t)D * 256 * 2; S.wTile = (size_t)256 * 256 * 2; S.te = ps + 64; S.hec = F.G == 256 ? (const unsigned*)(F.ws + WS_CTL) + CW_HEC + l * 4096 : nullptr; S.tmo = (unsigned*)(F.ws + WS_CTL) + CW_BAR_TMO;
  EpiStoreBf16 E{(bf16*)(F.ws + WS_FS), D, (int)SZ_FS, F.lds + RING_BYTES};
  gemm_phase<EpiStoreBf16, MoeSched, true>(F.lds, F.tid, 512, 512, 256, S, E);
}
__device__ __forceinline__ void phase_moe_combine(Ctx& F, const Args& A, int l) {
  const int gw = F.vcu * NWAVES + F.wave, NGW = F.G * NWAVES, lane = F.lane;
  float* hs = (float*)(F.ws + WS_HS); const float* mod = (const float*)(F.ws + WS_MOD) + (size_t)l * 9 * 6 * D;
  const int* tok_s = (const int*)(F.ws + WS_TOKS); const float* tok_w = (const float*)(F.ws + WS_TOKW); const bf16* fs = (const bf16*)(F.ws + WS_FS);
  for (int m = gw; m < T; m += NGW) { const int s0 = tok_s[2 * m], s1 = tok_s[2 * m + 1]; if (s0 < 0) continue;
    const int b = m / NTOK, t = m % NTOK, r = t < NCTX ? 8 : b; const float w0 = tok_w[2 * m], w1 = tok_w[2 * m + 1];
    const float4* g5 = (const float4*)(mod + (size_t)r * 6 * D + 5 * D);
#pragma unroll
    for (int j = 0; j < 4; ++j) { const int c4 = lane + 64 * j; const v2u a = ((const v2u*)(fs + (size_t)s0 * D))[c4], bq = ((const v2u*)(fs + (size_t)s1 * D))[c4]; const float4 g = g5[c4];
      float4 h = ((float4*)(hs + (size_t)m * D))[c4];
      h.x += g.x * (w0 * bflo(a.x) + w1 * bflo(bq.x)); h.y += g.y * (w0 * bfhi(a.x) + w1 * bfhi(bq.x)); h.z += g.z * (w0 * bflo(a.y) + w1 * bflo(bq.y)); h.w += g.w * (w0 * bfhi(a.y) + w1 * bfhi(bq.y));
      ((float4*)(hs + (size_t)m * D))[c4] = h; } }
}
}
namespace mk {
constexpr int NKT = NTOK / 64;
constexpr size_t WS_QM = WS_END2B, SZ_QM = (size_t)NB * 4 * NTOK * 96 * 2;
constexpr size_t WS_QD = WS_QM + SZ_QM, SZ_QD = (size_t)NB * 4 * NTOK * 64 * 2;
constexpr size_t WS_KM = WS_QD + SZ_QD, SZ_KM = (size_t)NB * 4 * NKT * 12288;
constexpr size_t WS_KD = WS_KM + SZ_KM, SZ_KD = (size_t)NB * 2 * NKT * 8192;
constexpr size_t WS_VM = WS_KD + SZ_KD, SZ_VM = (size_t)NB * 4 * NKT * 8192;
constexpr size_t WS_VD = WS_VM + SZ_VM, SZ_VD = (size_t)NB * 2 * NKT * 8192;
constexpr size_t WS_END3 = WS_VD + SZ_VD;
constexpr float QSCALE_M = 0.10206207261596577f * 1.4426950408889634f, QSCALE_D = 0.125f * 1.4426950408889634f;

template <int NCB> __device__ __forceinline__ int v_st(int k, int c) { const int kk = (k & ~0xC) | ((k & 4) << 1) | ((k & 8) >> 1); return ((kk >> 3) * NCB + (c >> 5)) * 512 + ((kk & 7) * 32 + (c & 31)) * 2; }
__device__ __forceinline__ int v_rd_base(int lane) { return ((lane & 3) << 3) | (((lane >> 2) & 3) << 6) | (((lane >> 4) & 1) << 5) | (((lane >> 5) & 1) << 8); }
template <int NCB> constexpr int v_rd_off(int d0, int ks, int half) { return d0 * 512 + ks * (2 * NCB * 512) + half * (NCB * 512); }
typedef short s16x4 __attribute__((ext_vector_type(4)));
typedef float f32x16 __attribute__((ext_vector_type(16)));
template <int OFF> __device__ __forceinline__ s16x4 tr_read(int vb) { s16x4 r; asm volatile("ds_read_b64_tr_b16 %0, %1 offset:%2" : "=&v"(r) : "v"(vb), "i"(OFF) : "memory"); return r; }
__device__ __forceinline__ int crow(int r, int hi) { return (r & 3) + 8 * (r >> 2) + 4 * hi; }
#define SBAR() __builtin_amdgcn_sched_barrier(0)

template <int ROT> __device__ __forceinline__ void rope_cs(int t, int i, float& cs, float& sn) {
  constexpr int NF = ROT / 4;
  if (t < NCTX) { cs = 1.f; sn = 0.f; return; }
  const int tl = t - NCTX; const float pos = (i < NF) ? (float)(tl >> 6) : (float)(tl & 63); const int fi = i % NF;
  const float fr = exp2f(-(float)fi * (13.287712379549449f / (float)NF));
  float rev = pos * fr * 0.15915494309189535f; rev = rev - floorf(rev);
  cs = __builtin_amdgcn_cosf(rev); sn = __builtin_amdgcn_sinf(rev);
}

__device__ __forceinline__ void phase_b_rows(Ctx& F, const Args& A, int l) {
  const int gw = F.vcu * NWAVES + F.wave, NGW = F.G * NWAVES, lane = F.lane;
  const bf16* zb = (const bf16*)(F.ws + WS_ZB); bf16* Y = (bf16*)(F.ws + WS_Y);
  const float* gq_gain = A.in[15] + l * 64; const float* gk_gain = A.in[16] + l * 64; const float* w_conv = A.in[14] + l * 3 * 256;
  const float gq = gq_gain[lane], gk = gk_gain[lane];
  float wcv[3][4];
#pragma unroll
  for (int j = 0; j < 3; ++j)
#pragma unroll
    for (int e = 0; e < 4; ++e) wcv[j][e] = w_conv[j * 256 + 4 * lane + e];
  constexpr int RB = 3;
  for (int m0 = gw; m0 < T; m0 += RB * NGW) {
    int mr[RB]; bool ok[RB];
#pragma unroll
    for (int i = 0; i < RB; ++i) { const int mi = m0 + i * NGW; ok[i] = mi < T; mr[i] = ok[i] ? mi : m0; }
    bf16 kpe[RB], gqv[RB][4], gkv[RB][2], gvv[RB][2]; v2u cc[RB][3], cx[RB][3], cb[RB]; float cmask[RB][3];
#pragma unroll
    for (int i = 0; i < RB; ++i) { const int m = mr[i], t = m % NTOK; const bf16* zr = zb + (size_t)m * ZBW;
      kpe[i] = zr[ZB_KPE + (lane & 31)];
#pragma unroll
      for (int h = 0; h < 4; ++h) gqv[i][h] = zr[ZB_GQ + h * 64 + lane];
#pragma unroll
      for (int h = 0; h < 2; ++h) { gkv[i][h] = zr[ZB_GK + h * 64 + lane]; gvv[i][h] = zr[ZB_GV + h * 64 + lane]; }
      const int lo = t < NCTX ? 0 : NCTX, hi = t < NCTX ? NCTX : NTOK;
#pragma unroll
      for (int j = 0; j < 3; ++j) { const int tt = t + j - 1; const bool in = tt >= lo && tt < hi; cmask[i][j] = in ? 1.f : 0.f; const bf16* z2 = zb + (size_t)(in ? m + j - 1 : m) * ZBW;
        cc[i][j] = *(const v2u*)(z2 + ZB_CC + 4 * lane); cx[i][j] = *(const v2u*)(z2 + ZB_CX + 4 * lane); }
      cb[i] = *(const v2u*)(zr + ZB_CB + 4 * lane); }
#pragma unroll
    for (int i = 0; i < RB; ++i) { const int m = mr[i]; const int b = m / NTOK, t = m % NTOK, tile = t >> 6, rr = t & 63; const bool okr = ok[i];
      { const float xv = bf2f(kpe[i]); const float xp = get_x16(xv, lane); float cs, sn; rope_cs<32>(t, lane & 15, cs, sn);
        const float o = (lane & 16) ? (xp * sn + xv * cs) : (xv * cs - xp * sn); const bf16 ob = (bf16)f2bf(o);
        if (lane < 32 && okr) {
#pragma unroll
          for (int h = 0; h < 4; ++h) ((bf16*)(F.ws + WS_KM + ((size_t)(b * 4 + h) * NKT + tile) * 12288))[(8 + (lane >> 3)) * 512 + rr * 8 + (lane & 7)] = ob; } }
      float cs64, sn64; rope_cs<64>(t, lane & 31, cs64, sn64);
#pragma unroll
      for (int h = 0; h < 4; ++h) { const float x0 = bf2f(gqv[i][h]); const float rinv = rsqrtf(wave_sum(x0 * x0) * (1.f / 64.f) + EPS); const float xv = x0 * rinv * gq;
        const float xp = get_x32(xv, lane); const float o = ((lane & 32) ? (xp * sn64 + xv * cs64) : (xv * cs64 - xp * sn64)) * QSCALE_D;
        if (okr) ((bf16*)(F.ws + WS_QD))[((size_t)(b * 4 + h) * NTOK + t) * 64 + lane] = (bf16)f2bf(o); }
#pragma unroll
      for (int h = 0; h < 2; ++h) { const float x0 = bf2f(gkv[i][h]); const float rinv = rsqrtf(wave_sum(x0 * x0) * (1.f / 64.f) + EPS); const float xv = x0 * rinv * gk;
        const float xp = get_x32(xv, lane); const float o = (lane & 32) ? (xp * sn64 + xv * cs64) : (xv * cs64 - xp * sn64);
        if (okr) { ((bf16*)(F.ws + WS_KD + ((size_t)(b * 2 + h) * NKT + tile) * 8192))[(lane >> 3) * 512 + rr * 8 + (lane & 7)] = (bf16)f2bf(o);
          *(bf16*)(F.ws + WS_VD + ((size_t)(b * 2 + h) * NKT + tile) * 8192 + v_st<2>(rr, lane)) = gvv[i][h]; } }
      { float a[4] = {0.f, 0.f, 0.f, 0.f};
#pragma unroll
        for (int j = 0; j < 3; ++j) { const float mk_ = cmask[i][j]; const v2u c1 = cc[i][j], c2 = cx[i][j];
          a[0] += mk_ * wcv[j][0] * bflo(c1.x) * bflo(c2.x); a[1] += mk_ * wcv[j][1] * bfhi(c1.x) * bfhi(c2.x); a[2] += mk_ * wcv[j][2] * bflo(c1.y) * bflo(c2.y); a[3] += mk_ * wcv[j][3] * bfhi(c1.y) * bfhi(c2.y); }
        v2u o; o.x = pk2(bflo(cb[i].x) * a[0], bfhi(cb[i].x) * a[1]); o.y = pk2(bflo(cb[i].y) * a[2], bfhi(cb[i].y) * a[3]);
        if (okr) *(v2u*)(Y + (size_t)m * D + 512 + 4 * lane) = o; } }
  }
}
template <int NWID> __device__ __forceinline__ float seg_rinv(const bf16* seg, int fq) {
  float ss = 0.f;
#pragma unroll
  for (int i = 0; i < NWID / 32; ++i) { const v4u w = *(const v4u*)(seg + fq * (NWID / 4) + i * 8);
    ss += bflo(w.x) * bflo(w.x) + bfhi(w.x) * bfhi(w.x) + bflo(w.y) * bflo(w.y) + bfhi(w.y) * bfhi(w.y) + bflo(w.z) * bflo(w.z) + bfhi(w.z) * bfhi(w.z) + bflo(w.w) * bflo(w.w) + bfhi(w.w) * bfhi(w.w); }
  ss = sum_x16(ss); ss = sum_x32(ss);
  return rsqrtf(ss * (1.f / NWID) + EPS);
}
struct EpiQm {
  static constexpr bool PERM = true;
  const float* rss; bf16* QM;
  __device__ __forceinline__ void operator()(const f32x4 (&acc)[2][2][4][2], const Unit& u, int wr, int wc, int fr, int fq) const {
    if (u.pn == 0) {
#pragma unroll
      for (int ai = 0; ai < 2; ++ai)
#pragma unroll
        for (int m = 0; m < 4; ++m) { const int r = u.pm * 256 + ai * 128 + wr * 64 + m * 16 + fr; const int b = r / NTOK, t = r % NTOK;
          const f32x4 p4 = *(const f32x4*)(rss + (size_t)r * 8); const float sc = rsqrtf(((p4[0] + p4[1]) + (p4[2] + p4[3])) * (1.f / 256.f) + EPS) * QSCALE_M;
#pragma unroll
          for (int bj = 0; bj < 2; ++bj) { const int h = 2 * bj + (wc >> 1), d = 32 * (wc & 1) + 8 * fq; const f32x4 v0 = acc[ai][bj][m][0] * sc, v1 = acc[ai][bj][m][1] * sc;
            v4u w; w.x = cvt_pk_bf16(v0[0], v0[1]); w.y = cvt_pk_bf16(v0[2], v0[3]); w.z = cvt_pk_bf16(v1[0], v1[1]); w.w = cvt_pk_bf16(v1[2], v1[3]);
            *(v4u*)(QM + ((size_t)(b * 4 + h) * NTOK + t) * 96 + d) = w; } }
    } else {
#pragma unroll
      for (int ai = 0; ai < 2; ++ai)
#pragma unroll
        for (int m = 0; m < 4; ++m) { const int r = u.pm * 256 + ai * 128 + wr * 64 + m * 16 + fr; const int b = r / NTOK, t = r % NTOK;
          const f32x4 p4 = *(const f32x4*)(rss + (size_t)r * 8); const float sc = rsqrtf(((p4[0] + p4[1]) + (p4[2] + p4[3])) * (1.f / 256.f) + EPS) * QSCALE_M;
          const int h = wc; const f32x4 x1 = acc[ai][0][m][0] * sc, x2 = acc[ai][0][m][1] * sc; float o1[4], o2[4];
#pragma unroll
          for (int e = 0; e < 4; ++e) { float cs, sn; rope_cs<32>(t, 4 * fq + e, cs, sn); o1[e] = x1[e] * cs - x2[e] * sn; o2[e] = x1[e] * sn + x2[e] * cs; }
          bf16* q = QM + ((size_t)(b * 4 + h) * NTOK + t) * 96 + 64 + 4 * fq;
          v2u w1; w1.x = cvt_pk_bf16(o1[0], o1[1]); w1.y = cvt_pk_bf16(o1[2], o1[3]); *(v2u*)q = w1;
          v2u w2; w2.x = cvt_pk_bf16(o2[0], o2[1]); w2.y = cvt_pk_bf16(o2[2], o2[3]); *(v2u*)(q + 16) = w2; }
    }
  }
};
struct EpiKVm {
  static constexpr bool PERM = true;
  const float* rss; unsigned char* ws;
  __device__ __forceinline__ void operator()(const f32x4 (&acc)[2][2][4][2], const Unit& u, int wr, int wc, int fr, int fq) const {
    const bool isk = __builtin_amdgcn_readfirstlane(wc) < 2;
    const size_t tileB = isk ? 12288 : 8192; unsigned char* base = ws + (isk ? WS_KM : WS_VM);
#pragma unroll
    for (int ai = 0; ai < 2; ++ai)
#pragma unroll
      for (int m = 0; m < 4; ++m) { const int r = u.pm * 256 + ai * 128 + wr * 64 + m * 16 + fr; const int b = r / NTOK, t = r % NTOK, tile = t >> 6, rr = t & 63;
        const f32x4 p4 = *(const f32x4*)(rss + (size_t)r * 8 + 4); const float sc = rsqrtf(((p4[0] + p4[1]) + (p4[2] + p4[3])) * (1.f / 128.f) + EPS);
        const int inoff = isk ? (4 * wc + fq) * 1024 + rr * 16 : v_st<2>(rr, 32 * (wc - 2) + 8 * fq);
#pragma unroll
        for (int bj = 0; bj < 2; ++bj) { const int h = 2 * u.pn + bj; const f32x4 v0 = acc[ai][bj][m][0] * sc, v1 = acc[ai][bj][m][1] * sc;
          v4u w; w.x = cvt_pk_bf16(v0[0], v0[1]); w.y = cvt_pk_bf16(v0[2], v0[3]); w.z = cvt_pk_bf16(v1[0], v1[1]); w.w = cvt_pk_bf16(v1[2], v1[3]);
          *(v4u*)(base + ((size_t)(b * 4 + h) * NKT + tile) * tileB + inoff) = w; } }
  }
};
struct SliceSched {
  TileOrder o; const char* A; const char* B;
  __device__ __forceinline__ bool next(int i, Unit& u) const { int pm, pn; if (!o.tile(i, pm, pn)) return false; u.pm = pm; u.pn = pn; u.aux = 0; u.a = A + (size_t)pm * 256 * ZBW * 2; u.b = B + (size_t)pn * 256 * 512; return true; }
  __device__ __forceinline__ void a_ready(const Unit&, int) const {}
};
__device__ __forceinline__ void phase_b_chunkmix(Ctx& F, const Args& A, int l, const int widx, const int nw) {
  const int lane = F.lane, wave = F.wave, r32 = lane & 31, hi = lane >> 5;
  const bf16* zb = (const bf16*)(F.ws + WS_ZB); bf16* Y = (bf16*)(F.ws + WS_Y); const bf16* wsg = (const bf16*)(F.ws + WS_WSGU + l * SZ_WSGU1);
  const float* sgu_gain = A.in[7] + l * 256; const float* b_s = A.in[9] + l * 4 * 128;
  const float g0 = sgu_gain[4 * lane], g1 = sgu_gain[4 * lane + 1], g2 = sgu_gain[4 * lane + 2], g3 = sgu_gain[4 * lane + 3];
  LAS unsigned char* img = F.lds;
  const int g = wave >> 1, ph = wave & 1;
  for (int ch = widx; ch < T / 128; ch += nw) {
    const int m0 = ch * 128;
    __syncthreads();
    for (int q = wave; q < 128; q += NWAVES) { const v2u w = *(const v2u*)(zb + (size_t)(m0 + q) * ZBW + ZB_AV + 4 * lane);
      const float a0 = gelu_tanh(bflo(w.x)), a1 = gelu_tanh(bfhi(w.x)), a2 = gelu_tanh(bflo(w.y)), a3 = gelu_tanh(bfhi(w.y));
      const float rinv = rsqrtf(wave_sum(a0 * a0 + a1 * a1 + a2 * a2 + a3 * a3) * (1.f / 256.f) + EPS);
      v2u o; o.x = pk2(a0 * rinv * g0, a1 * rinv * g1); o.y = pk2(a2 * rinv * g2, a3 * rinv * g3);
      *(LAS v2u*)(img + v_st<8>(q, 4 * lane)) = o; }
    __syncthreads();
    f32x16 acc[2][2];
#pragma unroll
    for (int a = 0; a < 2; ++a)
#pragma unroll
      for (int c = 0; c < 2; ++c) acc[a][c] = f32x16{};
    const int vb = (int)(uintptr_t)img + v_rd_base(lane) + (2 * g) * 512;
    const bf16* wrow = wsg + ((size_t)g * 128 + 64 * ph + r32) * 128 + 8 * hi;
#define CM_STEP(KS) do { const bf16x8 a0 = *(const bf16x8*)(wrow + 16 * (KS)), a1 = *(const bf16x8*)(wrow + 32 * 128 + 16 * (KS)); \
      const s16x4 l0 = tr_read<v_rd_off<8>(0, KS, 0)>(vb), h0 = tr_read<v_rd_off<8>(0, KS, 1)>(vb), l1 = tr_read<v_rd_off<8>(1, KS, 0)>(vb), h1 = tr_read<v_rd_off<8>(1, KS, 1)>(vb); \
      asm volatile("s_waitcnt lgkmcnt(0)" ::: "memory"); SBAR(); \
      const bf16x8 b0 = (bf16x8){l0[0], l0[1], l0[2], l0[3], h0[0], h0[1], h0[2], h0[3]}, b1 = (bf16x8){l1[0], l1[1], l1[2], l1[3], h1[0], h1[1], h1[2], h1[3]}; \
      acc[0][0] = __builtin_amdgcn_mfma_f32_32x32x16_bf16(a0, b0, acc[0][0], 0, 0, 0); acc[0][1] = __builtin_amdgcn_mfma_f32_32x32x16_bf16(a0, b1, acc[0][1], 0, 0, 0); \
      acc[1][0] = __builtin_amdgcn_mfma_f32_32x32x16_bf16(a1, b0, acc[1][0], 0, 0, 0); acc[1][1] = __builtin_amdgcn_mfma_f32_32x32x16_bf16(a1, b1, acc[1][1], 0, 0, 0); } while (0)
    CM_STEP(0); CM_STEP(1); CM_STEP(2); CM_STEP(3); CM_STEP(4); CM_STEP(5); CM_STEP(6); CM_STEP(7);
#undef CM_STEP
#pragma unroll
    for (int pt = 0; pt < 2; ++pt)
#pragma unroll
      for (int r = 0; r < 16; ++r) { const int p = 64 * ph + 32 * pt + crow(r, hi); const float bs = b_s[g * 128 + p];
#pragma unroll
        for (int cb = 0; cb < 2; ++cb) { const int c = 64 * g + 32 * cb + r32; const float au = gelu_tanh(bf2f(zb[(size_t)(m0 + p) * ZBW + ZB_AU + c]));
          Y[(size_t)(m0 + p) * D + c] = (bf16)f2bf(au * (acc[pt][cb][r] + bs)); } }
  }
  __syncthreads();
}
constexpr float ATT_THR = 8.f;
template <bool FIRST> __device__ __forceinline__ void att_partialSM(f32x16& p0, f32x16& p1, float& m_reg, float& alpha, f32x16& nm) {
  float pmax = p0[0];
#pragma unroll
  for (int r = 1; r < 16; ++r) pmax = fmaxf(pmax, p0[r]);
#pragma unroll
  for (int r = 0; r < 16; ++r) pmax = fmaxf(pmax, p1[r]);
  { auto rr = __builtin_amdgcn_permlane32_swap(__float_as_uint(pmax), opq(__float_as_uint(pmax)), false, false); const unsigned r0 = rr[0], r1 = rr[1]; pmax = fmaxf(__uint_as_float(r0), __uint_as_float(r1)); }
  if (FIRST) { m_reg = pmax; alpha = 1.f;
#pragma unroll
    for (int r = 0; r < 16; ++r) { p0[r] -= pmax; p1[r] -= pmax; nm[r] = -pmax; } }
  else if (__builtin_expect(__all(pmax <= ATT_THR), 1)) { alpha = 1.f; }
  else { const float d = fmaxf(pmax, 0.f); alpha = __builtin_amdgcn_exp2f(-d); m_reg += d; const float nmv = -m_reg;
#pragma unroll
    for (int r = 0; r < 16; ++r) { p0[r] -= d; p1[r] -= d; nm[r] = nmv; } }
#pragma unroll
  for (int r = 0; r < 16; ++r) p0[r] = __builtin_amdgcn_exp2f(p0[r]);
}
__device__ __forceinline__ void att_finishSM(f32x16& p0, f32x16& p1, float alpha, float& l_reg, bf16x8& pa0, bf16x8& pa1, bf16x8& pa2, bf16x8& pa3) {
#pragma unroll
  for (int r = 0; r < 16; ++r) p1[r] = __builtin_amdgcn_exp2f(p1[r]);
  f32x2 ps2 = {0.f, 0.f};
#pragma unroll
  for (int r = 0; r < 16; r += 2) { ps2 += (f32x2){p0[r], p0[r + 1]}; ps2 += (f32x2){p1[r], p1[r + 1]}; }
  float ps = ps2[0] + ps2[1];
  { auto rr = __builtin_amdgcn_permlane32_swap(__float_as_uint(ps), opq(__float_as_uint(ps)), false, false); const unsigned r0 = rr[0], r1 = rr[1]; ps = __uint_as_float(r0) + __uint_as_float(r1); }
  l_reg = l_reg * alpha + ps;
#define PK4(P, BASE, OUT) do { unsigned a0 = cvt_pk_bf16(P[BASE + 0], P[BASE + 1]), a1 = cvt_pk_bf16(P[BASE + 2], P[BASE + 3]);   \
    unsigned b0 = cvt_pk_bf16(P[BASE + 4], P[BASE + 5]), b1 = cvt_pk_bf16(P[BASE + 6], P[BASE + 7]);                              \
    auto r0 = __builtin_amdgcn_permlane32_swap(a0, b0, false, false); auto r1 = __builtin_amdgcn_permlane32_swap(a1, b1, false, false); \
    v4u w = {r0[0], r1[0], r0[1], r1[1]}; OUT = __builtin_bit_cast(bf16x8, w); } while (0)
  PK4(p0, 0, pa0); PK4(p0, 8, pa1); PK4(p1, 0, pa2); PK4(p1, 8, pa3);
#undef PK4
}
template <int DK> __device__ __forceinline__ void att_qkt(f32x16& p0, f32x16& p1, const LAS unsigned char* Ks, const bf16x8* qr, int r32, int hi, const f32x16& nm) {
#pragma unroll
  for (int d0 = 0; d0 < DK / 16; ++d0) { const LAS unsigned char* kb = Ks + (2 * d0 + hi) * 1024 + r32 * 16;
    const bf16x8 b0 = *(const LAS bf16x8*)kb, b1 = *(const LAS bf16x8*)(kb + 512);
    if (d0 == 0) { p0 = __builtin_amdgcn_mfma_f32_32x32x16_bf16(b0, qr[d0], nm, 0, 0, 0); p1 = __builtin_amdgcn_mfma_f32_32x32x16_bf16(b1, qr[d0], nm, 0, 0, 0); }
    else { p0 = __builtin_amdgcn_mfma_f32_32x32x16_bf16(b0, qr[d0], p0, 0, 0, 0); p1 = __builtin_amdgcn_mfma_f32_32x32x16_bf16(b1, qr[d0], p1, 0, 0, 0); } }
}
template <int D0> __device__ __forceinline__ void att_pv_one(f32x16& od, int vb, bf16x8 pa0, bf16x8 pa1, bf16x8 pa2, bf16x8 pa3) {
  const s16x4 l0 = tr_read<v_rd_off<2>(D0, 0, 0)>(vb), h0 = tr_read<v_rd_off<2>(D0, 0, 1)>(vb), l1 = tr_read<v_rd_off<2>(D0, 1, 0)>(vb), h1 = tr_read<v_rd_off<2>(D0, 1, 1)>(vb);
  const s16x4 l2 = tr_read<v_rd_off<2>(D0, 2, 0)>(vb), h2 = tr_read<v_rd_off<2>(D0, 2, 1)>(vb), l3 = tr_read<v_rd_off<2>(D0, 3, 0)>(vb), h3 = tr_read<v_rd_off<2>(D0, 3, 1)>(vb);
  asm volatile("s_waitcnt lgkmcnt(0)" ::: "memory"); SBAR();
#define PK(Lx, Hx) (bf16x8){Lx[0], Lx[1], Lx[2], Lx[3], Hx[0], Hx[1], Hx[2], Hx[3]}
  od = __builtin_amdgcn_mfma_f32_32x32x16_bf16(pa0, PK(l0, h0), od, 0, 0, 0);
  od = __builtin_amdgcn_mfma_f32_32x32x16_bf16(pa1, PK(l1, h1), od, 0, 0, 0);
  od = __builtin_amdgcn_mfma_f32_32x32x16_bf16(pa2, PK(l2, h2), od, 0, 0, 0);
  od = __builtin_amdgcn_mfma_f32_32x32x16_bf16(pa3, PK(l3, h3), od, 0, 0, 0);
#undef PK
}
template <int DK>
__device__ __forceinline__ void attn_unit(LAS unsigned char* lds, const int tid, const bf16* __restrict__ Qb, const unsigned char* __restrict__ Kt, const unsigned char* __restrict__ Vt, const int NT, bf16* Ob) {
  constexpr int KB = DK * 128, ND = DK / 16;
  const int wid = __builtin_amdgcn_readfirstlane(tid >> 6), lane = tid & 63, r32 = lane & 31, hi = lane >> 5;
  LAS unsigned char* Vl = lds; LAS unsigned char* Kl = lds + 16384; LAS float* wsf = (LAS float*)(lds + 16384 + 2 * KB) + wid * 64; LAS float* li_l = wsf; LAS float* al_l = wsf + 32;
  LAS bf16* stg = (LAS bf16*)(lds + 16384 + 2 * KB + 2048) + wid * 2048;
  float m_reg = 0.f, l_reg = 0.f; f32x16 o[2] = {f32x16{}, f32x16{}}; f32x16 nm = f32x16{}; bf16x8 qr[ND];
  const bf16* Qw = Qb + (size_t)(wid * 32 + r32) * DK + hi * 8;
#pragma unroll
  for (int d0 = 0; d0 < ND; ++d0) qr[d0] = *(const bf16x8*)(Qw + d0 * 16);
  const bool has2 = (DK == 96) && (wid < 4);
  const int vb0 = (int)(uintptr_t)Vl + v_rd_base(lane);
  struct { v4u k0, k1, v; } sr_[2];
#define SLOAD(i, tl) do { const unsigned char* kp_ = Kt + (size_t)(tl) * KB + tid * 16; sr_[i].k0 = *(const v4u*)kp_; if (has2) sr_[i].k1 = *(const v4u*)(kp_ + 8192); sr_[i].v = *(const v4u*)(Vt + (size_t)(tl) * 8192 + tid * 16); } while (0)
#define SWRITE(b, i) do { *(LAS v4u*)(Kl + (b) * KB + tid * 16) = sr_[i].k0; if (has2) *(LAS v4u*)(Kl + (b) * KB + 8192 + tid * 16) = sr_[i].k1; *(LAS v4u*)(Vl + (b) * 8192 + tid * 16) = sr_[i].v; } while (0)
#define RESC(a) do { if (__any((a) < 1.f)) { if (hi == 0) al_l[r32] = (a); asm volatile("s_waitcnt lgkmcnt(0)" ::: "memory"); \
    _Pragma("unroll") for (int d = 0; d < 2; ++d) _Pragma("unroll") for (int r = 0; r < 16; ++r) o[d][r] *= al_l[crow(r, hi)]; } } while (0)
  f32x16 pA0, pA1, pB0, pB1; float alA, alB; bf16x8 pa0, pa1, pa2, pa3;
  SLOAD(0, 0); SWRITE(0, 0); __syncthreads();
  att_qkt<DK>(pA0, pA1, Kl, qr, r32, hi, nm); att_partialSM<true>(pA0, pA1, m_reg, alA, nm);
  SLOAD(1, 1); SLOAD(0, 2);
  SWRITE(1, 1); __syncthreads();
#pragma unroll 1
  for (int j = 1; j + 1 < NT; j += 2) {
    SBAR(); att_qkt<DK>(pB0, pB1, Kl + KB, qr, r32, hi, nm);
    att_finishSM(pA0, pA1, alA, l_reg, pa0, pa1, pa2, pa3); SBAR();
    SLOAD(1, j + 2); SBAR();
    att_pv_one<0>(o[0], vb0, pa0, pa1, pa2, pa3); att_pv_one<1>(o[1], vb0, pa0, pa1, pa2, pa3); att_partialSM<false>(pB0, pB1, m_reg, alB, nm);
    __syncthreads(); SWRITE(0, 0);
    RESC(alB); __syncthreads();
    SBAR(); att_qkt<DK>(pA0, pA1, Kl, qr, r32, hi, nm);
    att_finishSM(pB0, pB1, alB, l_reg, pa0, pa1, pa2, pa3); SBAR();
    if (j + 3 < NT) SLOAD(0, j + 3); SBAR();
    att_pv_one<0>(o[0], vb0 + 8192, pa0, pa1, pa2, pa3); att_pv_one<1>(o[1], vb0 + 8192, pa0, pa1, pa2, pa3); att_partialSM<false>(pA0, pA1, m_reg, alA, nm);
    __syncthreads(); SWRITE(1, 1);
    RESC(alA); __syncthreads();
  }
  SBAR(); att_qkt<DK>(pB0, pB1, Kl + KB, qr, r32, hi, nm);
  att_finishSM(pA0, pA1, alA, l_reg, pa0, pa1, pa2, pa3); SBAR();
  att_pv_one<0>(o[0], vb0, pa0, pa1, pa2, pa3); att_pv_one<1>(o[1], vb0, pa0, pa1, pa2, pa3); att_partialSM<false>(pB0, pB1, m_reg, alB, nm);
  __syncthreads(); RESC(alB);
  att_finishSM(pB0, pB1, alB, l_reg, pa0, pa1, pa2, pa3); SBAR();
  att_pv_one<0>(o[0], vb0 + 8192, pa0, pa1, pa2, pa3); att_pv_one<1>(o[1], vb0 + 8192, pa0, pa1, pa2, pa3);
  if (hi == 0) li_l[r32] = l_reg; asm volatile("s_waitcnt lgkmcnt(0)" ::: "memory");
#pragma unroll
  for (int r = 0; r < 16; ++r) { const float rl = __builtin_amdgcn_rcpf(li_l[crow(r, hi)]); const int orow = crow(r, hi);
    stg[orow * 64 + r32] = (bf16)f2bf(o[0][r] * rl); stg[orow * 64 + 32 + r32] = (bf16)f2bf(o[1][r] * rl); }
  asm volatile("s_waitcnt lgkmcnt(0)" ::: "memory");
#pragma unroll
  for (int i = 0; i < 4; ++i) { const int row = i * 8 + (lane >> 3), ch = lane & 7; const v4u v = *(const LAS v4u*)(stg + row * 64 + ch * 8); *(v4u*)(Ob + (size_t)(wid * 32 + row) * D + ch * 8) = v; }
#undef SLOAD
#undef SWRITE
#undef RESC
}
__device__ __forceinline__ void phase_attn(Ctx& F, const Args& A, bool skipctx = false) {
  for (int i = 0;; ++i) {
    const int Lx = i * F.G + (int)blockIdx.x; if (Lx >= (skipctx ? 512 : 576)) break;
    int kind, b, h, qb;
    if (Lx < 512) { kind = Lx >> 8; const int rem = Lx & 255; b = rem & 7; const int idx = rem >> 3; h = idx >> 3; qb = 1 + (idx & 7); }
    else { const int ll = Lx - 512; b = ll & 7; const int j = ll >> 3; kind = j >> 2; h = j & 3; qb = 0; }
    const int NT = qb == 0 ? 4 : NKT;
    bf16* Ob = (bf16*)(F.ws + WS_Y) + (size_t)(b * NTOK + qb * 256) * D + (kind == 0 ? 256 : 768) + h * 64;
    if (kind == 0) attn_unit<96>(F.lds, F.tid, (const bf16*)(F.ws + WS_QM) + ((size_t)(b * 4 + h) * NTOK + qb * 256) * 96, F.ws + WS_KM + (size_t)(b * 4 + h) * NKT * 12288, F.ws + WS_VM + (size_t)(b * 4 + h) * NKT * 8192, NT, Ob);
    else attn_unit<64>(F.lds, F.tid, (const bf16*)(F.ws + WS_QD) + ((size_t)(b * 4 + h) * NTOK + qb * 256) * 64, F.ws + WS_KD + (size_t)(b * 2 + (h >> 1)) * NKT * 8192, F.ws + WS_VD + (size_t)(b * 2 + (h >> 1)) * NKT * 8192, NT, Ob);
  }
  __syncthreads();
}
__device__ __forceinline__ void phase_b(Ctx& F, const Args& A, int l) {
  phase_b_rows(F, A, l);
  refresh_ctx(F, A);
  const bool split = F.G >= 200; const int c = (int)blockIdx.x;
  if (!split || c >= 144) {
    const int gsub = split ? F.G - 144 : F.G, csub = split ? c - 144 : c;
    { SliceSched S; S.o.init(NROWT, 2, gsub, csub); S.A = (const char*)(F.ws + WS_ZB) + ZB_MQ * 2; S.B = (const char*)(F.ws + WS_WUQ + l * SZ_WUQ1);
      EpiQm E{(const float*)(F.ws + WS_RSS), (bf16*)(F.ws + WS_QM)}; gemm_phase<EpiQm, SliceSched, true>(F.lds, F.tid, ZBW * 2, 512, 256, S, E); }
    refresh_ctx(F, A);
    { SliceSched S; S.o.init(NROWT, 2, gsub, csub); S.A = (const char*)(F.ws + WS_ZB) + ZB_MKV * 2; S.B = (const char*)(F.ws + WS_WUKV + l * SZ_WUKV1);
      EpiKVm E{(const float*)(F.ws + WS_RSS), F.ws}; gemm_phase<EpiKVm, SliceSched, true>(F.lds, F.tid, ZBW * 2, 512, 256, S, E); }
    refresh_ctx(F, A);
  }
  if (!split) phase_b_chunkmix(F, A, l, c, F.G); else if (c < 144) phase_b_chunkmix(F, A, l, c, 144);
}
}
namespace mk {
__device__ __forceinline__ void phase_norm_mod(Ctx& F, const Args& A, int l, bool dry = false) {
  const int gw = F.vcu * NWAVES + F.wave, NGW = F.G * NWAVES, lane = F.lane;
  if (F.vcu < 9 && !dry) {
    const int r = F.vcu; const float* sh = (const float*)(F.ws + WS_MOD) + (size_t)l * 9 * 6 * D + (size_t)r * 6 * D + 3 * D;
    const float* wgr = A.in[21] + (size_t)l * D * 4; const float* bgr = A.in[22] + l * 4; const float* wer = A.in[23] + (size_t)l * D * 32; const float* ber = A.in[24] + l * 32;
    for (int j = F.wave; j < 36; j += NWAVES) { float s = 0.f;
#pragma unroll 4
      for (int i = 0; i < 16; ++i) { const int k = lane + 64 * i; s += sh[k] * (j < 4 ? wgr[k * 4 + j] : wer[k * 32 + (j - 4)]); }
      s = wave_sum(s); if (lane == 0) ((float*)(F.ws + WS_CJ))[l * (9 * 36) + r * 36 + j] = s + (j < 4 ? bgr[j] : ber[j - 4]); } }
  bf16* hs = (bf16*)(F.ws + WS_HS); bf16* hn = (bf16*)(F.ws + WS_HN); const float* mod = (const float*)(F.ws + WS_MOD) + (size_t)l * 9 * 6 * D;
  const int* tok_e = (const int*)(F.ws + WS_TOKE); const int* tok_r = (const int*)(F.ws + WS_TOKR); const float* tok_w = (const float*)(F.ws + WS_TOKW); const bf16* fs = (const bf16*)(F.ws + WS_FS);
  const LAS int* ps = (const LAS int*)(F.lds + XSCR_OFF); if (l > 0 && !dry) moe_tables(F, A, l - 1);
  for (int m = gw; m < T; m += NGW) {
    const int b = m / NTOK, t = m % NTOK, r = t < NCTX ? 8 : b;
    const float4* xr = t < NCTX ? (const float4*)(A.in[2] + ((size_t)b * NCTX + t) * D) : (const float4*)(A.in[0] + ((size_t)b * NLAT + (t - NCTX)) * D); const v2u* hr = (const v2u*)(hs + (size_t)m * D);
    const float4* sh = (const float4*)(mod + (size_t)r * 6 * D); const float4* sc = sh + D / 4;
    float4 v[4]; float ss = 0.f;
    if (l == 0 && !dry) {
#pragma unroll
      for (int j = 0; j < 4; ++j) v[j] = xr[lane + 64 * j]; }
    else {
#pragma unroll
      for (int j = 0; j < 4; ++j) { const v2u w = hr[lane + 64 * j]; v[j] = make_float4(bflo(w.x), bfhi(w.x), bflo(w.y), bfhi(w.y)); } }
    if (l > 0 && !dry) { const int s0 = ps[tok_e[2 * m]] + tok_r[2 * m], s1 = ps[tok_e[2 * m + 1]] + tok_r[2 * m + 1]; const float w0 = tok_w[2 * m], w1 = tok_w[2 * m + 1]; const float4* g5 = (const float4*)(mod - (size_t)9 * 6 * D + (size_t)r * 6 * D + 5 * D);
#pragma unroll
      for (int j = 0; j < 4; ++j) { const int c4 = lane + 64 * j; const v2u a = ((const v2u*)(fs + (size_t)s0 * D))[c4], bq = ((const v2u*)(fs + (size_t)s1 * D))[c4]; const float4 g = g5[c4];
        v[j].x += g.x * (w0 * bflo(a.x) + w1 * bflo(bq.x)); v[j].y += g.y * (w0 * bfhi(a.x) + w1 * bfhi(bq.x)); v[j].z += g.z * (w0 * bflo(a.y) + w1 * bflo(bq.y)); v[j].w += g.w * (w0 * bfhi(a.y) + w1 * bfhi(bq.y)); } }
#pragma unroll
    for (int j = 0; j < 4; ++j) { v2u w; w.x = pk2(v[j].x, v[j].y); w.y = pk2(v[j].z, v[j].w); ((v2u*)(hs + (size_t)m * D))[lane + 64 * j] = w;
      v[j] = make_float4(bflo(w.x), bfhi(w.x), bflo(w.y), bfhi(w.y)); ss += v[j].x * v[j].x + v[j].y * v[j].y + v[j].z * v[j].z + v[j].w * v[j].w; }
    const float rinv = rsqrtf(wave_sum(ss) * (1.f / D) + EPS);
#pragma unroll
    for (int j = 0; j < 4; ++j) { const float4 a = sc[lane + 64 * j], s4 = sh[lane + 64 * j];
      v2u o; o.x = pk2(v[j].x * rinv * (1.f + a.x) + s4.x, v[j].y * rinv * (1.f + a.y) + s4.y); o.y = pk2(v[j].z * rinv * (1.f + a.z) + s4.z, v[j].w * rinv * (1.f + a.w) + s4.w);
      ((v2u*)(hn + (size_t)m * D))[lane + 64 * j] = o;
      { const float h0 = v[j].x * rinv * (1.f + a.x) + s4.x, h1 = v[j].y * rinv * (1.f + a.y) + s4.y, h2 = v[j].z * rinv * (1.f + a.z) + s4.z, h3 = v[j].w * rinv * (1.f + a.w) + s4.w;
        int w8 = 0; w8 = __builtin_amdgcn_cvt_pk_fp8_f32(h0, h1, w8, false); w8 = __builtin_amdgcn_cvt_pk_fp8_f32(h2, h3, w8, true); ((int*)(F.ws + WS_HN8 + (size_t)m * D))[lane + 64 * j] = w8; } }
  }
}
__device__ __forceinline__ void phase_final(Ctx& F, const Args& A) {
  const int gw = F.vcu * NWAVES + F.wave, NGW = F.G * NWAVES, lane = F.lane;
  const bf16* hs = (const bf16*)(F.ws + WS_HS); const float* mod = (const float*)(F.ws + WS_MOD) + (size_t)(L - 1) * 9 * 6 * D; const float4* fg = (const float4*)A.in[27];
  const int* tok_e = (const int*)(F.ws + WS_TOKE); const int* tok_r = (const int*)(F.ws + WS_TOKR); const float* tok_w = (const float*)(F.ws + WS_TOKW); const bf16* fs = (const bf16*)(F.ws + WS_FS);
  const LAS int* ps = (const LAS int*)(F.lds + XSCR_OFF); moe_tables(F, A, L - 1);
  for (int rI = gw; rI < NB * NLAT; rI += NGW) {
    const int b = rI / NLAT, tl = rI % NLAT; const size_t m = (size_t)b * NTOK + NCTX + tl;
    const v2u* xr = (const v2u*)(hs + m * D); float4 v[4]; float ss = 0.f;
    const int s0 = ps[tok_e[2 * m]] + tok_r[2 * m], s1 = ps[tok_e[2 * m + 1]] + tok_r[2 * m + 1]; const float w0 = tok_w[2 * m], w1 = tok_w[2 * m + 1]; const float4* g5 = (const float4*)(mod + (size_t)b * 6 * D + 5 * D);
#pragma unroll
    for (int j = 0; j < 4; ++j) { const int c4 = lane + 64 * j; { const v2u w = xr[c4]; v[j] = make_float4(bflo(w.x), bfhi(w.x), bflo(w.y), bfhi(w.y)); } const v2u a = ((const v2u*)(fs + (size_t)s0 * D))[c4], bq = ((const v2u*)(fs + (size_t)s1 * D))[c4]; const float4 g = g5[c4];
      v[j].x += g.x * (w0 * bflo(a.x) + w1 * bflo(bq.x)); v[j].y += g.y * (w0 * bfhi(a.x) + w1 * bfhi(bq.x)); v[j].z += g.z * (w0 * bflo(a.y) + w1 * bflo(bq.y)); v[j].w += g.w * (w0 * bfhi(a.y) + w1 * bfhi(bq.y));
      ss += v[j].x * v[j].x + v[j].y * v[j].y + v[j].z * v[j].z + v[j].w * v[j].w; }
    const float rinv = rsqrtf(wave_sum(ss) * (1.f / D) + EPS);
#pragma unroll
    for (int j = 0; j < 4; ++j) { const float4 g = fg[lane + 64 * j]; float4 o; o.x = v[j].x * rinv * g.x; o.y = v[j].y * rinv * g.y; o.z = v[j].z * rinv * g.z; o.w = v[j].w * rinv * g.w; ((float4*)(A.out + (size_t)rI * D))[lane + 64 * j] = o; }
  }
}
constexpr int CW_BAR = 16384;
__global__ void __launch_bounds__(NTHR, 2) mk_kernel(Args a) {
  extern __shared__ __attribute__((aligned(16))) unsigned char lds_raw[];
  Ctx F; F.lds = (LAS unsigned char*)lds_raw; F.ws = a.ws;
  { const int t0 = threadIdx.x; F.wave = __builtin_amdgcn_readfirstlane(t0 >> 6); }
  F.lane = (int)__builtin_amdgcn_mbcnt_hi(~0u, __builtin_amdgcn_mbcnt_lo(~0u, 0u)); F.tid = F.wave * 64 + F.lane;
  F.G = gridDim.x; { const int bx = blockIdx.x; F.vcu = (F.G % 8 == 0) ? (bx % 8) * (F.G / 8) + bx / 8 : bx; }
  volatile LAS unsigned* st = (volatile LAS unsigned*)(F.lds + MISC_OFF);
  if (F.tid < 4) st[F.tid] = 0u;
  __syncthreads();
  XcdBarrier bar = xcd_barrier_post((unsigned*)(F.ws + WS_CTL) + CW_BAR, st, F.tid == 0);
#define GRID_BAR() do { { unsigned char* w_ = a.ws; asm volatile("" : "+s"(w_)); unsigned x_ = bar.x; asm volatile("" : "+s"(x_)); bar.x = x_; bar.bar = (unsigned*)(w_ + WS_CTL) + CW_BAR; xcd_barrier(bar, F.tid == 0); F.ws = w_; } \
    int wv_ = F.wave; asm volatile("" : "+s"(wv_)); F.wave = wv_; unsigned z_ = 0u; asm volatile("" : "+v"(z_)); const int l_ = (int)__builtin_amdgcn_mbcnt_hi(~0u, __builtin_amdgcn_mbcnt_lo(~0u, z_)); F.lane = l_; F.tid = wv_ * 64 + l_; } while (0)
#ifndef DUP
#define DUP 0
#endif
#ifndef GPM
#define GPM 0
#endif
  phase_prep(F, a); GRID_BAR();
  if (DUP & 256) { phase_prep(F, a); GRID_BAR(); }
#pragma unroll 1
  for (int l = 0; l < L; ++l) {
    phase_norm_mod(F, a, l); GRID_BAR();
    phase_zgemm(F, a, l); GRID_BAR();
    if (DUP & 1) { phase_zgemm(F, a, l, GPM); GRID_BAR(); }
    phase_b(F, a, l); GRID_BAR();
    if (DUP & 2) { phase_b(F, a, l); GRID_BAR(); }
    if (DUP & 8192) { phase_b_rows(F, a, l); GRID_BAR(); }
    if (DUP & 16384) { const int c = (int)blockIdx.x; if (c < 144) phase_b_chunkmix(F, a, l, c, 144); GRID_BAR(); }
    const bool lastl = l == L - 1;
    phase_attn(F, a, lastl); GRID_BAR();
    phase_branch(F, a, l, lastl);
    if (F.G == 256) refresh_ctx(F, a); else GRID_BAR();
    phase_gate(F, a, l, lastl);
    if (F.G == 256) refresh_ctx(F, a); else GRID_BAR();
    phase_out(F, a, l, 1.f, F.G == 256, lastl); GRID_BAR();
    phase_norm_router(F, a, l, l == L - 1); GRID_BAR();
    phase_moe_gu(F, a, l);
    if (F.G == 256) refresh_ctx(F, a); else GRID_BAR();
    phase_moe_dn(F, a, l); GRID_BAR();
    if (DUP & 1024) { phase_norm_mod(F, a, l, true); GRID_BAR(); }
    if (DUP & 2048) { phase_out(F, a, l, 0.f, false); GRID_BAR(); }
    if (DUP & 128) { phase_gate<GPM>(F, a, l, lastl, CW_TILE); GRID_BAR(); }
    if (DUP & 64) { phase_gate(F, a, l, lastl, CW_TILE); refresh_ctx(F, a); phase_out(F, a, l, 0.f, true, lastl, CW_TILE); GRID_BAR(); }
    if (DUP & 4096) { phase_norm_router(F, a, l, l == L - 1, true); GRID_BAR(); }
    if (DUP & 512) { GRID_BAR(); GRID_BAR(); GRID_BAR(); GRID_BAR(); GRID_BAR(); GRID_BAR(); GRID_BAR(); GRID_BAR(); GRID_BAR(); GRID_BAR(); }
  }
  phase_final(F, a);
}
}

extern "C" void kernel_launch(void* const* d_in, const int* in_sizes, int n_in, void* d_out, int out_size, void* d_ws, size_t ws_size, hipStream_t stream) {
  using namespace mk;
  static int grid = 0;
  if (grid == 0) {
    int dev = 0, cus = 0, per_cu = 0;
    hipGetDevice(&dev); hipDeviceGetAttribute(&cus, hipDeviceAttributeMultiprocessorCount, dev);
    hipFuncSetAttribute((const void*)mk_kernel, hipFuncAttributeMaxDynamicSharedMemorySize, LDS_BYTES);
    hipOccupancyMaxActiveBlocksPerMultiprocessor(&per_cu, (const void*)mk_kernel, NTHR, LDS_BYTES);
    grid = per_cu >= 1 ? cus : -1;
  }
  if (grid < 0 || WS_END3 > ws_size) { fprintf(stderr, "kernel_launch: cannot run (grid %d, ws need %zu have %zu)\n", grid, (size_t)WS_END3, ws_size); (void)hipMemsetAsync(d_out, 0xFF, (size_t)out_size * 4, stream); return; }
  Args a{}; for (int i = 0; i < 28; ++i) a.in[i] = (const float*)d_in[i]; a.out = (float*)d_out; a.ws = (unsigned char*)d_ws;
  (void)hipMemsetAsync(d_ws, 0, CTL_BYTES, stream);
  void* args[] = {&a};
  hipError_t e = hipLaunchCooperativeKernel((const void*)mk_kernel, dim3(grid), dim3(NTHR), args, LDS_BYTES, stream);
  if (e != hipSuccess) fprintf(stderr, "kernel_launch: cooperative launch failed: %s (grid %d)\n", hipGetErrorString(e), grid);
}
```

```cpp
#include <hip/hip_runtime.h>
#include <cstdio>
#include <cstdint>
namespace g8 {
#define G8_LAS __attribute__((address_space(3)))
typedef unsigned short bf16_t;
typedef short bf16x8 __attribute__((ext_vector_type(8)));
typedef float f32x4 __attribute__((ext_vector_type(4)));
typedef float f32x2 __attribute__((ext_vector_type(2)));
typedef unsigned u32x4 __attribute__((ext_vector_type(4)));
typedef unsigned u32x2 __attribute__((ext_vector_type(2)));
typedef int i32x4 __attribute__((ext_vector_type(4)));
typedef int i32x8 __attribute__((ext_vector_type(8)));
constexpr int BM = 256, BK = 64, HALF = 128, HTB = HALF * BK * 2, STAGE_BYTES = 8 * HTB;

__host__ __device__ __forceinline__ int lds_byte(int r, int c) { const int st = (r >> 4) * 2 + (c >> 5), rr = r & 15, cc = c & 31, ob = rr * 64 + cc * 2; return st * 1024 + (ob ^ (((ob >> 9) & 1) << 5)); }
__host__ __device__ __forceinline__ void stage_rc(int b, int& R, int& C) { const int st = b / 1024, sb = b % 1024, swz = sb ^ (((sb >> 9) & 1) << 5); R = (st >> 1) * 16 + swz / 64; C = (st & 1) * 32 + (swz % 64) / 2; }
__host__ __device__ __forceinline__ int perm32(int rho) { const int n = rho >> 4, i = rho & 15; return 8 * (i >> 2) + 4 * n + (i & 3); }

struct Unit { const char* a; const char* b; const int* rows; int pm, pn, aux, nv; };

__device__ __forceinline__ unsigned cvt_pk_bf16(float lo, float hi) { unsigned r; asm volatile("v_cvt_pk_bf16_f32 %0, %1, %2" : "=v"(r) : "v"(lo), "v"(hi)); return r; }

template <class...> using void_tt = void;
template <class E, class = void> struct has_acc_init { static constexpr bool value = false; };
template <class E> struct has_acc_init<E, void_tt<decltype(&E::acc_init)>> { static constexpr bool value = true; };
template <class Epi, class Sched, bool ALIGN_EPI, bool GATHER = false, bool FP8 = false>
__device__ __forceinline__ void gemm_phase(G8_LAS unsigned char* lds, const int tid, const int ldaB, const int ldbB, const int K, const Sched& S, const Epi& E) {
    const int wid = __builtin_amdgcn_readfirstlane(tid >> 6), lane = tid & 63, wr = wid >> 2, wc = wid & 3, fr = lane & 15, fq = lane >> 4;
    const int nt = K / BK;
    unsigned voffA[2], voffB[2]; int Rr[2], Cc2[2];
#pragma unroll
    for (int i = 0; i < 2; ++i) { int R, C; stage_rc(tid * 16 + i * 8192, R, C); const int Rb = Epi::PERM ? ((R & ~31) + perm32(R & 31)) : R; Rr[i] = R; Cc2[i] = C * 2;
        voffA[i] = (unsigned)(R * ldaB + C * 2); voffB[i] = (unsigned)(Rb * ldbB + C * 2); }
    const size_t kstep = (size_t)(BK * 2);
    const size_t hstepA = (size_t)HALF * ldaB, hstepB = (size_t)HALF * ldbB;
    const unsigned ldsw = (unsigned)wid * 1024u;
    const G8_LAS unsigned char* abase = lds + (FP8 ? lds_byte(wr * 64 + fr, fq * 16) : lds_byte(wr * 64 + fr, fq * 8));
    const G8_LAS unsigned char* bbase = lds + 4 * HTB + (FP8 ? lds_byte(wc * 32 + fr, fq * 16) : lds_byte(wc * 32 + fr, fq * 8));
#define G8_SA(b, h) (((b) * 2 + (h)) * HTB)
#define G8_SB(b, h) ((4 + (b) * 2 + (h)) * HTB)
#define G8_STAGE(bufoff, gbase, voff) do { _Pragma("unroll") for (int _i = 0; _i < 2; ++_i) \
        __builtin_amdgcn_global_load_lds((const unsigned*)((const char*)(gbase) + (voff)[_i]), (G8_LAS unsigned*)(lds + (bufoff) + ldsw + _i * 8192), 16, 0, 0); } while (0)
#define G8_STAGE_A(bufoff, h, base, nx) do { if constexpr (GATHER) { unsigned vo_[2] = {(nx) ? gvN[h][0] : gvC[h][0], (nx) ? gvN[h][1] : gvC[h][1]}; G8_STAGE(bufoff, base, vo_); } else { G8_STAGE(bufoff, (base) + ((h) ? hstepA : 0), voffA); } } while (0)
#define G8_LDA(dst, b, h) do { if constexpr (FP8) { _Pragma("unroll") for (int m = 0; m < 4; ++m) dst##8[m] = *(const G8_LAS i32x8*)(abase + (G8_SA(b, h) + m * 2048)); } \
      else { _Pragma("unroll") for (int m = 0; m < 4; ++m) _Pragma("unroll") for (int k = 0; k < 2; ++k) dst[m][k] = *(const G8_LAS bf16x8*)(abase + (G8_SA(b, h) + m * 2048 + k * 1024)); } } while (0)
#define G8_LDB(dst, b, h) do { if constexpr (FP8) { _Pragma("unroll") for (int n = 0; n < 2; ++n) dst##8[n] = *(const G8_LAS i32x8*)(bbase + (((b) * 2 + (h)) * HTB + n * 2048)); } \
      else { _Pragma("unroll") for (int n = 0; n < 2; ++n) _Pragma("unroll") for (int k = 0; k < 2; ++k) dst[n][k] = *(const G8_LAS bf16x8*)(bbase + (((b) * 2 + (h)) * HTB + n * 2048 + k * 1024)); } } while (0)
#define G8_MMA(ai, bj, At, Bt) do { __builtin_amdgcn_s_setprio(1); if constexpr (FP8) { _Pragma("unroll") for (int m = 0; m < 4; ++m) _Pragma("unroll") for (int n = 0; n < 2; ++n) \
        asm volatile("v_mfma_scale_f32_16x16x128_f8f6f4 %0, %1, %2, %0, %3, %3 op_sel_hi:[0,0,0]" : "+v"(acc[ai][bj][m][n]) : "v"(Bt##8[n]), "v"(At##8[m]), "v"(sc1f8)); } \
      else { _Pragma("unroll") for (int m = 0; m < 4; ++m) _Pragma("unroll") for (int n = 0; n < 2; ++n) _Pragma("unroll") for (int k = 0; k < 2; ++k) \
        acc[ai][bj][m][n] = __builtin_amdgcn_mfma_f32_16x16x32_bf16(Bt[n][k], At[m][k], acc[ai][bj][m][n], 0, 0, 0); } __builtin_amdgcn_s_setprio(0); } while (0)
#define G8_WAIT_V(n) asm volatile("s_waitcnt vmcnt(" #n ")" ::: "memory")
#define G8_WAIT_L(n) asm volatile("s_waitcnt lgkmcnt(" #n ")" ::: "memory")
#define G8_BAR __builtin_amdgcn_s_barrier()
#define G8_SCHED __builtin_amdgcn_sched_barrier(0)
    Unit cur, nxt; int ui = 0;
    if (!S.next(0, cur)) return;
    f32x4 acc[2][2][4][2];
#pragma unroll
    for (int a = 0; a < 2; ++a)
#pragma unroll
        for (int b = 0; b < 2; ++b)
#pragma unroll
            for (int m = 0; m < 4; ++m)
#pragma unroll
                for (int n = 0; n < 2; ++n) acc[a][b][m][n] = (f32x4){0.f, 0.f, 0.f, 0.f};
    if constexpr (has_acc_init<Epi>::value) E.acc_init(acc, cur, wr, wc, fr, fq);
    bf16x8 At[4][2], B0[2][2], B1[2][2]; i32x8 At8[4], B08[2], B18[2];
    int sc1f8 = 0x7F7F7F7F; if constexpr (FP8) asm volatile("" : "+v"(sc1f8));
    const char* cA = cur.a; const char* cB = cur.b;
    S.a_ready(cur, tid);
    unsigned gvC[2][2], gvN[2][2];
    if constexpr (GATHER) {
#pragma unroll
        for (int h = 0; h < 2; ++h)
#pragma unroll
            for (int i = 0; i < 2; ++i) { gvC[h][i] = (h * 128 + Rr[i] < cur.nv ? (unsigned)cur.rows[h * 128 + Rr[i]] : 0u) * (unsigned)ldaB + (unsigned)Cc2[i]; gvN[h][i] = gvC[h][i]; } }
    G8_STAGE(G8_SB(0, 0), cB, voffB); G8_STAGE(G8_SB(0, 1), cB + hstepB, voffB); G8_STAGE_A(G8_SA(0, 0), 0, cA, false); G8_STAGE_A(G8_SA(0, 1), 1, cA, false);
    if (wr == 1) G8_BAR;
    G8_WAIT_V(2); G8_BAR;
    G8_STAGE(G8_SB(1, 0), cB + kstep, voffB); G8_STAGE_A(G8_SA(1, 0), 0, cA + kstep, false); G8_STAGE(G8_SB(1, 1), cB + hstepB + kstep, voffB);
    G8_WAIT_V(6); G8_BAR;
#pragma unroll 1
    for (;;) {
        const bool has_next = S.next(ui + 1, nxt);
        const char* nA = has_next ? nxt.a : cA; const char* nB = has_next ? nxt.b : cB;
        if constexpr (GATHER) { if (has_next) {
#pragma unroll
            for (int h = 0; h < 2; ++h)
#pragma unroll
                for (int i = 0; i < 2; ++i) gvN[h][i] = (h * 128 + Rr[i] < nxt.nv ? (unsigned)nxt.rows[h * 128 + Rr[i]] : 0u) * (unsigned)ldaB + (unsigned)Cc2[i]; } }
#pragma unroll 1
        for (int t = 0; t < nt; t += 2) {
            const bool last = (t == nt - 2);
            if (last && has_next) S.a_ready(nxt, tid);
            const char* a1 = cA + (size_t)(t + 1) * kstep;
            const char* a2 = last ? nA : cA + (size_t)(t + 2) * kstep; const char* b2 = last ? nB : cB + (size_t)(t + 2) * kstep;
            const char* a3 = a2 + kstep; const char* b3 = b2 + kstep;
            G8_LDB(B0, 0, 0); G8_LDB(B1, 0, 1); G8_SCHED; G8_LDA(At, 0, 0); G8_STAGE_A(G8_SA(1, 1), 1, a1, false);
            G8_WAIT_V(8); G8_WAIT_L(0); G8_BAR; G8_MMA(0, 0, At, B0); G8_MMA(0, 1, At, B1); G8_BAR; G8_SCHED;
            G8_LDA(At, 0, 1); G8_STAGE(G8_SB(0, 0), b2, voffB); G8_STAGE(G8_SB(0, 1), b2 + hstepB, voffB); G8_STAGE_A(G8_SA(0, 0), 0, a2, last);
            G8_WAIT_V(8); G8_WAIT_L(0); G8_BAR; G8_MMA(1, 0, At, B0); G8_MMA(1, 1, At, B1); G8_BAR; G8_SCHED;
            G8_LDB(B0, 1, 0); G8_LDB(B1, 1, 1); G8_SCHED; G8_LDA(At, 1, 0); G8_STAGE_A(G8_SA(0, 1), 1, a2, last);
            G8_WAIT_V(8); G8_WAIT_L(0); G8_BAR; G8_MMA(0, 0, At, B0); G8_MMA(0, 1, At, B1); G8_BAR; G8_SCHED;
            G8_LDA(At, 1, 1); G8_STAGE(G8_SB(1, 0), b3, voffB); G8_STAGE(G8_SB(1, 1), b3 + hstepB, voffB); G8_STAGE_A(G8_SA(1, 0), 0, a3, last);
            G8_WAIT_V(8); G8_WAIT_L(0); G8_BAR; G8_MMA(1, 0, At, B0); G8_MMA(1, 1, At, B1); G8_BAR; G8_SCHED;
        }
        if constexpr (FP8) asm volatile("s_nop 15\n\ts_nop 7" ::: "memory");
        if constexpr (ALIGN_EPI) { if (wr == 0) G8_BAR; }
        E(acc, cur, wr, wc, fr, fq);
        if (!has_next) break;
#pragma unroll
        for (int a = 0; a < 2; ++a)
#pragma unroll
            for (int b = 0; b < 2; ++b)
#pragma unroll
                for (int m = 0; m < 4; ++m)
#pragma unroll
                    for (int n = 0; n < 2; ++n) acc[a][b][m][n] = (f32x4){0.f, 0.f, 0.f, 0.f};
        if constexpr (has_acc_init<Epi>::value) E.acc_init(acc, nxt, wr, wc, fr, fq);
        cur = nxt; cA = nA; cB = nB; ++ui;
        if constexpr (GATHER) {
#pragma unroll
            for (int h = 0; h < 2; ++h)
#pragma unroll
                for (int i = 0; i < 2; ++i) gvC[h][i] = gvN[h][i]; }
        if constexpr (ALIGN_EPI) { if (wr == 1) G8_BAR; }
    }
    G8_WAIT_V(0);
    if constexpr (!ALIGN_EPI) { if (wr == 0) G8_BAR; }
    G8_BAR;
#undef G8_SA
#undef G8_SB
#undef G8_STAGE
#undef G8_STAGE_A
#undef G8_LDA
#undef G8_LDB
#undef G8_MMA
#undef G8_WAIT_V
#undef G8_WAIT_L
#undef G8_BAR
#undef G8_SCHED
}
}
namespace mk {
using namespace g8;
constexpr int NB = 8, NCTX = 256, NLAT = 2048, NTOK = NCTX + NLAT, T = NB * NTOK, D = 1024, L = 4, NE = 32;
constexpr int NWAVES = 8, NTHR = 512;
constexpr float EPS = 1e-6f;
constexpr int NROWT = T / 256;
constexpr int ZBW = 2304, ZB_AU = 0, ZB_AV = 256, ZB_MQ = 512, ZB_CB = 768, ZB_CC = 1024, ZB_CX = 1280, ZB_GQ = 1536, ZB_GK = 1792, ZB_GV = 1920, ZB_MKV = 2048, ZB_KPE = 2176;
constexpr int DIN = 2208;
constexpr int RING_BYTES = 131072, MISC_OFF = 153600, XSCR_OFF = MISC_OFF + 1024, LDS_BYTES = 163840 - 4096;
constexpr size_t MiB = 1u << 20;
constexpr size_t al(size_t x) { return (x + 255) / 256 * 256; }
constexpr size_t WS_CTL = 0, CTL_BYTES = 1 * MiB;
constexpr size_t WS_MOD = WS_CTL + CTL_BYTES, SZ_MOD = al((size_t)L * 9 * 6 * D * 4);
constexpr size_t WS_WIN = WS_MOD + SZ_MOD, SZ_WIN1 = (size_t)ZBW * D * 2;
constexpr size_t WS_WG = WS_WIN + L * SZ_WIN1, SZ_WG1 = (size_t)4096 * D * 2;
constexpr size_t WS_WB = WS_WG + L * SZ_WG1, SZ_WB1 = (size_t)4 * 1024 * 256 * 2;
constexpr size_t WS_WOUT = WS_WB + L * SZ_WB1, SZ_WOUT1 = (size_t)D * D * 2;
constexpr size_t WS_WUQ = WS_WOUT + L * SZ_WOUT1, SZ_WUQ1 = (size_t)512 * 256 * 2;
constexpr size_t WS_WUKV = WS_WUQ + L * SZ_WUQ1, SZ_WUKV1 = (size_t)512 * 256 * 2;
constexpr size_t WS_WSGU = WS_WUKV + L * SZ_WUKV1, SZ_WSGU1 = (size_t)4 * 128 * 128 * 2;
constexpr size_t WS_WGU = WS_WSGU + L * SZ_WSGU1, SZ_WGU1 = (size_t)NE * 512 * D * 2;
constexpr size_t WS_WDN = WS_WGU + L * SZ_WGU1, SZ_WDN1 = (size_t)NE * D * 256 * 2;
constexpr size_t WS_WG8 = WS_WDN + L * SZ_WDN1, SZ_WG81 = (size_t)4096 * D;
constexpr size_t WS_HS = WS_WG8 + L * SZ_WG81, SZ_HS = (size_t)T * D * 2;
constexpr size_t WS_HN = WS_HS + SZ_HS, SZ_HN = (size_t)T * D * 2;
constexpr size_t WS_HN8 = WS_HN + SZ_HN, SZ_HN8 = (size_t)T * D;
constexpr size_t WS_RSS = WS_HN8 + SZ_HN8, SZ_RSS = (size_t)T * 2 * 4 * 4;
constexpr size_t WS_ARENA = WS_RSS + SZ_RSS;

#define GAS __attribute__((address_space(1)))
#define LAS __attribute__((address_space(3)))
typedef unsigned short bf16;
typedef unsigned v4u __attribute__((ext_vector_type(4)));
typedef unsigned v2u __attribute__((ext_vector_type(2)));
#define LDS_WAIT() asm volatile("s_waitcnt lgkmcnt(0)" ::: "memory")
#define VM_WAIT() asm volatile("s_waitcnt vmcnt(0)" ::: "memory")
__device__ __forceinline__ unsigned f2bf(float f) { unsigned u = __builtin_bit_cast(unsigned, f); return (u + 0x7fffu + ((u >> 16) & 1u)) >> 16; }
__device__ __forceinline__ unsigned pk2(float lo, float hi) { return f2bf(lo) | (f2bf(hi) << 16); }
__device__ __forceinline__ float bf2f(unsigned short h) { return __builtin_bit_cast(float, (unsigned)h << 16); }
__device__ __forceinline__ float bflo(unsigned w) { return __builtin_bit_cast(float, w << 16); }
__device__ __forceinline__ float bfhi(unsigned w) { return __builtin_bit_cast(float, w & 0xffff0000u); }
template <int CTRL> __device__ __forceinline__ float dppf(float v) { return __builtin_bit_cast(float, __builtin_amdgcn_update_dpp(0, __builtin_bit_cast(int, v), CTRL, 0xF, 0xF, true)); }
__device__ __forceinline__ unsigned opq(unsigned x) { asm volatile("" : "+v"(x)); return x; }
__device__ __forceinline__ float sum_x16(float v) { const unsigned a = __float_as_uint(v); auto rr = __builtin_amdgcn_permlane16_swap(a, opq(a), false, false); const unsigned r0 = rr[0], r1 = rr[1]; return __uint_as_float(r0) + __uint_as_float(r1); }
__device__ __forceinline__ float sum_x32(float v) { const unsigned a = __float_as_uint(v); auto rr = __builtin_amdgcn_permlane32_swap(a, opq(a), false, false); const unsigned r0 = rr[0], r1 = rr[1]; return __uint_as_float(r0) + __uint_as_float(r1); }
__device__ __forceinline__ float get_x16(float v, int lane) { const unsigned a = __float_as_uint(v); auto rr = __builtin_amdgcn_permlane16_swap(a, opq(a), false, false); const unsigned r0 = rr[0], r1 = rr[1]; return __uint_as_float((lane & 16) ? r0 : r1); }
__device__ __forceinline__ float get_x32(float v, int lane) { const unsigned a = __float_as_uint(v); auto rr = __builtin_amdgcn_permlane32_swap(a, opq(a), false, false); const unsigned r0 = rr[0], r1 = rr[1]; return __uint_as_float((lane & 32) ? r0 : r1); }
__device__ __forceinline__ float wave_sum(float v) {
  v += dppf<0xB1>(v);
  v += dppf<0x4E>(v);
  v += dppf<0x141>(v);
  v += dppf<0x140>(v);
  v = sum_x16(v);
  return sum_x32(v);
}
__device__ __forceinline__ float siluf(float x) { return x / (1.f + __expf(-x)); }
__device__ __forceinline__ float sigmoidf(float x) { return 1.f / (1.f + __expf(-x)); }
__device__ __forceinline__ float gelu_tanh(float x) { const float u = 0.7978845608028654f * (x + 0.044715f * x * x * x); const float e = __expf(2.f * u); return x - x * __builtin_amdgcn_rcpf(e + 1.f); }

#define XB_TMO      128
#define XB_XCNT(j)  (256  + 64 * (j))
#define XB_XSUB(j)  (1280 + 64 * (j))
#define XB_XGEN(j)  (2304 + 64 * (j))
#define XB_TOP      3328
#define XB_TOPGEN   3392
#define XCD_BAR_WORDS 3456
#define XB_SPIN_CAP (1u << 18)
__device__ __forceinline__ unsigned xb_ld(unsigned* p)              { return __hip_atomic_load(p, __ATOMIC_RELAXED, __HIP_MEMORY_SCOPE_AGENT); }
__device__ __forceinline__ unsigned xb_add(unsigned* p, unsigned v) { return __hip_atomic_fetch_add(p, v, __ATOMIC_RELAXED, __HIP_MEMORY_SCOPE_AGENT); }
__device__ __forceinline__ unsigned xb_xcc_id() { return (unsigned)__builtin_amdgcn_s_getreg((3 << 11) | 20) & 0xFu; }
#define XB_SPIN(cond, bar) do { unsigned _sp = 0; while (cond) { __builtin_amdgcn_s_sleep(1); \
    if ((++_sp & 255u) == 0u) { if (xb_ld(&(bar)[XB_TMO])) break; if (_sp > XB_SPIN_CAP) { atomicAdd(&(bar)[XB_TMO], 1u); break; } } } } while (0)
struct XcdBarrier { unsigned* bar; unsigned x; volatile LAS unsigned* st; };
__device__ __forceinline__ XcdBarrier xcd_barrier_post(unsigned* bar, volatile LAS unsigned* st, const bool leader) {
    XcdBarrier b; b.bar = bar; b.x = xb_xcc_id(); b.st = st;
    if (leader) (void)xb_add(&bar[XB_XCNT(b.x)], 1u);
    return b;
}
__device__ __forceinline__ void xcd_barrier_complete(unsigned* bar, unsigned x, unsigned& nloc, unsigned& nx) {
    const unsigned G = gridDim.x * gridDim.y * gridDim.z;
    unsigned sum, cnt, mine, sp = 0u;
    for (;;) {
        sum = 0u; cnt = 0u; mine = 0u;
#pragma unroll
        for (unsigned j = 0; j < 16; ++j) { const unsigned c = xb_ld(&bar[XB_XCNT(j)]); sum += c; cnt += (c > 0u) ? 1u : 0u; mine = (j == x) ? c : mine; }
        if (sum == G) break;
        __builtin_amdgcn_s_sleep(1);
        if ((++sp & 255u) == 0u) { if (xb_ld(&bar[XB_TMO])) break; if (sp > XB_SPIN_CAP) { atomicAdd(&bar[XB_TMO], 1u); break; } }
    }
    nloc = mine > 0u ? mine : 1u; nx = cnt > 0u ? cnt : 1u;
}
__device__ __forceinline__ void xcd_barrier(const XcdBarrier& b, const bool leader) {
    asm volatile("s_waitcnt vmcnt(0)" ::: "memory");
    __syncthreads();
    if (leader) {
        unsigned* bar = b.bar;
        __builtin_amdgcn_s_waitcnt(0);
        unsigned nloc = b.st[0], nx = b.st[1];
        if (nloc == 0u) { xcd_barrier_complete(bar, b.x, nloc, nx); b.st[0] = nloc; b.st[1] = nx; }
        const unsigned old = xb_add(&bar[XB_XSUB(b.x)], 1u);
        const unsigned gen = old / nloc;
        if (old + 1u == (gen + 1u) * nloc) {
            __builtin_amdgcn_fence(__ATOMIC_RELEASE, "agent");
            asm volatile("s_waitcnt vmcnt(0)" ::: "memory");
            const unsigned og = xb_add(&bar[XB_TOP], 1u);
            const unsigned tg = og / nx;
            if (og + 1u == (tg + 1u) * nx) xb_add(&bar[XB_TOPGEN], 1u);
            else XB_SPIN(xb_ld(&bar[XB_TOPGEN]) == tg, bar);
            __builtin_amdgcn_fence(__ATOMIC_ACQUIRE, "agent");
            xb_add(&bar[XB_XGEN(b.x)], 1u);
            asm volatile("s_waitcnt vmcnt(0)" ::: "memory");
        } else {
            XB_SPIN(xb_ld(&bar[XB_XGEN(b.x)]) == gen, bar);
            __builtin_amdgcn_fence(__ATOMIC_ACQUIRE, "agent");
            asm volatile("s_waitcnt vmcnt(0)" ::: "memory");
        }
    }
    __syncthreads();
}

struct Args { const float* in[28]; float* out; unsigned char* ws; int phase, layer, flag, pad; };
struct Ctx {
  LAS unsigned char* lds; unsigned char* ws; int tid, lane, wave, vcu, G;
};

__device__ __forceinline__ void refresh_ctx(Ctx& F, const Args& A) {
  unsigned char* w_ = A.ws; asm volatile("" : "+s"(w_)); F.ws = w_;
  int wv_ = F.wave; asm volatile("" : "+s"(wv_)); F.wave = wv_; unsigned z_ = 0u; asm volatile("" : "+v"(z_)); const int l_ = (int)__builtin_amdgcn_mbcnt_hi(~0u, __builtin_amdgcn_mbcnt_lo(~0u, z_)); F.lane = l_; F.tid = wv_ * 64 + l_;
}
struct TileOrder {
  int nM, nN, nwg, G, c, skip, wgm;
  __device__ void init(int nM_, int nN_, int G_, int c_, int skip_ = 0, int wgm_ = 8) { nM = nM_; nN = nN_; nwg = nM * nN; G = G_; c = c_; skip = skip_; wgm = wgm_; }
  __device__ __forceinline__ bool tile(int i, int& pm, int& pn) const {
    const long Lx = (long)i * G + c; if (Lx >= nwg) return false;
    int wgid = (int)Lx; { const int q = nwg / 8, r = nwg % 8, xcd = wgid % 8, off = wgid / 8; wgid = (xcd < r ? xcd * (q + 1) : r * (q + 1) + (xcd - r) * q) + off; }
    const int WGM = wgm; const int nig = WGM * nN, gid = wgid / nig, fm = gid * WGM, gsz = (nM - fm) < WGM ? (nM - fm) : WGM;
    pm = fm + ((wgid % nig) % gsz); pn = (wgid % nig) / gsz; if (skip) pm += pm / 8 + 1; return true;
  }
};
struct PlainSched {
  TileOrder o; const char* A; const char* B; size_t aTile, bTile;
  __device__ __forceinline__ bool next(int i, Unit& u) const { int pm, pn; if (!o.tile(i, pm, pn)) return false; u.pm = pm; u.pn = pn; u.aux = 0; u.a = A + (size_t)pm * aTile; u.b = B + (size_t)pn * bTile; return true; }
  __device__ __forceinline__ void a_ready(const Unit&, int) const {}
};
constexpr int STG_PITCH = 528;
template <bool SC1> __device__ __forceinline__ void store_tile_rows(const f32x4 (&acc)[2][2][4][2], LAS unsigned char* stg, bf16* O, int obytes, int ldc, int row_base, int col_base, int wr, int wc, int fr, int fq) {
  const int tid = (wr * 4 + wc) * 64 + fq * 16 + fr;
  const __amdgpu_buffer_rsrc_t rs = __builtin_amdgcn_make_buffer_rsrc(O, 0, obytes, 0x00020000);
  LAS unsigned char* wp = stg + (wr * 16 + fr) * STG_PITCH + (wc * 32 + fq * 8) * 2; const LAS unsigned char* rp = stg + (tid >> 5) * STG_PITCH + (tid & 31) * 16;
#pragma unroll
  for (int ai = 0; ai < 2; ++ai)
#pragma unroll
    for (int m = 0; m < 4; ++m) {
#pragma unroll
      for (int bj = 0; bj < 2; ++bj) { const f32x4 v0 = acc[ai][bj][m][0], v1 = acc[ai][bj][m][1];
        v4u w; w.x = cvt_pk_bf16(v0[0], v0[1]); w.y = cvt_pk_bf16(v0[2], v0[3]); w.z = cvt_pk_bf16(v1[0], v1[1]); w.w = cvt_pk_bf16(v1[2], v1[3]);
        *(LAS v4u*)(wp + bj * 256) = w; }
      asm volatile("s_waitcnt lgkmcnt(0)" ::: "memory"); __builtin_amdgcn_s_barrier(); asm volatile("" ::: "memory");
#pragma unroll
      for (int ps = 0; ps < 2; ++ps) { const int rl = ps * 16 + (tid >> 5); const v4u w = *(const LAS v4u*)(rp + ps * 16 * STG_PITCH);
        const int off = ((row_base + ai * 128 + (rl >> 4) * 64 + m * 16 + (rl & 15)) * ldc + col_base + (tid & 31) * 8) * 2;
        __builtin_amdgcn_raw_buffer_store_b128(w, rs, off, 0, SC1 ? 16 : 0); }
      asm volatile("s_waitcnt lgkmcnt(0)" ::: "memory"); __builtin_amdgcn_s_barrier(); asm volatile("" ::: "memory"); }
}
struct EpiStoreBf16 {
  static constexpr bool PERM = true;
  bf16* O; int ldc; int obytes; LAS unsigned char* stg;
  __device__ __forceinline__ void operator()(const f32x4 (&acc)[2][2][4][2], const Unit& u, int wr, int wc, int fr, int fq) const {
    store_tile_rows<false>(acc, stg, O, obytes, ldc, u.pm * 256, u.pn * 256, wr, wc, fr, fq);
  }
};

__device__ __forceinline__ int zmap(int n) {
  if (n < 768) return n;
  if (n < 896) return ZB_MKV + (n - 768);
  if (n < 928) return ZB_KPE + (n - 896);
  if (n < 1184) return ZB_CB + (n - 928);
  if (n < 1440) return ZB_CC + (n - 1184);
  if (n < 1696) return ZB_CX + (n - 1440);
  if (n < 1952) return ZB_GQ + (n - 1696);
  if (n < 2080) return ZB_GK + (n - 1952);
  return ZB_GV + (n - 2080);
}
__device__ __forceinline__ int gmap(int i, int c) { const int jp = c >> 6, cl = c & 63, wc = cl >> 4, h = (cl >> 3) & 1, n = (cl >> 2) & 1, e = cl & 3, bj = i >> 1, fq = 2 * h + (i & 1); return 256 * jp + 128 * bj + 32 * wc + 16 * n + 4 * fq + e; }
__device__ __forceinline__ int uqmap(int n) { const int h = n / 96, dd = n % 96; if (dd < 64) return 64 * h + dd; const int d = dd - 64; return 256 + 32 * h + 8 * ((d >> 2) & 3) + 4 * (d >> 4) + (d & 3); }
__device__ __forceinline__ int gumap(int n) { const int up = n >> 8, j = n & 255; return 256 * (j >> 7) + 128 * up + (j & 127); }

struct PrepItem { const float* W; bf16* dst; const float* kscale; int ldw, N, ldd, k0, n0, mt, mp; };
__device__ __forceinline__ int prep_map(int mt, int mp, int n) { return mt == 0 ? n : mt == 1 ? zmap(n) : mt == 2 ? gmap(mp, n) : mt == 3 ? uqmap(n) : gumap(n); }
__device__ __forceinline__ PrepItem prep_decode(const Args& A, unsigned char* ws, int it) {
  constexpr int I_IN = 16 * 9, I_G = 4 * 16 * 4, I_B = 4 * 4 * 4, I_O = 16 * 4, I_UQ = 4 * 2, I_UKV = 2 * 2, I_GU = NE * 16 * 2, I_DN = NE * 4 * 4;
  constexpr int I_L = I_IN + I_G + I_B + I_O + I_UQ + I_UKV + I_GU + I_DN;
  PrepItem p; const int l = it / I_L; int r = it % I_L; p.kscale = nullptr; p.mt = 0; p.mp = 0;
  if (r < I_IN) { const int kb = r / 9, nb = r % 9; p.W = A.in[6] + (size_t)l * D * DIN; p.ldw = DIN; p.N = DIN; p.dst = (bf16*)(ws + WS_WIN + l * SZ_WIN1); p.ldd = D; p.k0 = kb * 64; p.n0 = nb * 256; p.mt = 1; return p; } r -= I_IN;
  if (r < I_G) { const int i = r / 64, rr = r % 64, kb = rr / 4, nb = rr % 4; p.W = A.in[17] + ((size_t)l * 4 + i) * D * D; p.ldw = D; p.N = D; p.dst = (bf16*)(ws + WS_WG8 + l * SZ_WG81); p.ldd = D; p.k0 = kb * 64; p.n0 = nb * 256; p.mt = 2; p.mp = i; return p; } r -= I_G;
  if (r < I_B) { const int i = r / 16, rr = r % 16, kb = rr / 4, nb = rr % 4; p.W = A.in[19] + ((size_t)l * 4 + i) * 256 * D; p.ldw = D; p.N = D; p.dst = (bf16*)(ws + WS_WB + l * SZ_WB1) + (size_t)i * 1024 * 256; p.ldd = 256; p.k0 = kb * 64; p.n0 = nb * 256; return p; } r -= I_B;
  if (r < I_O) { const int kb = r / 4, nb = r % 4; p.W = A.in[20] + (size_t)l * D * D; p.ldw = D; p.N = D; p.dst = (bf16*)(ws + WS_WOUT + l * SZ_WOUT1); p.ldd = D; p.k0 = kb * 64; p.n0 = nb * 256; return p; } r -= I_O;
  if (r < I_UQ) { const int kb = r / 2, nb = r % 2; p.W = A.in[11] + (size_t)l * 256 * 384; p.ldw = 384; p.N = 384; p.dst = (bf16*)(ws + WS_WUQ + l * SZ_WUQ1); p.ldd = 256; p.kscale = A.in[10] + l * 256; p.k0 = kb * 64; p.n0 = nb * 256; p.mt = 3; return p; } r -= I_UQ;
  if (r < I_UKV) { const int kb = r / 2, nb = r % 2; p.W = A.in[13] + (size_t)l * 128 * 512; p.ldw = 512; p.N = 512; p.dst = (bf16*)(ws + WS_WUKV + l * SZ_WUKV1); p.ldd = 256; p.kscale = A.in[12] + l * 128; p.k0 = kb * 64; p.n0 = nb * 256; return p; } r -= I_UKV;
  if (r < I_GU) { const int e = r / 32, rr = r % 32, kb = rr / 2, nb = rr % 2; p.W = A.in[25] + ((size_t)l * NE + e) * D * 512; p.ldw = 512; p.N = 512; p.dst = (bf16*)(ws + WS_WGU + l * SZ_WGU1) + (size_t)e * 512 * D; p.ldd = D; p.k0 = kb * 64; p.n0 = nb * 256; p.mt = 4; return p; } r -= I_GU;
  { const int e = r / 16, rr = r % 16, kb = rr / 4, nb = rr % 4; p.W = A.in[26] + ((size_t)l * NE + e) * 256 * D; p.ldw = D; p.N = D; p.dst = (bf16*)(ws + WS_WDN + l * SZ_WDN1) + (size_t)e * D * 256; p.ldd = 256; p.k0 = kb * 64; p.n0 = nb * 256; return p; }
}
__device__ __forceinline__ void prep_load(const PrepItem& p, int tid, float4 (&v)[8]) {
#pragma unroll
  for (int i = 0; i < 8; ++i) { const int idx = tid + i * NTHR, kk = idx >> 6, c4 = (idx & 63) * 4; v[i] = make_float4(0.f, 0.f, 0.f, 0.f);
    if (p.n0 + c4 < p.N) v[i] = *(const float4*)(p.W + (size_t)(p.k0 + kk) * p.ldw + p.n0 + c4); }
}
__device__ __forceinline__ void phase_prep(Ctx& F, const Args& A) {
  const int lane = F.lane;
  const float* w_sgu = A.in[8];
  { const float* c = A.in[1]; const float* c_ctx = A.in[3]; const float* w_ada = A.in[4]; const float* b_ada = A.in[5]; float* mod = (float*)(F.ws + WS_MOD);
    LAS float* sil = (LAS float*)F.lds; LAS float* red = sil + 9 * D;
    if (F.vcu < L * 96) {
      for (int i = F.tid; i < 9 * D; i += NTHR) { const int r = i / D, k = i % D; sil[i] = siluf(r < 8 ? c[r * D + k] : c_ctx[k]); }
      __syncthreads();
      for (int it = F.vcu; it < L * 96; it += F.G) { const int l = it / 96, n = (it % 96) * 64 + lane; float acc[9];
#pragma unroll
        for (int r = 0; r < 9; ++r) acc[r] = 0.f;
        const float* w = w_ada + (size_t)l * D * 6 * D + n;
#pragma unroll 8
        for (int kk = 0; kk < 128; ++kk) { const int k = F.wave * 128 + kk; const float wv = w[(size_t)k * 6 * D];
#pragma unroll
          for (int r = 0; r < 9; ++r) acc[r] += sil[r * D + k] * wv; }
        __syncthreads();
#pragma unroll
        for (int r = 0; r < 9; ++r) red[(F.wave * 9 + r) * 64 + lane] = acc[r];
        __syncthreads();
        if (F.wave == 0) { const float bv = b_ada[l * 6 * D + n];
#pragma unroll
          for (int r = 0; r < 9; ++r) { float s = 0.f;
#pragma unroll
            for (int w8 = 0; w8 < 8; ++w8) s += red[(w8 * 9 + r) * 64 + lane];
            mod[((size_t)l * 9 + r) * 6 * D + n] = s + bv; } }
      }
      __syncthreads(); } }
  constexpr int I_LT = 16 * 9 + 4 * 16 * 4 + 4 * 4 * 4 + 16 * 4 + 4 * 2 + 2 * 2 + NE * 16 * 2 + NE * 4 * 4;
  { LAS float* scr = (LAS float*)F.lds; const int tid = F.tid;
    int it = F.vcu; float4 v[8]; PrepItem cur;
    if (it < L * I_LT) { cur = prep_decode(A, F.ws, it); prep_load(cur, tid, v); }
    while (it < L * I_LT) {
#pragma unroll
      for (int i = 0; i < 8; ++i) { const int idx = tid + i * NTHR, kk = idx >> 6, c4 = (idx & 63) * 4; float4 x = v[i];
        if (cur.kscale) { const float s = cur.kscale[cur.k0 + kk]; x.x *= s; x.y *= s; x.z *= s; x.w *= s; }
        *(LAS f32x4*)(scr + kk * 260 + c4) = (f32x4){x.x, x.y, x.z, x.w}; }
      const int nit = it + F.G; PrepItem nxt = cur;
      if (nit < L * I_LT) { nxt = prep_decode(A, F.ws, nit); prep_load(nxt, tid, v); }
      __syncthreads();
#pragma unroll
      for (int i = 0; i < 4; ++i) { const int idx = tid + i * NTHR, n = idx & 255, c = idx >> 8; const LAS float* s = scr + (8 * c) * 260 + n;
        if (cur.n0 + n < cur.N) {
          if (cur.mt == 2) { int w0 = 0, w1 = 0;
            w0 = __builtin_amdgcn_cvt_pk_fp8_f32(32.f * s[0 * 260], 32.f * s[1 * 260], w0, false); w0 = __builtin_amdgcn_cvt_pk_fp8_f32(32.f * s[2 * 260], 32.f * s[3 * 260], w0, true);
            w1 = __builtin_amdgcn_cvt_pk_fp8_f32(32.f * s[4 * 260], 32.f * s[5 * 260], w1, false); w1 = __builtin_amdgcn_cvt_pk_fp8_f32(32.f * s[6 * 260], 32.f * s[7 * 260], w1, true);
            v2u o; o.x = (unsigned)w0; o.y = (unsigned)w1; *(v2u*)((unsigned char*)cur.dst + (size_t)prep_map(cur.mt, cur.mp, cur.n0 + n) * cur.ldd + cur.k0 + 8 * c) = o; }
          else { v4u o; o.x = pk2(s[0 * 260], s[1 * 260]); o.y = pk2(s[2 * 260], s[3 * 260]); o.z = pk2(s[4 * 260], s[5 * 260]); o.w = pk2(s[6 * 260], s[7 * 260]);
            *(v4u*)(cur.dst + (size_t)prep_map(cur.mt, cur.mp, cur.n0 + n) * cur.ldd + cur.k0 + 8 * c) = o; } } }
      __syncthreads();
      cur = nxt; it = nit;
    }
  }
  const size_t gt = (size_t)F.vcu * NTHR + F.tid, NGT = (size_t)F.G * NTHR;
  for (int l = 0; l < L; ++l) {
    v4u z4 = {0u, 0u, 0u, 0u};
    { v4u* p = (v4u*)(F.ws + WS_WIN + l * SZ_WIN1 + (size_t)DIN * D * 2); for (size_t i = gt; i < (size_t)(ZBW - DIN) * D * 2 / 16; i += NGT) p[i] = z4; }
    { v4u* p = (v4u*)(F.ws + WS_WUQ + l * SZ_WUQ1 + (size_t)384 * 256 * 2); for (size_t i = gt; i < (size_t)128 * 256 * 2 / 16; i += NGT) p[i] = z4; }
    { for (size_t i = gt; i < (size_t)512 * 16; i += NGT) { const size_t row = i / 16, c = i % 16; *(v4u*)(F.ws + WS_WUKV + l * SZ_WUKV1 + row * 512 + 256 + c * 16) = z4; } }
    { const float* s = w_sgu + (size_t)l * 4 * 128 * 128; bf16* d = (bf16*)(F.ws + WS_WSGU + l * SZ_WSGU1); for (size_t i = gt; i < (size_t)4 * 128 * 128 / 2; i += NGT) ((unsigned*)d)[i] = pk2(s[2 * i], s[2 * i + 1]); }
  }
}
}
namespace mk {
constexpr int CW_CNT = 8192, CW_PANEL = 32768, CW_TILE = 65536, CW_BAR_TMO = 16384 + 128;
constexpr size_t SZ_ZB_BYTES = (size_t)T * ZBW * 2;
struct EpiZ {
  static constexpr bool PERM = true;
  bf16* O; float* rss; int mode; LAS unsigned char* stg;
  __device__ __forceinline__ void operator()(const f32x4 (&acc)[2][2][4][2], const Unit& u, int wr, int wc, int fr, int fq) const {
    if (mode) return;
    const int row0 = u.pm * 256 + wr * 64 + fr;
    store_tile_rows<false>(acc, stg, O, (int)SZ_ZB_BYTES, ZBW, u.pm * 256, u.pn * 256, wr, wc, fr, fq);
    if (u.pn == 2 || u.pn == 8) { const int which = u.pn == 2 ? 0 : 1;
#pragma unroll
      for (int ai = 0; ai < 2; ++ai)
#pragma unroll
        for (int m = 0; m < 4; ++m) { float s = 0.f;
#pragma unroll
          for (int n = 0; n < 2; ++n) { const f32x4 a0 = acc[ai][0][m][n]; s += a0[0] * a0[0] + a0[1] * a0[1] + a0[2] * a0[2] + a0[3] * a0[3];
            if (which == 0) { const f32x4 a1 = acc[ai][1][m][n]; s += a1[0] * a1[0] + a1[1] * a1[1] + a1[2] * a1[2] + a1[3] * a1[3]; } }
          s = sum_x16(s); s = sum_x32(s);
          if (fq == 0) rss[((size_t)(row0 + ai * 128 + m * 16) * 2 + which) * 4 + wc] = s; } }
  }
};
__device__ __forceinline__ void phase_zgemm(Ctx& F, const Args& A, int l, int mode = 0) {
  PlainSched S; S.o.init(NROWT, ZBW / 256, F.G, (int)blockIdx.x, 0, 9); S.A = (const char*)(F.ws + WS_HN); S.B = (const char*)(F.ws + WS_WIN + l * SZ_WIN1); S.aTile = (size_t)256 * D * 2; S.bTile = (size_t)256 * D * 2;
  EpiZ E{(bf16*)(F.ws + WS_ARENA), (float*)(F.ws + WS_RSS), mode, F.lds + RING_BYTES};
  gemm_phase<EpiZ, PlainSched, true>(F.lds, F.tid, D * 2, D * 2, D, S, E);
}
constexpr size_t WS_ZB = WS_ARENA, SZ_ZB = (size_t)T * ZBW * 2;
constexpr size_t WS_Y = WS_ZB + SZ_ZB, SZ_Y = (size_t)T * D * 2;
constexpr size_t WS_Z4 = WS_Y + SZ_Y, SZ_Z4 = (size_t)T * 4096 * 2;
constexpr size_t WS_MG = WS_Z4 + SZ_Z4, SZ_MG = (size_t)T * D * 2;
constexpr size_t WS_END1 = WS_MG + SZ_MG;
struct BranchSched {
  TileOrder o; const char* Y; const char* WB;
  __device__ __forceinline__ bool next(int i, Unit& u) const { int pm, pn; if (!o.tile(i, pm, pn)) return false; u.pm = pm; u.pn = pn; u.aux = 0; const int br = pn >> 2;
    u.a = Y + (size_t)pm * 256 * D * 2 + br * 512; u.b = WB + (size_t)br * 1024 * 512 + (size_t)(pn & 3) * 256 * 512; return true; }
  __device__ __forceinline__ void a_ready(const Unit&, int) const {}
};
constexpr int CW_BRC = 98304;
__device__ __forceinline__ bool wait_counter(const unsigned* cnt, unsigned need, unsigned* tmo, int tid) {
  if (tid < 64) { unsigned sp = 0;
    while ((unsigned)__builtin_amdgcn_readfirstlane((int)__hip_atomic_load(cnt, __ATOMIC_RELAXED, __HIP_MEMORY_SCOPE_AGENT)) < need) { __builtin_amdgcn_s_sleep(2);
      if ((++sp & 255u) == 0u) { if (__hip_atomic_load(tmo, __ATOMIC_RELAXED, __HIP_MEMORY_SCOPE_AGENT)) break; if (sp > (1u << 18)) { atomicAdd(tmo, 1u); break; } } }
    __builtin_amdgcn_fence(__ATOMIC_ACQUIRE, "agent");
    asm volatile("s_waitcnt vmcnt(0)" ::: "memory"); }
  asm volatile("" ::: "memory"); __builtin_amdgcn_s_barrier(); asm volatile("" ::: "memory"); return true;
}
struct BranchSched2 {
  int x, j; bool skip; const char* Y; const char* WB;
  __device__ __forceinline__ bool next(int i, Unit& u) const { int w;
    if (i < 4) w = 32 * i + j;
    else if (skip || j < 20) return false;
    else if (i == 4) w = j >= 28 ? 136 + 2 * (j - 28) : j >= 24 ? 128 + (j - 24) : 132 + (j - 20);
    else if (i == 5 && j >= 28) w = 137 + 2 * (j - 28); else return false;
    u.pn = w & 15; u.pm = 9 * x + (skip ? 1 : 0) + (w >> 4); u.aux = 0; u.rows = nullptr; const int br = u.pn >> 2;
    u.a = Y + (size_t)u.pm * 256 * D * 2 + br * 512; u.b = WB + (size_t)br * 1024 * 512 + (size_t)(u.pn & 3) * 256 * 512; return true; }
  __device__ __forceinline__ void a_ready(const Unit&, int) const {}
};
struct EpiZ4 {
  static constexpr bool PERM = true;
  bf16* O; unsigned* cnt; LAS unsigned char* stg;
  __device__ __forceinline__ void operator()(const f32x4 (&acc)[2][2][4][2], const Unit& u, int wr, int wc, int fr, int fq) const {
    store_tile_rows<true>(acc, stg, O, (int)SZ_Z4, 4096, u.pm * 256, u.pn * 256, wr, wc, fr, fq);
    if (cnt) { asm volatile("s_waitcnt vmcnt(0)" ::: "memory"); if (fr == 0 && fq == 0) __hip_atomic_fetch_add(cnt + (u.pm * 4 + (u.pn & 3)) * 64, 1u, __ATOMIC_RELAXED, __HIP_MEMORY_SCOPE_AGENT); }
  }
};
__device__ __forceinline__ void phase_branch(Ctx& F, const Args& A, int l, bool skipctx = false) {
  if (F.G == 256) { BranchSched2 S; S.x = (int)blockIdx.x & 7; S.j = (int)blockIdx.x >> 3; S.skip = skipctx; S.Y = (const char*)(F.ws + WS_Y); S.WB = (const char*)(F.ws + WS_WB + l * SZ_WB1);
    EpiZ4 E{(bf16*)(F.ws + WS_Z4), (unsigned*)(F.ws + WS_CTL) + CW_BRC + l * (72 * 4 * 64), F.lds + RING_BYTES};
    gemm_phase<EpiZ4, BranchSched2, true>(F.lds, F.tid, D * 2, 512, 256, S, E); return; }
  BranchSched S; S.o.init(skipctx ? NB * 8 : NROWT, 16, F.G, (int)blockIdx.x, skipctx ? 1 : 0, skipctx ? 8 : 9); S.Y = (const char*)(F.ws + WS_Y); S.WB = (const char*)(F.ws + WS_WB + l * SZ_WB1);
  EpiStoreBf16 E{(bf16*)(F.ws + WS_Z4), 4096, (int)SZ_Z4, F.lds + RING_BYTES};
  gemm_phase<EpiStoreBf16, BranchSched, true>(F.lds, F.tid, D * 2, 512, 256, S, E);
}
template <int MODE> struct EpiMergeT {
  static constexpr bool PERM = false;
  const bf16* Z4; const float* bg; bf16* M; unsigned* panel; LAS unsigned char* stg;
  static constexpr float L2E = 1.4426950408889634f;
  __device__ __forceinline__ void acc_init(f32x4 (&acc)[2][2][4][2], const Unit& u, int wr, int wc, int fr, int fq) const {
    const int pq = fq & 1, c0 = u.pn * 64 + wc * 16 + (fq >> 1) * 8;
#pragma unroll
    for (int bj = 0; bj < 2; ++bj)
#pragma unroll
      for (int n = 0; n < 2; ++n) { const f32x4 b32 = *(const f32x4*)(bg + (2 * bj + pq) * D + c0 + 4 * n) * 32.f;
#pragma unroll
        for (int ai = 0; ai < 2; ++ai)
#pragma unroll
          for (int m = 0; m < 4; ++m) acc[ai][bj][m][n] = b32; }
  }
  __device__ __forceinline__ void operator()(const f32x4 (&acc)[2][2][4][2], const Unit& u, int wr, int wc, int fr, int fq) const {
    const int pq = fq & 1, c0 = u.pn * 64 + wc * 16 + (fq >> 1) * 8;
    const GAS bf16* Zg = (const GAS bf16*)Z4 + pq * D + c0;
    const __amdgpu_buffer_rsrc_t rs = __builtin_amdgcn_make_buffer_rsrc(M, 0, (int)SZ_MG, 0x00020000);
    const int tid = (wr * 4 + wc) * 64 + fq * 16 + fr;
    v4u zz[2][4][2];
#pragma unroll
    for (int ai = 0; ai < 2; ++ai)
#pragma unroll
      for (int m = 0; m < 4; ++m) { const size_t r = (size_t)u.pm * 256 + ai * 128 + wr * 64 + m * 16 + fr;
#pragma unroll
        for (int bj = 0; bj < 2; ++bj) { if (MODE == 1) zz[ai][m][bj] = (v4u){0x3f803f80u + (unsigned)fr, 0x3f803f80u, 0x3f803f80u, 0x3f803f80u}; else zz[ai][m][bj] = *(const GAS v4u*)(Zg + r * 4096 + 2 * bj * D); } }
#pragma unroll
    for (int ai = 0; ai < 2; ++ai) {
#pragma unroll
      for (int m = 0; m < 4; ++m) { f32x2 sa = {0.f, 0.f}, sb = sa, sc = sa, sd = sa;
#pragma unroll
        for (int bj = 0; bj < 2; ++bj) { const v4u z2 = zz[ai][m][bj]; const f32x4 t0 = acc[ai][bj][m][0] * (L2E / 32.f), t1 = acc[ai][bj][m][1] * (L2E / 32.f);
#define SIG2(S, TA, TB, ZW) do { const f32x2 d_ = (f32x2){__builtin_amdgcn_exp2f(-(TA)), __builtin_amdgcn_exp2f(-(TB))} + 1.f; const f32x2 r_ = {__builtin_amdgcn_rcpf(d_[0]), __builtin_amdgcn_rcpf(d_[1])}; \
            S += (f32x2){bflo(ZW), bfhi(ZW)} * r_; } while (0)
          SIG2(sa, t0[0], t0[1], z2.x); SIG2(sb, t0[2], t0[3], z2.y); SIG2(sc, t1[0], t1[1], z2.z); SIG2(sd, t1[2], t1[3], z2.w);
#undef SIG2
        }
        const f32x4 s0 = {sa[0], sa[1], sb[0], sb[1]}, s1 = {sc[0], sc[1], sd[0], sd[1]};
        float t[4];
#pragma unroll
        for (int e = 0; e < 4; ++e) { const float lo = s0[e], hi = s1[e]; auto rr = __builtin_amdgcn_permlane16_swap(__float_as_uint(lo), __float_as_uint(hi), false, false); const unsigned r0 = rr[0], r1 = rr[1]; t[e] = __uint_as_float(r0) + __uint_as_float(r1); }
        v2u o2; o2.x = cvt_pk_bf16(t[0], t[1]); o2.y = cvt_pk_bf16(t[2], t[3]);
        *(LAS v2u*)(stg + (wr * 64 + m * 16 + fr) * 144 + (wc * 16 + (fq >> 1) * 8 + 4 * pq) * 2) = o2; }
      asm volatile("s_waitcnt lgkmcnt(0)" ::: "memory"); __builtin_amdgcn_s_barrier(); asm volatile("" ::: "memory");
#pragma unroll
      for (int ps = 0; ps < 2; ++ps) { const int row = ps * 64 + (tid >> 3), ch = tid & 7; const v4u w = *(const LAS v4u*)(stg + row * 144 + ch * 16);
        if (MODE != 2 || w.x == 0x12345678u) __builtin_amdgcn_raw_buffer_store_b128(w, rs, (int)(((size_t)u.pm * 256 + ai * 128 + row) * D + u.pn * 64) * 2 + ch * 16, 0, 16); }
      asm volatile("s_waitcnt lgkmcnt(0)" ::: "memory"); __builtin_amdgcn_s_barrier(); asm volatile("" ::: "memory"); }
    if (panel) { asm volatile("s_waitcnt vmcnt(0)" ::: "memory"); if (fr == 0 && fq == 0) __hip_atomic_fetch_add(panel + 64 * u.pm, 1u, __ATOMIC_RELAXED, __HIP_MEMORY_SCOPE_AGENT); }
  }
};
using EpiMerge = EpiMergeT<0>;
struct GateSched {
  int x, j; bool skip; const char* A; const char* B; const unsigned* brc; unsigned* tmo;
  __device__ __forceinline__ bool next(int i, Unit& u) const { int w;
    if (skip) { if (i >= 4) return false; w = 32 * i + j; }
    else if (j < 20) { if (i >= 5) return false; w = (i == 4 ? 124 : 32 * i) + j; }
    else if (j < 28) { const int k = j - 20; if (i < 3) w = 20 + 32 * i + k; else if (i == 3 && k < 4) w = 116 + k; else return false; }
    else { const int k = j - 28; if (i < 3) w = 28 + 32 * i + k; else if (i == 3) w = 120 + k; else return false; }
    u.pn = w & 15; u.pm = 9 * x + (skip ? 1 : 0) + (w >> 4); u.aux = 0; u.rows = nullptr; u.a = A + (size_t)u.pm * 256 * D; u.b = B + (size_t)u.pn * 256 * D; return true; }
  __device__ __forceinline__ void a_ready(const Unit& u, int tid) const { if (brc) wait_counter(brc + (u.pm * 4 + (u.pn >> 2)) * 64, 32u, tmo, tid); }
};
template <int MODE = 0> __device__ __forceinline__ void phase_gate(Ctx& F, const Args& A, int l, bool skipctx = false, int cbase = CW_PANEL) {
  if (F.G == 256) { GateSched S; S.x = (int)blockIdx.x & 7; S.j = (int)blockIdx.x >> 3; S.skip = skipctx; S.A = (const char*)(F.ws + WS_HN8); S.B = (const char*)(F.ws + WS_WG8 + l * SZ_WG81); S.brc = cbase == CW_PANEL ? (const unsigned*)(F.ws + WS_CTL) + CW_BRC + l * (72 * 4 * 64) : nullptr; S.tmo = (unsigned*)(F.ws + WS_CTL) + CW_BAR_TMO;
    EpiMergeT<MODE> E{(const bf16*)(F.ws + WS_Z4), A.in[18] + (size_t)l * 4 * D, (bf16*)(F.ws + WS_MG), (unsigned*)(F.ws + WS_CTL) + cbase + l * (72 * 64), F.lds + RING_BYTES};
    gemm_phase<EpiMergeT<MODE>, GateSched, true, false, true>(F.lds, F.tid, D, D, D / 2, S, E); return; }
  PlainSched S; S.o.init(skipctx ? NB * 8 : NROWT, 16, F.G, (int)blockIdx.x, skipctx ? 1 : 0, skipctx ? 8 : 9); S.A = (const char*)(F.ws + WS_HN8); S.B = (const char*)(F.ws + WS_WG8 + l * SZ_WG81); S.aTile = (size_t)256 * D; S.bTile = (size_t)256 * D;
  EpiMergeT<MODE> E{(const bf16*)(F.ws + WS_Z4), A.in[18] + (size_t)l * 4 * D, (bf16*)(F.ws + WS_MG), F.G == 256 ? (unsigned*)(F.ws + WS_CTL) + CW_PANEL + l * (72 * 64) : nullptr};
  gemm_phase<EpiMergeT<MODE>, PlainSched, true, false, true>(F.lds, F.tid, D, D, D / 2, S, E);
}
struct EpiResid {
  static constexpr bool PERM = true;
  bf16* hs; const float* mod; float gs;
  __device__ __forceinline__ void operator()(const f32x4 (&acc)[2][2][4][2], const Unit& u, int wr, int wc, int fr, int fq) const {
    const int b = u.pm / 9, rm = (u.pm % 9 == 0) ? 8 : b; const float* gv = mod + (size_t)rm * 6 * D + 2 * D;
    const int col0 = u.pn * 256 + wc * 32 + fq * 8;
    GAS bf16* hg = (GAS bf16*)hs;
#pragma unroll
    for (int bj = 0; bj < 2; ++bj) { v4u w[2][4]; const int c = col0 + bj * 128;
      const f32x4 g0 = *(const f32x4*)(gv + c) * gs, g1 = *(const f32x4*)(gv + c + 4) * gs;
#pragma unroll
      for (int ai = 0; ai < 2; ++ai)
#pragma unroll
        for (int m = 0; m < 4; ++m) w[ai][m] = *(const GAS v4u*)(hg + ((size_t)u.pm * 256 + ai * 128 + wr * 64 + m * 16 + fr) * D + c);
#pragma unroll
      for (int ai = 0; ai < 2; ++ai)
#pragma unroll
        for (int m = 0; m < 4; ++m) { const v4u ww = w[ai][m]; const f32x4 h0 = {bflo(ww.x), bfhi(ww.x), bflo(ww.y), bfhi(ww.y)}, h1 = {bflo(ww.z), bfhi(ww.z), bflo(ww.w), bfhi(ww.w)};
          const f32x4 o0 = h0 + g0 * acc[ai][bj][m][0], o1 = h1 + g1 * acc[ai][bj][m][1];
          v4u ow; ow.x = cvt_pk_bf16(o0[0], o0[1]); ow.y = cvt_pk_bf16(o0[2], o0[3]); ow.z = cvt_pk_bf16(o1[0], o1[1]); ow.w = cvt_pk_bf16(o1[2], o1[3]);
          *(GAS v4u*)(hg + ((size_t)u.pm * 256 + ai * 128 + wr * 64 + m * 16 + fr) * D + c) = ow; } }
  }
};
struct OutSched {
  int c; const char* A; const char* B; unsigned* panel; unsigned* tmo; bool counted; bool skip;
  __device__ __forceinline__ bool next(int i, Unit& u) const { const int x = c & 7, j = c >> 3; int o;
    if (skip) { if (i > 0) return false; o = j; }
    else if (j >= 24 && j < 28) { if (i > 1) return false; o = 2 * (j - 24) + i; }
    else if (i > 0) return false; else if (j >= 28) o = 12 + (j - 28); else if (j >= 20) o = 8 + (j - 20); else o = 16 + j;
    u.pm = 9 * x + (skip ? 1 : 0) + (o >> 2); u.pn = o & 3;
    u.aux = 0; u.rows = nullptr; u.a = A + (size_t)u.pm * 256 * D * 2; u.b = B + (size_t)u.pn * 256 * D * 2; return true; }
  __device__ __forceinline__ void a_ready(const Unit& u, int tid) const {
    if (!counted) return;
    if (tid < 64) { unsigned sp = 0;
      while ((unsigned)__builtin_amdgcn_readfirstlane((int)__hip_atomic_load(panel + 64 * u.pm, __ATOMIC_RELAXED, __HIP_MEMORY_SCOPE_AGENT)) < 128u) { __builtin_amdgcn_s_sleep(2);
        if ((++sp & 255u) == 0u) { if (__hip_atomic_load(tmo, __ATOMIC_RELAXED, __HIP_MEMORY_SCOPE_AGENT)) break; if (sp > (1u << 18)) { atomicAdd(tmo, 1u); break; } } }
      __builtin_amdgcn_fence(__ATOMIC_ACQUIRE, "agent");
      asm volatile("s_waitcnt vmcnt(0)" ::: "memory"); }
    asm volatile("" ::: "memory"); __builtin_amdgcn_s_barrier(); asm volatile("" ::: "memory");
  }
};
__device__ __forceinline__ void phase_out(Ctx& F, const Args& A, int l, float gs = 1.f, bool counted = false, bool skipctx = false, int cbase = CW_PANEL) {
  EpiResid E{(bf16*)(F.ws + WS_HS), (const float*)(F.ws + WS_MOD) + (size_t)l * 9 * 6 * D, gs};
  if (F.G == 256) { OutSched S; S.c = (int)blockIdx.x; S.A = (const char*)(F.ws + WS_MG); S.B = (const char*)(F.ws + WS_WOUT + l * SZ_WOUT1); S.panel = (unsigned*)(F.ws + WS_CTL) + cbase + l * (72 * 64); S.tmo = (unsigned*)(F.ws + WS_CTL) + CW_BAR_TMO; S.counted = counted; S.skip = skipctx;
    gemm_phase<EpiResid, OutSched, true>(F.lds, F.tid, D * 2, D * 2, D, S, E); }
  else { PlainSched S; S.o.init(skipctx ? NB * 8 : NROWT, 4, F.G, (int)blockIdx.x, skipctx ? 1 : 0); S.A = (const char*)(F.ws + WS_MG); S.B = (const char*)(F.ws + WS_WOUT + l * SZ_WOUT1); S.aTile = (size_t)256 * D * 2; S.bTile = (size_t)256 * D * 2;
    gemm_phase<EpiResid, PlainSched, true>(F.lds, F.tid, D * 2, D * 2, D, S, E); }
}
constexpr int CAP2 = 2 * T + NE * 256, NT_MOE = CAP2 / 256;
constexpr size_t WS_XG = WS_ARENA, SZ_XG = (size_t)CAP2 * D * 2;
constexpr size_t WS_HE = WS_XG + SZ_XG, SZ_HE = (size_t)CAP2 * 256 * 2;
constexpr size_t WS_FS = WS_HE + SZ_HE, SZ_FS = (size_t)CAP2 * D * 2;
static_assert(WS_FS + SZ_FS <= WS_END1, "moe arena fits in the mixer arena");
constexpr size_t WS_TOKE = WS_END1, WS_TOKW = WS_TOKE + (size_t)2 * T * 4, WS_TOKR = WS_TOKW + (size_t)2 * T * 4, WS_TOKS = WS_TOKR + (size_t)2 * T * 4, WS_END2 = WS_TOKS + (size_t)2 * T * 4;
constexpr size_t WS_SLOT = WS_END2;
constexpr size_t WS_CJ = WS_SLOT + (size_t)CAP2 * 4;
constexpr size_t WS_SLSP = WS_CJ + 8192;
constexpr size_t WS_END2B = WS_SLSP + (size_t)NE * T * 4;
__device__ __forceinline__ void phase_norm_router(Ctx& F, const Args& A, int l, bool skip_ctx, bool dry = false) {
  const int gw = F.vcu * NWAVES + F.wave, NGW = F.G * NWAVES, lane = F.lane;
  const bf16* hs = (const bf16*)(F.ws + WS_HS); bf16* hn = (bf16*)(F.ws + WS_HN); const float* mod = (const float*)(F.ws + WS_MOD) + (size_t)l * 9 * 6 * D;
  const float* wgr = A.in[21] + (size_t)l * D * 4; const float* bgr = A.in[22] + l * 4; const float* wer = A.in[23] + (size_t)l * D * 32; const float* ber = A.in[24] + l * 32;
  int* tok_e = (int*)(F.ws + WS_TOKE); float* tok_w = (float*)(F.ws + WS_TOKW); int* tok_r = (int*)(F.ws + WS_TOKR);
  unsigned* counts = (unsigned*)(F.ws + WS_CTL) + CW_CNT + l * 64;
  if (dry) { tok_e = (int*)A.out; tok_w = A.out + (1 << 20); tok_r = (int*)A.out + (2 << 20); counts += 32; }
  constexpr int WPB = 2064;
  LAS unsigned char* Wh = F.lds; LAS unsigned char* Wl = F.lds + 36 * WPB; const float* cj = (const float*)(F.ws + WS_CJ) + l * (9 * 36); LAS unsigned* lcnt = (LAS unsigned*)(F.lds + 72 * WPB); LAS unsigned* lbase = lcnt + 32; LAS unsigned* rowctr = lbase + 32;
  __syncthreads();
  { float4 w[18];
#pragma unroll
    for (int it = 0; it < 16; ++it) w[it] = ((const float4*)wer)[F.tid + NTHR * it];
#pragma unroll
    for (int it = 0; it < 2; ++it) w[16 + it] = ((const float4*)wgr)[F.tid + NTHR * it];
#define WSPLIT(J, K, V) do { const float v_ = (V); const unsigned h_ = f2bf(v_); const unsigned l_ = f2bf(v_ - __uint_as_float(h_ << 16)); *(LAS unsigned short*)(Wh + (J) * WPB + (K) * 2) = (unsigned short)h_; *(LAS unsigned short*)(Wl + (J) * WPB + (K) * 2) = (unsigned short)l_; } while (0)
#pragma unroll
    for (int it = 0; it < 16; ++it) { const int i4 = F.tid + NTHR * it, k = i4 >> 3, j = 4 + 4 * (i4 & 7); WSPLIT(j, k, w[it].x); WSPLIT(j + 1, k, w[it].y); WSPLIT(j + 2, k, w[it].z); WSPLIT(j + 3, k, w[it].w); }
#pragma unroll
    for (int it = 0; it < 2; ++it) { const int k = F.tid + NTHR * it; WSPLIT(0, k, w[16 + it].x); WSPLIT(1, k, w[16 + it].y); WSPLIT(2, k, w[16 + it].z); WSPLIT(3, k, w[16 + it].w); }
#undef WSPLIT
  }
  if (F.tid < 32) lcnt[F.tid] = 0u;
  if (F.tid == 32) rowctr[0] = 0u;
  __syncthreads();
  refresh_ctx(F, A);
  const int NR = skip_ctx ? NB * NLAT : T;
  const int lane2 = F.lane; const int g16 = F.wave * F.G + F.vcu, NG = NR / 16; const int fr = lane2 & 15, fq = lane2 >> 4;
  int myE0 = -1, myE1 = -1, mym = 0, myR0 = 0, myR1 = 0; int* slsp = (int*)(F.ws + WS_SLSP); if (dry) slsp = (int*)A.out + (3 << 20);
  if (g16 < NG) {
    const int r0 = g16 * 16 + fr; const int m = skip_ctx ? (r0 / NLAT) * NTOK + NCTX + (r0 % NLAT) : r0; const int b = m / NTOK, t = m % NTOK, r = t < NCTX ? 8 : b; mym = m;
    const bf16* xrow = hs + (size_t)m * D + 16 * fq; const float* scr = mod + (size_t)r * 6 * D + 4 * D + 16 * fq;
    const int j2 = fr < 4 ? 32 + fr : 35;
    const LAS unsigned char* ah0 = Wh + fr * WPB + 32 * fq; const LAS unsigned char* ah1 = Wh + (16 + fr) * WPB + 32 * fq; const LAS unsigned char* ah2 = Wh + j2 * WPB + 32 * fq;
    const LAS unsigned char* al0 = Wl + fr * WPB + 32 * fq; const LAS unsigned char* al1 = Wl + (16 + fr) * WPB + 32 * fq; const LAS unsigned char* al2 = Wl + j2 * WPB + 32 * fq;
    f32x4 acc0 = {0.f, 0.f, 0.f, 0.f}, acc1 = acc0, acc2 = acc0; float ss = 0.f;
#pragma unroll 2
    for (int g = 0; g < 16; ++g) { const uint4 xw0 = *(const uint4*)(xrow + 64 * g), xw1 = *(const uint4*)(xrow + 64 * g + 8);
      float xa[16] = {bflo(xw0.x), bfhi(xw0.x), bflo(xw0.y), bfhi(xw0.y), bflo(xw0.z), bfhi(xw0.z), bflo(xw0.w), bfhi(xw0.w), bflo(xw1.x), bfhi(xw1.x), bflo(xw1.y), bfhi(xw1.y), bflo(xw1.z), bfhi(xw1.z), bflo(xw1.w), bfhi(xw1.w)};
#pragma unroll
      for (int q = 0; q < 4; ++q) { const float4 s4 = *(const float4*)(scr + 64 * g + 4 * q);
        ss += (xa[4 * q] * xa[4 * q] + xa[4 * q + 1] * xa[4 * q + 1]) + (xa[4 * q + 2] * xa[4 * q + 2] + xa[4 * q + 3] * xa[4 * q + 3]);
        xa[4 * q] *= 1.f + s4.x; xa[4 * q + 1] *= 1.f + s4.y; xa[4 * q + 2] *= 1.f + s4.z; xa[4 * q + 3] *= 1.f + s4.w; }
#pragma unroll
      for (int s = 0; s < 2; ++s) {
        v4u xh, xl;
#pragma unroll
        for (int e2 = 0; e2 < 4; ++e2) { const float a = xa[8 * s + 2 * e2], b2 = xa[8 * s + 2 * e2 + 1]; const unsigned h = cvt_pk_bf16(a, b2); const unsigned lo = cvt_pk_bf16(a - bflo(h), b2 - bfhi(h)); xh[e2] = h; xl[e2] = lo; }
        const bf16x8 bh = __builtin_bit_cast(bf16x8, xh), bl = __builtin_bit_cast(bf16x8, xl);
        const bf16x8 h0 = *(const LAS bf16x8*)(ah0 + 128 * g + 16 * s), h1 = *(const LAS bf16x8*)(ah1 + 128 * g + 16 * s), h2 = *(const LAS bf16x8*)(ah2 + 128 * g + 16 * s);
        const bf16x8 l0 = *(const LAS bf16x8*)(al0 + 128 * g + 16 * s), l1 = *(const LAS bf16x8*)(al1 + 128 * g + 16 * s), l2 = *(const LAS bf16x8*)(al2 + 128 * g + 16 * s);
        acc0 = __builtin_amdgcn_mfma_f32_16x16x32_bf16(h0, bh, acc0, 0, 0, 0); acc1 = __builtin_amdgcn_mfma_f32_16x16x32_bf16(h1, bh, acc1, 0, 0, 0); acc2 = __builtin_amdgcn_mfma_f32_16x16x32_bf16(h2, bh, acc2, 0, 0, 0);
        acc0 = __builtin_amdgcn_mfma_f32_16x16x32_bf16(l0, bh, acc0, 0, 0, 0); acc1 = __builtin_amdgcn_mfma_f32_16x16x32_bf16(l1, bh, acc1, 0, 0, 0); acc2 = __builtin_amdgcn_mfma_f32_16x16x32_bf16(l2, bh, acc2, 0, 0, 0);
        acc0 = __builtin_amdgcn_mfma_f32_16x16x32_bf16(h0, bl, acc0, 0, 0, 0); acc1 = __builtin_amdgcn_mfma_f32_16x16x32_bf16(h1, bl, acc1, 0, 0, 0); acc2 = __builtin_amdgcn_mfma_f32_16x16x32_bf16(h2, bl, acc2, 0, 0, 0); } }
    ss = sum_x16(ss); ss = sum_x32(ss);
    const float rinv = rsqrtf(ss * (1.f / D) + EPS);
    float lg[36];
#pragma unroll
    for (int e = 0; e < 4; ++e) { lg[e] = acc0[e]; lg[16 + e] = acc1[e]; lg[32 + e] = acc2[e]; }
#pragma unroll
    for (int q = 1; q < 4; ++q)
#pragma unroll
      for (int e = 0; e < 4; ++e) { const float a0 = acc0[e], a1 = acc1[e];
        lg[4 * q + e] = __int_as_float(__builtin_amdgcn_ds_bpermute((fr + 16 * q) << 2, __float_as_int(a0))); lg[16 + 4 * q + e] = __int_as_float(__builtin_amdgcn_ds_bpermute((fr + 16 * q) << 2, __float_as_int(a1))); }
    if (fq == 0) {
      const float* cr = cj + r * 36;
      float mxg = -1e30f; int g = 0; float gl[4];
#pragma unroll
      for (int j = 0; j < 4; ++j) { gl[j] = rinv * lg[j] + cr[j]; if (gl[j] > mxg) { mxg = gl[j]; g = j; } }
      float sg = 0.f;
#pragma unroll
      for (int j = 0; j < 4; ++j) sg += __expf(gl[j] - mxg);
      const float pg = 1.f / sg;
      float v0 = -1e30f, v1 = -1e30f; int e0 = 0, e1 = 0;
#pragma unroll
      for (int j = 0; j < 8; ++j) { float le = 0.f;
#pragma unroll
        for (int gg = 0; gg < 4; ++gg) if (gg == g) le = lg[4 + gg * 8 + j];
        le = rinv * le + cr[4 + g * 8 + j];
        if (le > v0) { v1 = v0; e1 = e0; v0 = le; e0 = j; } else if (le > v1) { v1 = le; e1 = j; } }
      const float p1 = __expf(v1 - v0); const float inv = pg / (1.f + p1);
      myE0 = g * 8 + e0; myE1 = g * 8 + e1;
      tok_e[2 * m] = myE0; tok_e[2 * m + 1] = myE1; tok_w[2 * m] = inv; tok_w[2 * m + 1] = p1 * inv;
      myR0 = (int)__hip_atomic_fetch_add(&lcnt[myE0], 1u, __ATOMIC_RELAXED, __HIP_MEMORY_SCOPE_WORKGROUP); myR1 = (int)__hip_atomic_fetch_add(&lcnt[myE1], 1u, __ATOMIC_RELAXED, __HIP_MEMORY_SCOPE_WORKGROUP);
    }
  }
  { const int NR2 = skip_ctx ? NB * NLAT : T; const int rpb = NR2 / F.G;
    for (;;) { unsigned q = 0; if (lane2 == 0) q = __hip_atomic_fetch_add(rowctr, 1u, __ATOMIC_RELAXED, __HIP_MEMORY_SCOPE_WORKGROUP); q = (unsigned)__builtin_amdgcn_readfirstlane((int)q); if ((int)q >= rpb) break;
      const int r0 = F.vcu * NWAVES + (int)(q & 7) + (int)(q >> 3) * NGW; const int m = skip_ctx ? (r0 / NLAT) * NTOK + NCTX + (r0 % NLAT) : r0; const int b = m / NTOK, t = m % NTOK, r = t < NCTX ? 8 : b;
      const float4* sh = (const float4*)(mod + (size_t)r * 6 * D + 3 * D); const float4* sc = sh + D / 4; const v2u* xr = (const v2u*)(hs + (size_t)m * D); float4 v[4]; float ss = 0.f;
#pragma unroll
      for (int j = 0; j < 4; ++j) { const v2u w = xr[lane2 + 64 * j]; v[j] = make_float4(bflo(w.x), bfhi(w.x), bflo(w.y), bfhi(w.y)); ss += v[j].x * v[j].x + v[j].y * v[j].y + v[j].z * v[j].z + v[j].w * v[j].w; }
      const float rinv = rsqrtf(wave_sum(ss) * (1.f / D) + EPS);
#pragma unroll
      for (int j = 0; j < 4; ++j) { const float4 a = sc[lane2 + 64 * j], s4 = sh[lane2 + 64 * j];
        v2u o; o.x = pk2(v[j].x * rinv * (1.f + a.x) + s4.x, v[j].y * rinv * (1.f + a.y) + s4.y); o.y = pk2(v[j].z * rinv * (1.f + a.z) + s4.z, v[j].w * rinv * (1.f + a.w) + s4.w);
        ((v2u*)(hn + (size_t)m * D))[lane2 + 64 * j] = o; } } }
  if (skip_ctx) { int neg1 = -1; asm volatile("" : "+v"(neg1)); for (int m = gw; m < T; m += NGW) if ((m % NTOK) < NCTX && lane < 2) tok_e[2 * m + lane] = neg1; }
  __syncthreads();
  if (F.tid < 32) { const unsigned c = lcnt[F.tid]; lbase[F.tid] = c ? atomicAdd(&counts[F.tid], c) : 0u; }
  __syncthreads();
  if (myE0 >= 0) { const int r0 = myR0 + (int)lbase[myE0], r1 = myR1 + (int)lbase[myE1]; tok_r[2 * mym] = r0; tok_r[2 * mym + 1] = r1; slsp[myE0 * T + r0] = mym; slsp[myE1 * T + r1] = mym; }
  __syncthreads();
}
__device__ __forceinline__ void moe_tables(Ctx& F, const Args& A, int l) {
  LAS int* ps = (LAS int*)(F.lds + XSCR_OFF); LAS int* te = ps + 64; LAS int* cn = ps + 256;
  const unsigned* counts = (const unsigned*)(F.ws + WS_CTL) + CW_CNT + l * 64;
  __syncthreads();
  if (F.tid < NE) cn[F.tid] = (int)__hip_atomic_load(counts + F.tid, __ATOMIC_RELAXED, __HIP_MEMORY_SCOPE_AGENT);
  __syncthreads();
  if (F.tid == 0) { int a = 0; for (int e = 0; e < NE; ++e) { ps[e] = a; a += (cn[e] + 255) / 256 * 256; } ps[NE] = a; }
  __syncthreads();
  for (int i = F.tid; i < NT_MOE; i += NTHR) { int e = -1;
    for (int j = 0; j < NE; ++j) if (i * 256 >= ps[j] && i * 256 < ps[j + 1]) e = j;
    if (e >= 0) { const int off = i * 256 - ps[e]; int nv = cn[e] - off; nv = nv > 256 ? 256 : nv; e |= ((nv - 1) << 5) | ((off >> 8) << 13); }
    te[i] = e; }
  __syncthreads();
}
struct MoeSched {
  int G, c, npn, ntile; const char* A; const char* W; size_t aTile, wExp, wTile; const LAS int* te; const int* slot_tok; const unsigned* hec; unsigned* tmo;
  __device__ __forceinline__ bool next(int i, Unit& u) const { int Lx = i * G + c;
    if (hec) { if (c >= 64) Lx = i == 0 ? c - 64 : i == 1 ? 128 + c : 384 + (i - 2) * 256 + (c - 64); else Lx = 576 + i * 256 + c; }
    if (Lx >= ntile * npn) return false; const int rt = Lx / npn, pn = Lx % npn; const int w = te[rt], e = w & 31;
    u.pm = rt; u.pn = pn; u.aux = e; u.a = A + (size_t)rt * aTile; u.b = W + (size_t)e * wExp + (size_t)pn * wTile; u.rows = slot_tok + e * T + (w >> 13) * 256; u.nv = ((w >> 5) & 255) + 1; return true; }
  __device__ __forceinline__ void a_ready(const Unit& u, int tid) const { if (hec) wait_counter(hec + u.pm * 16, 16u, tmo, tid); }
};
constexpr int CW_HEC = 200000;
struct EpiSwiGLU {
  static constexpr bool PERM = true;
  bf16* H; unsigned* cnt;
  __device__ __forceinline__ void operator()(const f32x4 (&acc)[2][2][4][2], const Unit& u, int wr, int wc, int fr, int fq) const {
    const __amdgpu_buffer_rsrc_t rs = __builtin_amdgcn_make_buffer_rsrc(H, 0, (int)SZ_HE, 0x00020000);
#pragma unroll
    for (int ai = 0; ai < 2; ++ai)
#pragma unroll
      for (int m = 0; m < 4; ++m) { const int r = u.pm * 256 + ai * 128 + wr * 64 + m * 16 + fr; float h[8];
#pragma unroll
        for (int n = 0; n < 2; ++n)
#pragma unroll
          for (int e = 0; e < 4; ++e) { const float g = acc[ai][0][m][n][e]; h[4 * n + e] = g * __builtin_amdgcn_rcpf(1.f + __expf(-g)) * acc[ai][1][m][n][e]; }
        v4u w; w.x = cvt_pk_bf16(h[0], h[1]); w.y = cvt_pk_bf16(h[2], h[3]); w.z = cvt_pk_bf16(h[4], h[5]); w.w = cvt_pk_bf16(h[6], h[7]);
        __builtin_amdgcn_raw_buffer_store_b128(w, rs, (r * 256 + u.pn * 128 + wc * 32 + fq * 8) * 2, 0, 16); }
    if (cnt) { asm volatile("s_waitcnt vmcnt(0)" ::: "memory"); if (fr == 0 && fq == 0) __hip_atomic_fetch_add(cnt + u.pm * 16, 1u, __ATOMIC_RELAXED, __HIP_MEMORY_SCOPE_AGENT); }
  }
};
__device__ __forceinline__ void phase_moe_gu(Ctx& F, const Args& A, int l) {
  moe_tables(F, A, l);
  const LAS int* ps = (const LAS int*)(F.lds + XSCR_OFF);
  MoeSched S; S.G = F.G; S.c = (int)blockIdx.x; S.npn = 2; S.ntile = ps[NE] / 256; S.A = (const char*)(F.ws + WS_HN); S.slot_tok = (const int*)(F.ws + WS_SLSP); S.W = (const char*)(F.ws + WS_WGU + l * SZ_WGU1); S.aTile = 0; S.wExp = (size_t)512 * D * 2; S.wTile = (size_t)256 * D * 2; S.te = ps + 64; S.hec = nullptr; S.tmo = nullptr;
  EpiSwiGLU E{(bf16*)(F.ws + WS_HE), F.G == 256 ? (unsigned*)(F.ws + WS_CTL) + CW_HEC + l * 4096 : nullptr};
  gemm_phase<EpiSwiGLU, MoeSched, true, true>(F.lds, F.tid, D * 2, D * 2, D, S, E);
}
__device__ __forceinline__ void phase_moe_dn(Ctx& F, const Args& A, int l) {
  moe_tables(F, A, l);
  const LAS int* ps = (const LAS int*)(F.lds + XSCR_OFF);
  MoeSched S; S.G = F.G; S.c = (int)blockIdx.x; S.npn = 4; S.ntile = ps[NE] / 256; S.slot_tok = (const int*)(F.ws + WS_SLSP); S.A = (const char*)(F.ws + WS_HE); S.W = (const char*)(F.ws + WS_WDN + l * SZ_WDN1); S.aTile = (size_t)256 * 256 * 2; S.wExp = (size_t)D * 256 * 2; S.wTile = (size_t)256 * 256 * 2; S.te = ps + 64; S.hec = F.G == 256 ? (const unsigned*)(F.ws + WS_CTL) + CW_HEC + l * 4096 : nullptr; S.tmo = (unsigned*)(F.ws + WS_CTL) + CW_BAR_TMO;
  EpiStoreBf16 E{(bf16*)(F.ws + WS_FS), D, (int)SZ_FS, F.lds + RING_BYTES};
  gemm_phase<EpiStoreBf16, MoeSched, true>(F.lds, F.tid, 512, 512, 256, S, E);
}
__device__ __forceinline__ void phase_moe_combine(Ctx& F, const Args& A, int l) {
  const int gw = F.vcu * NWAVES + F.wave, NGW = F.G * NWAVES, lane = F.lane;
  float* hs = (float*)(F.ws + WS_HS); const float* mod = (const float*)(F.ws + WS_MOD) + (size_t)l * 9 * 6 * D;
  const int* tok_s = (const int*)(F.ws + WS_TOKS); const float* tok_w = (const float*)(F.ws + WS_TOKW); const bf16* fs = (const bf16*)(F.ws + WS_FS);
  for (int m = gw; m < T; m += NGW) { const int s0 = tok_s[2 * m], s1 = tok_s[2 * m + 1]; if (s0 < 0) continue;
    const int b = m / NTOK, t = m % NTOK, r = t < NCTX ? 8 : b; const float w0 = tok_w[2 * m], w1 = tok_w[2 * m + 1];
    const float4* g5 = (const float4*)(mod + (size_t)r * 6 * D + 5 * D);
#pragma unroll
    for (int j = 0; j < 4; ++j) { const int c4 = lane + 64 * j; const v2u a = ((const v2u*)(fs + (size_t)s0 * D))[c4], bq = ((const v2u*)(fs + (size_t)s1 * D))[c4]; const float4 g = g5[c4];
      float4 h = ((float4*)(hs + (size_t)m * D))[c4];
      h.x += g.x * (w0 * bflo(a.x) + w1 * bflo(bq.x)); h.y += g.y * (w0 * bfhi(a.x) + w1 * bfhi(bq.x)); h.z += g.z * (w0 * bflo(a.y) + w1 * bflo(bq.y)); h.w += g.w * (w0 * bfhi(a.y) + w1 * bfhi(bq.y));
      ((float4*)(hs + (size_t)m * D))[c4] = h; } }
}
}
namespace mk {
constexpr int NKT = NTOK / 64;
constexpr size_t WS_QM = WS_END2B, SZ_QM = (size_t)NB * 4 * NTOK * 96 * 2;
constexpr size_t WS_QD = WS_QM + SZ_QM, SZ_QD = (size_t)NB * 4 * NTOK * 64 * 2;
constexpr size_t WS_KM = WS_QD + SZ_QD, SZ_KM = (size_t)NB * 4 * NKT * 12288;
constexpr size_t WS_KD = WS_KM + SZ_KM, SZ_KD = (size_t)NB * 2 * NKT * 8192;
constexpr size_t WS_VM = WS_KD + SZ_KD, SZ_VM = (size_t)NB * 4 * NKT * 8192;
constexpr size_t WS_VD = WS_VM + SZ_VM, SZ_VD = (size_t)NB * 2 * NKT * 8192;
constexpr size_t WS_END3 = WS_VD + SZ_VD;
constexpr float QSCALE_M = 0.10206207261596577f * 1.4426950408889634f, QSCALE_D = 0.125f * 1.4426950408889634f;

template <int NCB> __device__ __forceinline__ int v_st(int k, int c) { const int kk = (k & ~0xC) | ((k & 4) << 1) | ((k & 8) >> 1); return ((kk >> 3) * NCB + (c >> 5)) * 512 + ((kk & 7) * 32 + (c & 31)) * 2; }
__device__ __forceinline__ int v_rd_base(int lane) { return ((lane & 3) << 3) | (((lane >> 2) & 3) << 6) | (((lane >> 4) & 1) << 5) | (((lane >> 5) & 1) << 8); }
template <int NCB> constexpr int v_rd_off(int d0, int ks, int half) { return d0 * 512 + ks * (2 * NCB * 512) + half * (NCB * 512); }
typedef short s16x4 __attribute__((ext_vector_type(4)));
typedef float f32x16 __attribute__((ext_vector_type(16)));
template <int OFF> __device__ __forceinline__ s16x4 tr_read(int vb) { s16x4 r; asm volatile("ds_read_b64_tr_b16 %0, %1 offset:%2" : "=&v"(r) : "v"(vb), "i"(OFF) : "memory"); return r; }
__device__ __forceinline__ int crow(int r, int hi) { return (r & 3) + 8 * (r >> 2) + 4 * hi; }
#define SBAR() __builtin_amdgcn_sched_barrier(0)

template <int ROT> __device__ __forceinline__ void rope_cs(int t, int i, float& cs, float& sn) {
  constexpr int NF = ROT / 4;
  if (t < NCTX) { cs = 1.f; sn = 0.f; return; }
  const int tl = t - NCTX; const float pos = (i < NF) ? (float)(tl >> 6) : (float)(tl & 63); const int fi = i % NF;
  const float fr = exp2f(-(float)fi * (13.287712379549449f / (float)NF));
  float rev = pos * fr * 0.15915494309189535f; rev = rev - floorf(rev);
  cs = __builtin_amdgcn_cosf(rev); sn = __builtin_amdgcn_sinf(rev);
}

__device__ __forceinline__ void phase_b_rows(Ctx& F, const Args& A, int l) {
  const int gw = F.vcu * NWAVES + F.wave, NGW = F.G * NWAVES, lane = F.lane;
  const bf16* zb = (const bf16*)(F.ws + WS_ZB); bf16* Y = (bf16*)(F.ws + WS_Y);
  const float* gq_gain = A.in[15] + l * 64; const float* gk_gain = A.in[16] + l * 64; const float* w_conv = A.in[14] + l * 3 * 256;
  const float gq = gq_gain[lane], gk = gk_gain[lane];
  float wcv[3][4];
#pragma unroll
  for (int j = 0; j < 3; ++j)
#pragma unroll
    for (int e = 0; e < 4; ++e) wcv[j][e] = w_conv[j * 256 + 4 * lane + e];
  constexpr int RB = 3;
  for (int m0 = gw; m0 < T; m0 += RB * NGW) {
    int mr[RB]; bool ok[RB];
#pragma unroll
    for (int i = 0; i < RB; ++i) { const int mi = m0 + i * NGW; ok[i] = mi < T; mr[i] = ok[i] ? mi : m0; }
    bf16 kpe[RB], gqv[RB][4], gkv[RB][2], gvv[RB][2]; v2u cc[RB][3], cx[RB][3], cb[RB]; float cmask[RB][3];
#pragma unroll
    for (int i = 0; i < RB; ++i) { const int m = mr[i], t = m % NTOK; const bf16* zr = zb + (size_t)m * ZBW;
      kpe[i] = zr[ZB_KPE + (lane & 31)];
#pragma unroll
      for (int h = 0; h < 4; ++h) gqv[i][h] = zr[ZB_GQ + h * 64 + lane];
#pragma unroll
      for (int h = 0; h < 2; ++h) { gkv[i][h] = zr[ZB_GK + h * 64 + lane]; gvv[i][h] = zr[ZB_GV + h * 64 + lane]; }
      const int lo = t < NCTX ? 0 : NCTX, hi = t < NCTX ? NCTX : NTOK;
#pragma unroll
      for (int j = 0; j < 3; ++j) { const int tt = t + j - 1; const bool in = tt >= lo && tt < hi; cmask[i][j] = in ? 1.f : 0.f; const bf16* z2 = zb + (size_t)(in ? m + j - 1 : m) * ZBW;
        cc[i][j] = *(const v2u*)(z2 + ZB_CC + 4 * lane); cx[i][j] = *(const v2u*)(z2 + ZB_CX + 4 * lane); }
      cb[i] = *(const v2u*)(zr + ZB_CB + 4 * lane); }
#pragma unroll
    for (int i = 0; i < RB; ++i) { const int m = mr[i]; const int b = m / NTOK, t = m % NTOK, tile = t >> 6, rr = t & 63; const bool okr = ok[i];
      { const float xv = bf2f(kpe[i]); const float xp = get_x16(xv, lane); float cs, sn; rope_cs<32>(t, lane & 15, cs, sn);
        const float o = (lane & 16) ? (xp * sn + xv * cs) : (xv * cs - xp * sn); const bf16 ob = (bf16)f2bf(o);
        if (lane < 32 && okr) {
#pragma unroll
          for (int h = 0; h < 4; ++h) ((bf16*)(F.ws + WS_KM + ((size_t)(b * 4 + h) * NKT + tile) * 12288))[(8 + (lane >> 3)) * 512 + rr * 8 + (lane & 7)] = ob; } }
      float cs64, sn64; rope_cs<64>(t, lane & 31, cs64, sn64);
#pragma unroll
      for (int h = 0; h < 4; ++h) { const float x0 = bf2f(gqv[i][h]); const float rinv = rsqrtf(wave_sum(x0 * x0) * (1.f / 64.f) + EPS); const float xv = x0 * rinv * gq;
        const float xp = get_x32(xv, lane); const float o = ((lane & 32) ? (xp * sn64 + xv * cs64) : (xv * cs64 - xp * sn64)) * QSCALE_D;
        if (okr) ((bf16*)(F.ws + WS_QD))[((size_t)(b * 4 + h) * NTOK + t) * 64 + lane] = (bf16)f2bf(o); }
#pragma unroll
      for (int h = 0; h < 2; ++h) { const float x0 = bf2f(gkv[i][h]); const float rinv = rsqrtf(wave_sum(x0 * x0) * (1.f / 64.f) + EPS); const float xv = x0 * rinv * gk;
        const float xp = get_x32(xv, lane); const float o = (lane & 32) ? (xp * sn64 + xv * cs64) : (xv * cs64 - xp * sn64);
        if (okr) { ((bf16*)(F.ws + WS_KD + ((size_t)(b * 2 + h) * NKT + tile) * 8192))[(lane >> 3) * 512 + rr * 8 + (lane & 7)] = (bf16)f2bf(o);
          *(bf16*)(F.ws + WS_VD + ((size_t)(b * 2 + h) * NKT + tile) * 8192 + v_st<2>(rr, lane)) = gvv[i][h]; } }
      { float a[4] = {0.f, 0.f, 0.f, 0.f};
#pragma unroll
        for (int j = 0; j < 3; ++j) { const float mk_ = cmask[i][j]; const v2u c1 = cc[i][j], c2 = cx[i][j];
          a[0] += mk_ * wcv[j][0] * bflo(c1.x) * bflo(c2.x); a[1] += mk_ * wcv[j][1] * bfhi(c1.x) * bfhi(c2.x); a[2] += mk_ * wcv[j][2] * bflo(c1.y) * bflo(c2.y); a[3] += mk_ * wcv[j][3] * bfhi(c1.y) * bfhi(c2.y); }
        v2u o; o.x = pk2(bflo(cb[i].x) * a[0], bfhi(cb[i].x) * a[1]); o.y = pk2(bflo(cb[i].y) * a[2], bfhi(cb[i].y) * a[3]);
        if (okr) *(v2u*)(Y + (size_t)m * D + 512 + 4 * lane) = o; } }
  }
}
template <int NWID> __device__ __forceinline__ float seg_rinv(const bf16* seg, int fq) {
  float ss = 0.f;
#pragma unroll
  for (int i = 0; i < NWID / 32; ++i) { const v4u w = *(const v4u*)(seg + fq * (NWID / 4) + i * 8);
    ss += bflo(w.x) * bflo(w.x) + bfhi(w.x) * bfhi(w.x) + bflo(w.y) * bflo(w.y) + bfhi(w.y) * bfhi(w.y) + bflo(w.z) * bflo(w.z) + bfhi(w.z) * bfhi(w.z) + bflo(w.w) * bflo(w.w) + bfhi(w.w) * bfhi(w.w); }
  ss = sum_x16(ss); ss = sum_x32(ss);
  return rsqrtf(ss * (1.f / NWID) + EPS);
}
struct EpiQm {
  static constexpr bool PERM = true;
  const float* rss; bf16* QM;
  __device__ __forceinline__ void operator()(const f32x4 (&acc)[2][2][4][2], const Unit& u, int wr, int wc, int fr, int fq) const {
    if (u.pn == 0) {
#pragma unroll
      for (int ai = 0; ai < 2; ++ai)
#pragma unroll
        for (int m = 0; m < 4; ++m) { const int r = u.pm * 256 + ai * 128 + wr * 64 + m * 16 + fr; const int b = r / NTOK, t = r % NTOK;
          const f32x4 p4 = *(const f32x4*)(rss + (size_t)r * 8); const float sc = rsqrtf(((p4[0] + p4[1]) + (p4[2] + p4[3])) * (1.f / 256.f) + EPS) * QSCALE_M;
#pragma unroll
          for (int bj = 0; bj < 2; ++bj) { const int h = 2 * bj + (wc >> 1), d = 32 * (wc & 1) + 8 * fq; const f32x4 v0 = acc[ai][bj][m][0] * sc, v1 = acc[ai][bj][m][1] * sc;
            v4u w; w.x = cvt_pk_bf16(v0[0], v0[1]); w.y = cvt_pk_bf16(v0[2], v0[3]); w.z = cvt_pk_bf16(v1[0], v1[1]); w.w = cvt_pk_bf16(v1[2], v1[3]);
            *(v4u*)(QM + ((size_t)(b * 4 + h) * NTOK + t) * 96 + d) = w; } }
    } else {
#pragma unroll
      for (int ai = 0; ai < 2; ++ai)
#pragma unroll
        for (int m = 0; m < 4; ++m) { const int r = u.pm * 256 + ai * 128 + wr * 64 + m * 16 + fr; const int b = r / NTOK, t = r % NTOK;
          const f32x4 p4 = *(const f32x4*)(rss + (size_t)r * 8); const float sc = rsqrtf(((p4[0] + p4[1]) + (p4[2] + p4[3])) * (1.f / 256.f) + EPS) * QSCALE_M;
          const int h = wc; const f32x4 x1 = acc[ai][0][m][0] * sc, x2 = acc[ai][0][m][1] * sc; float o1[4], o2[4];
#pragma unroll
          for (int e = 0; e < 4; ++e) { float cs, sn; rope_cs<32>(t, 4 * fq + e, cs, sn); o1[e] = x1[e] * cs - x2[e] * sn; o2[e] = x1[e] * sn + x2[e] * cs; }
          bf16* q = QM + ((size_t)(b * 4 + h) * NTOK + t) * 96 + 64 + 4 * fq;
          v2u w1; w1.x = cvt_pk_bf16(o1[0], o1[1]); w1.y = cvt_pk_bf16(o1[2], o1[3]); *(v2u*)q = w1;
          v2u w2; w2.x = cvt_pk_bf16(o2[0], o2[1]); w2.y = cvt_pk_bf16(o2[2], o2[3]); *(v2u*)(q + 16) = w2; }
    }
  }
};
struct EpiKVm {
  static constexpr bool PERM = true;
  const float* rss; unsigned char* ws;
  __device__ __forceinline__ void operator()(const f32x4 (&acc)[2][2][4][2], const Unit& u, int wr, int wc, int fr, int fq) const {
    const bool isk = __builtin_amdgcn_readfirstlane(wc) < 2;
    const size_t tileB = isk ? 12288 : 8192; unsigned char* base = ws + (isk ? WS_KM : WS_VM);
#pragma unroll
    for (int ai = 0; ai < 2; ++ai)
#pragma unroll
      for (int m = 0; m < 4; ++m) { const int r = u.pm * 256 + ai * 128 + wr * 64 + m * 16 + fr; const int b = r / NTOK, t = r % NTOK, tile = t >> 6, rr = t & 63;
        const f32x4 p4 = *(const f32x4*)(rss + (size_t)r * 8 + 4); const float sc = rsqrtf(((p4[0] + p4[1]) + (p4[2] + p4[3])) * (1.f / 128.f) + EPS);
        const int inoff = isk ? (4 * wc + fq) * 1024 + rr * 16 : v_st<2>(rr, 32 * (wc - 2) + 8 * fq);
#pragma unroll
        for (int bj = 0; bj < 2; ++bj) { const int h = 2 * u.pn + bj; const f32x4 v0 = acc[ai][bj][m][0] * sc, v1 = acc[ai][bj][m][1] * sc;
          v4u w; w.x = cvt_pk_bf16(v0[0], v0[1]); w.y = cvt_pk_bf16(v0[2], v0[3]); w.z = cvt_pk_bf16(v1[0], v1[1]); w.w = cvt_pk_bf16(v1[2], v1[3]);
          *(v4u*)(base + ((size_t)(b * 4 + h) * NKT + tile) * tileB + inoff) = w; } }
  }
};
struct SliceSched {
  TileOrder o; const char* A; const char* B;
  __device__ __forceinline__ bool next(int i, Unit& u) const { int pm, pn; if (!o.tile(i, pm, pn)) return false; u.pm = pm; u.pn = pn; u.aux = 0; u.a = A + (size_t)pm * 256 * ZBW * 2; u.b = B + (size_t)pn * 256 * 512; return true; }
  __device__ __forceinline__ void a_ready(const Unit&, int) const {}
};
__device__ __forceinline__ void phase_b_chunkmix(Ctx& F, const Args& A, int l, const int widx, const int nw) {
  const int lane = F.lane, wave = F.wave, r32 = lane & 31, hi = lane >> 5;
  const bf16* zb = (const bf16*)(F.ws + WS_ZB); bf16* Y = (bf16*)(F.ws + WS_Y); const bf16* wsg = (const bf16*)(F.ws + WS_WSGU + l * SZ_WSGU1);
  const float* sgu_gain = A.in[7] + l * 256; const float* b_s = A.in[9] + l * 4 * 128;
  const float g0 = sgu_gain[4 * lane], g1 = sgu_gain[4 * lane + 1], g2 = sgu_gain[4 * lane + 2], g3 = sgu_gain[4 * lane + 3];
  LAS unsigned char* img = F.lds;
  const int g = wave >> 1, ph = wave & 1;
  for (int ch = widx; ch < T / 128; ch += nw) {
    const int m0 = ch * 128;
    __syncthreads();
    for (int q = wave; q < 128; q += NWAVES) { const v2u w = *(const v2u*)(zb + (size_t)(m0 + q) * ZBW + ZB_AV + 4 * lane);
      const float a0 = gelu_tanh(bflo(w.x)), a1 = gelu_tanh(bfhi(w.x)), a2 = gelu_tanh(bflo(w.y)), a3 = gelu_tanh(bfhi(w.y));
      const float rinv = rsqrtf(wave_sum(a0 * a0 + a1 * a1 + a2 * a2 + a3 * a3) * (1.f / 256.f) + EPS);
      v2u o; o.x = pk2(a0 * rinv * g0, a1 * rinv * g1); o.y = pk2(a2 * rinv * g2, a3 * rinv * g3);
      *(LAS v2u*)(img + v_st<8>(q, 4 * lane)) = o; }
    __syncthreads();
    f32x16 acc[2][2];
#pragma unroll
    for (int a = 0; a < 2; ++a)
#pragma unroll
      for (int c = 0; c < 2; ++c) acc[a][c] = f32x16{};
    const int vb = (int)(uintptr_t)img + v_rd_base(lane) + (2 * g) * 512;
    const bf16* wrow = wsg + ((size_t)g * 128 + 64 * ph + r32) * 128 + 8 * hi;
#define CM_STEP(KS) do { const bf16x8 a0 = *(const bf16x8*)(wrow + 16 * (KS)), a1 = *(const bf16x8*)(wrow + 32 * 128 + 16 * (KS)); \
      const s16x4 l0 = tr_read<v_rd_off<8>(0, KS, 0)>(vb), h0 = tr_read<v_rd_off<8>(0, KS, 1)>(vb), l1 = tr_read<v_rd_off<8>(1, KS, 0)>(vb), h1 = tr_read<v_rd_off<8>(1, KS, 1)>(vb); \
      asm volatile("s_waitcnt lgkmcnt(0)" ::: "memory"); SBAR(); \
      const bf16x8 b0 = (bf16x8){l0[0], l0[1], l0[2], l0[3], h0[0], h0[1], h0[2], h0[3]}, b1 = (bf16x8){l1[0], l1[1], l1[2], l1[3], h1[0], h1[1], h1[2], h1[3]}; \
      acc[0][0] = __builtin_amdgcn_mfma_f32_32x32x16_bf16(a0, b0, acc[0][0], 0, 0, 0); acc[0][1] = __builtin_amdgcn_mfma_f32_32x32x16_bf16(a0, b1, acc[0][1], 0, 0, 0); \
      acc[1][0] = __builtin_amdgcn_mfma_f32_32x32x16_bf16(a1, b0, acc[1][0], 0, 0, 0); acc[1][1] = __builtin_amdgcn_mfma_f32_32x32x16_bf16(a1, b1, acc[1][1], 0, 0, 0); } while (0)
    CM_STEP(0); CM_STEP(1); CM_STEP(2); CM_STEP(3); CM_STEP(4); CM_STEP(5); CM_STEP(6); CM_STEP(7);
#undef CM_STEP
#pragma unroll
    for (int pt = 0; pt < 2; ++pt)
#pragma unroll
      for (int r = 0; r < 16; ++r) { const int p = 64 * ph + 32 * pt + crow(r, hi); const float bs = b_s[g * 128 + p];
#pragma unroll
        for (int cb = 0; cb < 2; ++cb) { const int c = 64 * g + 32 * cb + r32; const float au = gelu_tanh(bf2f(zb[(size_t)(m0 + p) * ZBW + ZB_AU + c]));
          Y[(size_t)(m0 + p) * D + c] = (bf16)f2bf(au * (acc[pt][cb][r] + bs)); } }
  }
  __syncthreads();
}
constexpr float ATT_THR = 8.f;
template <bool FIRST> __device__ __forceinline__ void att_partialSM(f32x16& p0, f32x16& p1, float& m_reg, float& alpha, f32x16& nm) {
  float pmax = p0[0];
#pragma unroll
  for (int r = 1; r < 16; ++r) pmax = fmaxf(pmax, p0[r]);
#pragma unroll
  for (int r = 0; r < 16; ++r) pmax = fmaxf(pmax, p1[r]);
  { auto rr = __builtin_amdgcn_permlane32_swap(__float_as_uint(pmax), opq(__float_as_uint(pmax)), false, false); const unsigned r0 = rr[0], r1 = rr[1]; pmax = fmaxf(__uint_as_float(r0), __uint_as_float(r1)); }
  if (FIRST) { m_reg = pmax; alpha = 1.f;
#pragma unroll
    for (int r = 0; r < 16; ++r) { p0[r] -= pmax; p1[r] -= pmax; nm[r] = -pmax; } }
  else if (__builtin_expect(__all(pmax <= ATT_THR), 1)) { alpha = 1.f; }
  else { const float d = fmaxf(pmax, 0.f); alpha = __builtin_amdgcn_exp2f(-d); m_reg += d; const float nmv = -m_reg;
#pragma unroll
    for (int r = 0; r < 16; ++r) { p0[r] -= d; p1[r] -= d; nm[r] = nmv; } }
#pragma unroll
  for (int r = 0; r < 16; ++r) p0[r] = __builtin_amdgcn_exp2f(p0[r]);
}
__device__ __forceinline__ void att_finishSM(f32x16& p0, f32x16& p1, float alpha, float& l_reg, bf16x8& pa0, bf16x8& pa1, bf16x8& pa2, bf16x8& pa3) {
#pragma unroll
  for (int r = 0; r < 16; ++r) p1[r] = __builtin_amdgcn_exp2f(p1[r]);
  f32x2 ps2 = {0.f, 0.f};
#pragma unroll
  for (int r = 0; r < 16; r += 2) { ps2 += (f32x2){p0[r], p0[r + 1]}; ps2 += (f32x2){p1[r], p1[r + 1]}; }
  float ps = ps2[0] + ps2[1];
  { auto rr = __builtin_amdgcn_permlane32_swap(__float_as_uint(ps), opq(__float_as_uint(ps)), false, false); const unsigned r0 = rr[0], r1 = rr[1]; ps = __uint_as_float(r0) + __uint_as_float(r1); }
  l_reg = l_reg * alpha + ps;
#define PK4(P, BASE, OUT) do { unsigned a0 = cvt_pk_bf16(P[BASE + 0], P[BASE + 1]), a1 = cvt_pk_bf16(P[BASE + 2], P[BASE + 3]);   \
    unsigned b0 = cvt_pk_bf16(P[BASE + 4], P[BASE + 5]), b1 = cvt_pk_bf16(P[BASE + 6], P[BASE + 7]);                              \
    auto r0 = __builtin_amdgcn_permlane32_swap(a0, b0, false, false); auto r1 = __builtin_amdgcn_permlane32_swap(a1, b1, false, false); \
    v4u w = {r0[0], r1[0], r0[1], r1[1]}; OUT = __builtin_bit_cast(bf16x8, w); } while (0)
  PK4(p0, 0, pa0); PK4(p0, 8, pa1); PK4(p1, 0, pa2); PK4(p1, 8, pa3);
#undef PK4
}
template <int DK> __device__ __forceinline__ void att_qkt(f32x16& p0, f32x16& p1, const LAS unsigned char* Ks, const bf16x8* qr, int r32, int hi, const f32x16& nm) {
#pragma unroll
  for (int d0 = 0; d0 < DK / 16; ++d0) { const LAS unsigned char* kb = Ks + (2 * d0 + hi) * 1024 + r32 * 16;
    const bf16x8 b0 = *(const LAS bf16x8*)kb, b1 = *(const LAS bf16x8*)(kb + 512);
    if (d0 == 0) { p0 = __builtin_amdgcn_mfma_f32_32x32x16_bf16(b0, qr[d0], nm, 0, 0, 0); p1 = __builtin_amdgcn_mfma_f32_32x32x16_bf16(b1, qr[d0], nm, 0, 0, 0); }
    else { p0 = __builtin_amdgcn_mfma_f32_32x32x16_bf16(b0, qr[d0], p0, 0, 0, 0); p1 = __builtin_amdgcn_mfma_f32_32x32x16_bf16(b1, qr[d0], p1, 0, 0, 0); } }
}
template <int D0> __device__ __forceinline__ void att_pv_one(f32x16& od, int vb, bf16x8 pa0, bf16x8 pa1, bf16x8 pa2, bf16x8 pa3) {
  const s16x4 l0 = tr_read<v_rd_off<2>(D0, 0, 0)>(vb), h0 = tr_read<v_rd_off<2>(D0, 0, 1)>(vb), l1 = tr_read<v_rd_off<2>(D0, 1, 0)>(vb), h1 = tr_read<v_rd_off<2>(D0, 1, 1)>(vb);
  const s16x4 l2 = tr_read<v_rd_off<2>(D0, 2, 0)>(vb), h2 = tr_read<v_rd_off<2>(D0, 2, 1)>(vb), l3 = tr_read<v_rd_off<2>(D0, 3, 0)>(vb), h3 = tr_read<v_rd_off<2>(D0, 3, 1)>(vb);
  asm volatile("s_waitcnt lgkmcnt(0)" ::: "memory"); SBAR();
#define PK(Lx, Hx) (bf16x8){Lx[0], Lx[1], Lx[2], Lx[3], Hx[0], Hx[1], Hx[2], Hx[3]}
  od = __builtin_amdgcn_mfma_f32_32x32x16_bf16(pa0, PK(l0, h0), od, 0, 0, 0);
  od = __builtin_amdgcn_mfma_f32_32x32x16_bf16(pa1, PK(l1, h1), od, 0, 0, 0);
  od = __builtin_amdgcn_mfma_f32_32x32x16_bf16(pa2, PK(l2, h2), od, 0, 0, 0);
  od = __builtin_amdgcn_mfma_f32_32x32x16_bf16(pa3, PK(l3, h3), od, 0, 0, 0);
#undef PK
}
template <int DK>
__device__ __forceinline__ void attn_unit(LAS unsigned char* lds, const int tid, const bf16* __restrict__ Qb, const unsigned char* __restrict__ Kt, const unsigned char* __restrict__ Vt, const int NT, bf16* Ob) {
  constexpr int KB = DK * 128, ND = DK / 16;
  const int wid = __builtin_amdgcn_readfirstlane(tid >> 6), lane = tid & 63, r32 = lane & 31, hi = lane >> 5;
  LAS unsigned char* Vl = lds; LAS unsigned char* Kl = lds + 16384; LAS float* wsf = (LAS float*)(lds + 16384 + 2 * KB) + wid * 64; LAS float* li_l = wsf; LAS float* al_l = wsf + 32;
  LAS bf16* stg = (LAS bf16*)(lds + 16384 + 2 * KB + 2048) + wid * 2048;
  float m_reg = 0.f, l_reg = 0.f; f32x16 o[2] = {f32x16{}, f32x16{}}; f32x16 nm = f32x16{}; bf16x8 qr[ND];
  const bf16* Qw = Qb + (size_t)(wid * 32 + r32) * DK + hi * 8;
#pragma unroll
  for (int d0 = 0; d0 < ND; ++d0) qr[d0] = *(const bf16x8*)(Qw + d0 * 16);
  const bool has2 = (DK == 96) && (wid < 4);
  const int vb0 = (int)(uintptr_t)Vl + v_rd_base(lane);
  struct { v4u k0, k1, v; } sr_[2];
#define SLOAD(i, tl) do { const unsigned char* kp_ = Kt + (size_t)(tl) * KB + tid * 16; sr_[i].k0 = *(const v4u*)kp_; if (has2) sr_[i].k1 = *(const v4u*)(kp_ + 8192); sr_[i].v = *(const v4u*)(Vt + (size_t)(tl) * 8192 + tid * 16); } while (0)
#define SWRITE(b, i) do { *(LAS v4u*)(Kl + (b) * KB + tid * 16) = sr_[i].k0; if (has2) *(LAS v4u*)(Kl + (b) * KB + 8192 + tid * 16) = sr_[i].k1; *(LAS v4u*)(Vl + (b) * 8192 + tid * 16) = sr_[i].v; } while (0)
#define RESC(a) do { if (__any((a) < 1.f)) { if (hi == 0) al_l[r32] = (a); asm volatile("s_waitcnt lgkmcnt(0)" ::: "memory"); \
    _Pragma("unroll") for (int d = 0; d < 2; ++d) _Pragma("unroll") for (int r = 0; r < 16; ++r) o[d][r] *= al_l[crow(r, hi)]; } } while (0)
  f32x16 pA0, pA1, pB0, pB1; float alA, alB; bf16x8 pa0, pa1, pa2, pa3;
  SLOAD(0, 0); SWRITE(0, 0); __syncthreads();
  att_qkt<DK>(pA0, pA1, Kl, qr, r32, hi, nm); att_partialSM<true>(pA0, pA1, m_reg, alA, nm);
  SLOAD(1, 1); SLOAD(0, 2);
  SWRITE(1, 1); __syncthreads();
#pragma unroll 1
  for (int j = 1; j + 1 < NT; j += 2) {
    SBAR(); att_qkt<DK>(pB0, pB1, Kl + KB, qr, r32, hi, nm);
    att_finishSM(pA0, pA1, alA, l_reg, pa0, pa1, pa2, pa3); SBAR();
    SLOAD(1, j + 2); SBAR();
    att_pv_one<0>(o[0], vb0, pa0, pa1, pa2, pa3); att_pv_one<1>(o[1], vb0, pa0, pa1, pa2, pa3); att_partialSM<false>(pB0, pB1, m_reg, alB, nm);
    __syncthreads(); SWRITE(0, 0);
    RESC(alB); __syncthreads();
    SBAR(); att_qkt<DK>(pA0, pA1, Kl, qr, r32, hi, nm);
    att_finishSM(pB0, pB1, alB, l_reg, pa0, pa1, pa2, pa3); SBAR();
    if (j + 3 < NT) SLOAD(0, j + 3); SBAR();
    att_pv_one<0>(o[0], vb0 + 8192, pa0, pa1, pa2, pa3); att_pv_one<1>(o[1], vb0 + 8192, pa0, pa1, pa2, pa3); att_partialSM<false>(pA0, pA1, m_reg, alA, nm);
    __syncthreads(); SWRITE(1, 1);
    RESC(alA); __syncthreads();
  }
  SBAR(); att_qkt<DK>(pB0, pB1, Kl + KB, qr, r32, hi, nm);
  att_finishSM(pA0, pA1, alA, l_reg, pa0, pa1, pa2, pa3); SBAR();
  att_pv_one<0>(o[0], vb0, pa0, pa1, pa2, pa3); att_pv_one<1>(o[1], vb0, pa0, pa1, pa2, pa3); att_partialSM<false>(pB0, pB1, m_reg, alB, nm);
  __syncthreads(); RESC(alB);
  att_finishSM(pB0, pB1, alB, l_reg, pa0, pa1, pa2, pa3); SBAR();
  att_pv_one<0>(o[0], vb0 + 8192, pa0, pa1, pa2, pa3); att_pv_one<1>(o[1], vb0 + 8192, pa0, pa1, pa2, pa3);
  if (hi == 0) li_l[r32] = l_reg; asm volatile("s_waitcnt lgkmcnt(0)" ::: "memory");
#pragma unroll
  for (int r = 0; r < 16; ++r) { const float rl = __builtin_amdgcn_rcpf(li_l[crow(r, hi)]); const int orow = crow(r, hi);
    stg[orow * 64 + r32] = (bf16)f2bf(o[0][r] * rl); stg[orow * 64 + 32 + r32] = (bf16)f2bf(o[1][r] * rl); }
  asm volatile("s_waitcnt lgkmcnt(0)" ::: "memory");
#pragma unroll
  for (int i = 0; i < 4; ++i) { const int row = i * 8 + (lane >> 3), ch = lane & 7; const v4u v = *(const LAS v4u*)(stg + row * 64 + ch * 8); *(v4u*)(Ob + (size_t)(wid * 32 + row) * D + ch * 8) = v; }
#undef SLOAD
#undef SWRITE
#undef RESC
}
__device__ __forceinline__ void phase_attn(Ctx& F, const Args& A, bool skipctx = false) {
  for (int i = 0;; ++i) {
    const int Lx = i * F.G + (int)blockIdx.x; if (Lx >= (skipctx ? 512 : 576)) break;
    int kind, b, h, qb;
    if (Lx < 512) { kind = Lx >> 8; const int rem = Lx & 255; b = rem & 7; const int idx = rem >> 3; h = idx >> 3; qb = 1 + (idx & 7); }
    else { const int ll = Lx - 512; b = ll & 7; const int j = ll >> 3; kind = j >> 2; h = j & 3; qb = 0; }
    const int NT = qb == 0 ? 4 : NKT;
    bf16* Ob = (bf16*)(F.ws + WS_Y) + (size_t)(b * NTOK + qb * 256) * D + (kind == 0 ? 256 : 768) + h * 64;
    if (kind == 0) attn_unit<96>(F.lds, F.tid, (const bf16*)(F.ws + WS_QM) + ((size_t)(b * 4 + h) * NTOK + qb * 256) * 96, F.ws + WS_KM + (size_t)(b * 4 + h) * NKT * 12288, F.ws + WS_VM + (size_t)(b * 4 + h) * NKT * 8192, NT, Ob);
    else attn_unit<64>(F.lds, F.tid, (const bf16*)(F.ws + WS_QD) + ((size_t)(b * 4 + h) * NTOK + qb * 256) * 64, F.ws + WS_KD + (size_t)(b * 2 + (h >> 1)) * NKT * 8192, F.ws + WS_VD + (size_t)(b * 2 + (h >> 1)) * NKT * 8192, NT, Ob);
  }
  __syncthreads();
}
__device__ __forceinline__ void phase_b(Ctx& F, const Args& A, int l) {
  phase_b_rows(F, A, l);
  refresh_ctx(F, A);
  const bool split = F.G >= 200; const int c = (int)blockIdx.x;
  if (!split || c >= 144) {
    const int gsub = split ? F.G - 144 : F.G, csub = split ? c - 144 : c;
    { SliceSched S; S.o.init(NROWT, 2, gsub, csub); S.A = (const char*)(F.ws + WS_ZB) + ZB_MQ * 2; S.B = (const char*)(F.ws + WS_WUQ + l * SZ_WUQ1);
      EpiQm E{(const float*)(F.ws + WS_RSS), (bf16*)(F.ws + WS_QM)}; gemm_phase<EpiQm, SliceSched, true>(F.lds, F.tid, ZBW * 2, 512, 256, S, E); }
    refresh_ctx(F, A);
    { SliceSched S; S.o.init(NROWT, 2, gsub, csub < gsub / 2 ? csub + gsub / 2 : csub - gsub / 2); S.A = (const char*)(F.ws + WS_ZB) + ZB_MKV * 2;   S.B = (const char*)(F.ws + WS_WUKV + l * SZ_WUKV1);
      EpiKVm E{(const float*)(F.ws + WS_RSS), F.ws}; gemm_phase<EpiKVm, SliceSched, true>(F.lds, F.tid, ZBW * 2, 512, 256, S, E); }
    refresh_ctx(F, A);
  }
  if (!split) phase_b_chunkmix(F, A, l, c, F.G); else if (c < 144) phase_b_chunkmix(F, A, l, c, 144);
}
}
namespace mk {
__device__ __forceinline__ void phase_norm_mod(Ctx& F, const Args& A, int l, bool dry = false) {
  const int gw = F.vcu * NWAVES + F.wave, NGW = F.G * NWAVES, lane = F.lane;
  if (F.vcu < 9 && !dry) {
    const int r = F.vcu; const float* sh = (const float*)(F.ws + WS_MOD) + (size_t)l * 9 * 6 * D + (size_t)r * 6 * D + 3 * D;
    const float* wgr = A.in[21] + (size_t)l * D * 4; const float* bgr = A.in[22] + l * 4; const float* wer = A.in[23] + (size_t)l * D * 32; const float* ber = A.in[24] + l * 32;
    for (int j = F.wave; j < 36; j += NWAVES) { float s = 0.f;
#pragma unroll 4
      for (int i = 0; i < 16; ++i) { const int k = lane + 64 * i; s += sh[k] * (j < 4 ? wgr[k * 4 + j] : wer[k * 32 + (j - 4)]); }
      s = wave_sum(s); if (lane == 0) ((float*)(F.ws + WS_CJ))[l * (9 * 36) + r * 36 + j] = s + (j < 4 ? bgr[j] : ber[j - 4]); } }
  bf16* hs = (bf16*)(F.ws + WS_HS); bf16* hn = (bf16*)(F.ws + WS_HN); const float* mod = (const float*)(F.ws + WS_MOD) + (size_t)l * 9 * 6 * D;
  const int* tok_e = (const int*)(F.ws + WS_TOKE); const int* tok_r = (const int*)(F.ws + WS_TOKR); const float* tok_w = (const float*)(F.ws + WS_TOKW); const bf16* fs = (const bf16*)(F.ws + WS_FS);
  const LAS int* ps = (const LAS int*)(F.lds + XSCR_OFF); if (l > 0 && !dry) moe_tables(F, A, l - 1);
  for (int m = gw; m < T; m += NGW) {
    const int b = m / NTOK, t = m % NTOK, r = t < NCTX ? 8 : b;
    const float4* xr = t < NCTX ? (const float4*)(A.in[2] + ((size_t)b * NCTX + t) * D) : (const float4*)(A.in[0] + ((size_t)b * NLAT + (t - NCTX)) * D); const v2u* hr = (const v2u*)(hs + (size_t)m * D);
    const float4* sh = (const float4*)(mod + (size_t)r * 6 * D); const float4* sc = sh + D / 4;
    float4 v[4]; float ss = 0.f;
    if (l == 0 && !dry) {
#pragma unroll
      for (int j = 0; j < 4; ++j) v[j] = xr[lane + 64 * j]; }
    else {
#pragma unroll
      for (int j = 0; j < 4; ++j) { const v2u w = hr[lane + 64 * j]; v[j] = make_float4(bflo(w.x), bfhi(w.x), bflo(w.y), bfhi(w.y)); } }
    if (l > 0 && !dry) { const int s0 = ps[tok_e[2 * m]] + tok_r[2 * m], s1 = ps[tok_e[2 * m + 1]] + tok_r[2 * m + 1]; const float w0 = tok_w[2 * m], w1 = tok_w[2 * m + 1]; const float4* g5 = (const float4*)(mod - (size_t)9 * 6 * D + (size_t)r * 6 * D + 5 * D);
#pragma unroll
      for (int j = 0; j < 4; ++j) { const int c4 = lane + 64 * j; const v2u a = ((const v2u*)(fs + (size_t)s0 * D))[c4], bq = ((const v2u*)(fs + (size_t)s1 * D))[c4]; const float4 g = g5[c4];
        v[j].x += g.x * (w0 * bflo(a.x) + w1 * bflo(bq.x)); v[j].y += g.y * (w0 * bfhi(a.x) + w1 * bfhi(bq.x)); v[j].z += g.z * (w0 * bflo(a.y) + w1 * bflo(bq.y)); v[j].w += g.w * (w0 * bfhi(a.y) + w1 * bfhi(bq.y)); } }
#pragma unroll
    for (int j = 0; j < 4; ++j) { v2u w; w.x = pk2(v[j].x, v[j].y); w.y = pk2(v[j].z, v[j].w); ((v2u*)(hs + (size_t)m * D))[lane + 64 * j] = w;
      v[j] = make_float4(bflo(w.x), bfhi(w.x), bflo(w.y), bfhi(w.y)); ss += v[j].x * v[j].x + v[j].y * v[j].y + v[j].z * v[j].z + v[j].w * v[j].w; }
    const float rinv = rsqrtf(wave_sum(ss) * (1.f / D) + EPS);
#pragma unroll
    for (int j = 0; j < 4; ++j) { const float4 a = sc[lane + 64 * j], s4 = sh[lane + 64 * j];
      v2u o; o.x = pk2(v[j].x * rinv * (1.f + a.x) + s4.x, v[j].y * rinv * (1.f + a.y) + s4.y); o.y = pk2(v[j].z * rinv * (1.f + a.z) + s4.z, v[j].w * rinv * (1.f + a.w) + s4.w);
      ((v2u*)(hn + (size_t)m * D))[lane + 64 * j] = o;
      { const float h0 = v[j].x * rinv * (1.f + a.x) + s4.x, h1 = v[j].y * rinv * (1.f + a.y) + s4.y, h2 = v[j].z * rinv * (1.f + a.z) + s4.z, h3 = v[j].w * rinv * (1.f + a.w) + s4.w;
        int w8 = 0; w8 = __builtin_amdgcn_cvt_pk_fp8_f32(h0, h1, w8, false); w8 = __builtin_amdgcn_cvt_pk_fp8_f32(h2, h3, w8, true); ((int*)(F.ws + WS_HN8 + (size_t)m * D))[lane + 64 * j] = w8; } }
  }
}
__device__ __forceinline__ void phase_final(Ctx& F, const Args& A) {
  const int gw = F.vcu * NWAVES + F.wave, NGW = F.G * NWAVES, lane = F.lane;
  const bf16* hs = (const bf16*)(F.ws + WS_HS); const float* mod = (const float*)(F.ws + WS_MOD) + (size_t)(L - 1) * 9 * 6 * D; const float4* fg = (const float4*)A.in[27];
  const int* tok_e = (const int*)(F.ws + WS_TOKE); const int* tok_r = (const int*)(F.ws + WS_TOKR); const float* tok_w = (const float*)(F.ws + WS_TOKW); const bf16* fs = (const bf16*)(F.ws + WS_FS);
  const LAS int* ps = (const LAS int*)(F.lds + XSCR_OFF); moe_tables(F, A, L - 1);
  for (int rI = gw; rI < NB * NLAT; rI += NGW) {
    const int b = rI / NLAT, tl = rI % NLAT; const size_t m = (size_t)b * NTOK + NCTX + tl;
    const v2u* xr = (const v2u*)(hs + m * D); float4 v[4]; float ss = 0.f;
    const int s0 = ps[tok_e[2 * m]] + tok_r[2 * m], s1 = ps[tok_e[2 * m + 1]] + tok_r[2 * m + 1]; const float w0 = tok_w[2 * m], w1 = tok_w[2 * m + 1]; const float4* g5 = (const float4*)(mod + (size_t)b * 6 * D + 5 * D);
#pragma unroll
    for (int j = 0; j < 4; ++j) { const int c4 = lane + 64 * j; { const v2u w = xr[c4]; v[j] = make_float4(bflo(w.x), bfhi(w.x), bflo(w.y), bfhi(w.y)); } const v2u a = ((const v2u*)(fs + (size_t)s0 * D))[c4], bq = ((const v2u*)(fs + (size_t)s1 * D))[c4]; const float4 g = g5[c4];
      v[j].x += g.x * (w0 * bflo(a.x) + w1 * bflo(bq.x)); v[j].y += g.y * (w0 * bfhi(a.x) + w1 * bfhi(bq.x)); v[j].z += g.z * (w0 * bflo(a.y) + w1 * bflo(bq.y)); v[j].w += g.w * (w0 * bfhi(a.y) + w1 * bfhi(bq.y));
      ss += v[j].x * v[j].x + v[j].y * v[j].y + v[j].z * v[j].z + v[j].w * v[j].w; }
    const float rinv = rsqrtf(wave_sum(ss) * (1.f / D) + EPS);
#pragma unroll
    for (int j = 0; j < 4; ++j) { const float4 g = fg[lane + 64 * j]; float4 o; o.x = v[j].x * rinv * g.x; o.y = v[j].y * rinv * g.y; o.z = v[j].z * rinv * g.z; o.w = v[j].w * rinv * g.w; ((float4*)(A.out + (size_t)rI * D))[lane + 64 * j] = o; }
  }
}
constexpr int CW_BAR = 16384;
__global__ void __launch_bounds__(NTHR, 2) mk_kernel(Args a) {
  extern __shared__ __attribute__((aligned(16))) unsigned char lds_raw[];
  Ctx F; F.lds = (LAS unsigned char*)lds_raw; F.ws = a.ws;
  { const int t0 = threadIdx.x; F.wave = __builtin_amdgcn_readfirstlane(t0 >> 6); }
  F.lane = (int)__builtin_amdgcn_mbcnt_hi(~0u, __builtin_amdgcn_mbcnt_lo(~0u, 0u)); F.tid = F.wave * 64 + F.lane;
  F.G = gridDim.x; { const int bx = blockIdx.x; F.vcu = (F.G % 8 == 0) ? (bx % 8) * (F.G / 8) + bx / 8 : bx; }
  volatile LAS unsigned* st = (volatile LAS unsigned*)(F.lds + MISC_OFF);
  if (F.tid < 4) st[F.tid] = 0u;
  __syncthreads();
  XcdBarrier bar = xcd_barrier_post((unsigned*)(F.ws + WS_CTL) + CW_BAR, st, F.tid == 0);
#define GRID_BAR() do { { unsigned char* w_ = a.ws; asm volatile("" : "+s"(w_)); unsigned x_ = bar.x; asm volatile("" : "+s"(x_)); bar.x = x_; bar.bar = (unsigned*)(w_ + WS_CTL) + CW_BAR; xcd_barrier(bar, F.tid == 0); F.ws = w_; } \
    int wv_ = F.wave; asm volatile("" : "+s"(wv_)); F.wave = wv_; unsigned z_ = 0u; asm volatile("" : "+v"(z_)); const int l_ = (int)__builtin_amdgcn_mbcnt_hi(~0u, __builtin_amdgcn_mbcnt_lo(~0u, z_)); F.lane = l_; F.tid = wv_ * 64 + l_; } while (0)
#ifndef DUP
#define DUP 0
#endif
#ifndef GPM
#define GPM 0
#endif
  phase_prep(F, a); GRID_BAR();
  if (DUP & 256) { phase_prep(F, a); GRID_BAR(); }
#pragma unroll 1
  for (int l = 0; l < L; ++l) {
    phase_norm_mod(F, a, l); GRID_BAR();
    phase_zgemm(F, a, l); GRID_BAR();
    if (DUP & 1) { phase_zgemm(F, a, l, GPM); GRID_BAR(); }
    phase_b(F, a, l); GRID_BAR();
    if (DUP & 2) { phase_b(F, a, l); GRID_BAR(); }
    if (DUP & 8192) { phase_b_rows(F, a, l); GRID_BAR(); }
    if (DUP & 16384) { const int c = (int)blockIdx.x; if (c < 144) phase_b_chunkmix(F, a, l, c, 144); GRID_BAR(); }
    const bool lastl = l == L - 1;
    phase_attn(F, a, lastl); GRID_BAR();
    phase_branch(F, a, l, lastl);
    if (F.G == 256) refresh_ctx(F, a); else GRID_BAR();
    phase_gate(F, a, l, lastl);
    if (F.G == 256) refresh_ctx(F, a); else GRID_BAR();
    phase_out(F, a, l, 1.f, F.G == 256, lastl); GRID_BAR();
    phase_norm_router(F, a, l, l == L - 1); GRID_BAR();
    phase_moe_gu(F, a, l);
    if (F.G == 256) refresh_ctx(F, a); else GRID_BAR();
    phase_moe_dn(F, a, l); GRID_BAR();
    if (DUP & 1024) { phase_norm_mod(F, a, l, true); GRID_BAR(); }
    if (DUP & 2048) { phase_out(F, a, l, 0.f, false); GRID_BAR(); }
    if (DUP & 128) { phase_gate<GPM>(F, a, l, lastl, CW_TILE); GRID_BAR(); }
    if (DUP & 64) { phase_gate(F, a, l, lastl, CW_TILE); refresh_ctx(F, a); phase_out(F, a, l, 0.f, true, lastl, CW_TILE); GRID_BAR(); }
    if (DUP & 4096) { phase_norm_router(F, a, l, l == L - 1, true); GRID_BAR(); }
    if (DUP & 512) { GRID_BAR(); GRID_BAR(); GRID_BAR(); GRID_BAR(); GRID_BAR(); GRID_BAR(); GRID_BAR(); GRID_BAR(); GRID_BAR(); GRID_BAR(); }
  }
  phase_final(F, a);
}
}

extern "C" void kernel_launch(void* const* d_in, const int* in_sizes, int n_in, void* d_out, int out_size, void* d_ws, size_t ws_size, hipStream_t stream) {
  using namespace mk;
  static int grid = 0;
  if (grid == 0) {
    int dev = 0, cus = 0, per_cu = 0;
    hipGetDevice(&dev); hipDeviceGetAttribute(&cus, hipDeviceAttributeMultiprocessorCount, dev);
    hipFuncSetAttribute((const void*)mk_kernel, hipFuncAttributeMaxDynamicSharedMemorySize, LDS_BYTES);
    hipOccupancyMaxActiveBlocksPerMultiprocessor(&per_cu, (const void*)mk_kernel, NTHR, LDS_BYTES);
    grid = per_cu >= 1 ? cus : -1;
  }
  if (grid < 0 || WS_END3 > ws_size) { fprintf(stderr, "kernel_launch: cannot run (grid %d, ws need %zu have %zu)\n", grid, (size_t)WS_END3, ws_size); (void)hipMemsetAsync(d_out, 0xFF, (size_t)out_size * 4, stream); return; }
  Args a{}; for (int i = 0; i < 28; ++i) a.in[i] = (const float*)d_in[i]; a.out = (float*)d_out; a.ws = (unsigned char*)d_ws;
  (void)hipMemsetAsync(d_ws, 0, CTL_BYTES, stream);
  void* args[] = {&a};
  hipError_t e = hipLaunchCooperativeKernel((const void*)mk_kernel, dim3(grid), dim3(NTHR), args, LDS_BYTES, stream);
  if (e != hipSuccess) fprintf(stderr, "kernel_launch: cooperative launch failed: %s (grid %d)\n", hipGetErrorString(e), grid);
}
```

```cpp
#include <hip/hip_runtime.h>
#include <cstdio>
#include <cstdint>
namespace g8 {
#define G8_LAS __attribute__((address_space(3)))
typedef unsigned short bf16_t;
typedef short bf16x8 __attribute__((ext_vector_type(8)));
typedef float f32x4 __attribute__((ext_vector_type(4)));
typedef float f32x2 __attribute__((ext_vector_type(2)));
typedef unsigned u32x4 __attribute__((ext_vector_type(4)));
typedef unsigned u32x2 __attribute__((ext_vector_type(2)));
typedef int i32x4 __attribute__((ext_vector_type(4)));
typedef int i32x8 __attribute__((ext_vector_type(8)));
constexpr int BM = 256, BK = 64, HALF = 128, HTB = HALF * BK * 2, STAGE_BYTES = 8 * HTB;

__host__ __device__ __forceinline__ int lds_byte(int r, int c) { const int st = (r >> 4) * 2 + (c >> 5), rr = r & 15, cc = c & 31, ob = rr * 64 + cc * 2; return st * 1024 + (ob ^ (((ob >> 9) & 1) << 5)); }
__host__ __device__ __forceinline__ void stage_rc(int b, int& R, int& C) { const int st = b / 1024, sb = b % 1024, swz = sb ^ (((sb >> 9) & 1) << 5); R = (st >> 1) * 16 + swz / 64; C = (st & 1) * 32 + (swz % 64) / 2; }
__host__ __device__ __forceinline__ int perm32(int rho) { const int n = rho >> 4, i = rho & 15; return 8 * (i >> 2) + 4 * n + (i & 3); }

struct Unit { const char* a; const char* b; const int* rows; int pm, pn, aux, nv; };

__device__ __forceinline__ unsigned cvt_pk_bf16(float lo, float hi) { unsigned r; asm volatile("v_cvt_pk_bf16_f32 %0, %1, %2" : "=v"(r) : "v"(lo), "v"(hi)); return r; }

template <class...> using void_tt = void;
template <class E, class = void> struct has_acc_init { static constexpr bool value = false; };
template <class E> struct has_acc_init<E, void_tt<decltype(&E::acc_init)>> { static constexpr bool value = true; };
template <class Epi, class Sched, bool ALIGN_EPI, bool GATHER = false, bool FP8 = false>
__device__ __forceinline__ void gemm_phase(G8_LAS unsigned char* lds, const int tid, const int ldaB, const int ldbB, const int K, const Sched& S, const Epi& E) {
    const int wid = __builtin_amdgcn_readfirstlane(tid >> 6), lane = tid & 63, wr = wid >> 2, wc = wid & 3, fr = lane & 15, fq = lane >> 4;
    const int nt = K / BK;
    unsigned voffA[2], voffB[2]; int Rr[2], Cc2[2];
#pragma unroll
    for (int i = 0; i < 2; ++i) { int R, C; stage_rc(tid * 16 + i * 8192, R, C); const int Rb = Epi::PERM ? ((R & ~31) + perm32(R & 31)) : R; Rr[i] = R; Cc2[i] = C * 2;
        voffA[i] = (unsigned)(R * ldaB + C * 2); voffB[i] = (unsigned)(Rb * ldbB + C * 2); }
    const size_t kstep = (size_t)(BK * 2);
    const size_t hstepA = (size_t)HALF * ldaB, hstepB = (size_t)HALF * ldbB;
    const unsigned ldsw = (unsigned)wid * 1024u;
    const G8_LAS unsigned char* abase = lds + (FP8 ? lds_byte(wr * 64 + fr, fq * 16) : lds_byte(wr * 64 + fr, fq * 8));
    const G8_LAS unsigned char* bbase = lds + 4 * HTB + (FP8 ? lds_byte(wc * 32 + fr, fq * 16) : lds_byte(wc * 32 + fr, fq * 8));
#define G8_SA(b, h) (((b) * 2 + (h)) * HTB)
#define G8_SB(b, h) ((4 + (b) * 2 + (h)) * HTB)
#define G8_STAGE(bufoff, gbase, voff) do { _Pragma("unroll") for (int _i = 0; _i < 2; ++_i) \
        __builtin_amdgcn_global_load_lds((const unsigned*)((const char*)(gbase) + (voff)[_i]), (G8_LAS unsigned*)(lds + (bufoff) + ldsw + _i * 8192), 16, 0, 0); } while (0)
#define G8_STAGE_A(bufoff, h, base, nx) do { if constexpr (GATHER) { unsigned vo_[2] = {(nx) ? gvN[h][0] : gvC[h][0], (nx) ? gvN[h][1] : gvC[h][1]}; G8_STAGE(bufoff, base, vo_); } else { G8_STAGE(bufoff, (base) + ((h) ? hstepA : 0), voffA); } } while (0)
#define G8_LDA(dst, b, h) do { if constexpr (FP8) { _Pragma("unroll") for (int m = 0; m < 4; ++m) { struct { bf16x8 lo, hi; } t_ = {*(const G8_LAS bf16x8*)(abase + (G8_SA(b, h) + m * 2048)), *(const G8_LAS bf16x8*)(abase + (G8_SA(b, h) + m * 2048 + 16))}; dst##8[m] = __builtin_bit_cast(i32x8, t_); } } \
      else { _Pragma("unroll") for (int m = 0; m < 4; ++m) _Pragma("unroll") for (int k = 0; k < 2; ++k) dst[m][k] = *(const G8_LAS bf16x8*)(abase + (G8_SA(b, h) + m * 2048 + k * 1024)); } } while (0)
#define G8_LDB(dst, b, h) do { if constexpr (FP8) { _Pragma("unroll") for (int n = 0; n < 2; ++n) { struct { bf16x8 lo, hi; } t_ = {*(const G8_LAS bf16x8*)(bbase + (((b) * 2 + (h)) * HTB + n * 2048)), *(const G8_LAS bf16x8*)(bbase + (((b) * 2 + (h)) * HTB + n * 2048 + 16))}; dst##8[n] = __builtin_bit_cast(i32x8, t_); } } \
      else { _Pragma("unroll") for (int n = 0; n < 2; ++n) _Pragma("unroll") for (int k = 0; k < 2; ++k) dst[n][k] = *(const G8_LAS bf16x8*)(bbase + (((b) * 2 + (h)) * HTB + n * 2048 + k * 1024)); } } while (0)
#define G8_MMA(ai, bj, At, Bt) do { __builtin_amdgcn_s_setprio(1); if constexpr (FP8) { _Pragma("unroll") for (int m = 0; m < 4; ++m) _Pragma("unroll") for (int n = 0; n < 2; ++n) \
        asm volatile("v_mfma_f32_16x16x128_f8f6f4 %0, %1, %2, %0" : "+v"(acc[ai][bj][m][n]) : "v"(Bt##8[n]), "v"(At##8[m])); } \
      else { _Pragma("unroll") for (int m = 0; m < 4; ++m) _Pragma("unroll") for (int n = 0; n < 2; ++n) _Pragma("unroll") for (int k = 0; k < 2; ++k) \
        acc[ai][bj][m][n] = __builtin_amdgcn_mfma_f32_16x16x32_bf16(Bt[n][k], At[m][k], acc[ai][bj][m][n], 0, 0, 0); } __builtin_amdgcn_s_setprio(0); } while (0)
#define G8_WAIT_V(n) asm volatile("s_waitcnt vmcnt(" #n ")" ::: "memory")
#define G8_WAIT_L(n) asm volatile("s_waitcnt lgkmcnt(" #n ")" ::: "memory")
#define G8_BAR __builtin_amdgcn_s_barrier()
#define G8_SCHED __builtin_amdgcn_sched_barrier(0)
    Unit cur, nxt; int ui = 0;
    if (!S.next(0, cur)) return;
    f32x4 acc[2][2][4][2];
#pragma unroll
    for (int a = 0; a < 2; ++a)
#pragma unroll
        for (int b = 0; b < 2; ++b)
#pragma unroll
            for (int m = 0; m < 4; ++m)
#pragma unroll
                for (int n = 0; n < 2; ++n) acc[a][b][m][n] = (f32x4){0.f, 0.f, 0.f, 0.f};
    if constexpr (has_acc_init<Epi>::value) E.acc_init(acc, cur, wr, wc, fr, fq);
    bf16x8 At[4][2], B0[2][2], B1[2][2]; i32x8 At8[4], B08[2], B18[2];
    int sc1f8 = 0x7F7F7F7F; if constexpr (FP8) asm volatile("" : "+v"(sc1f8));
    const char* cA = cur.a; const char* cB = cur.b;
    S.a_ready(cur, tid);
    unsigned gvC[2][2], gvN[2][2];
    if constexpr (GATHER) {
#pragma unroll
        for (int h = 0; h < 2; ++h)
#pragma unroll
            for (int i = 0; i < 2; ++i) { gvC[h][i] = (h * 128 + Rr[i] < cur.nv ? (unsigned)cur.rows[h * 128 + Rr[i]] : 0u) * (unsigned)ldaB + (unsigned)Cc2[i]; gvN[h][i] = gvC[h][i]; } }
    G8_STAGE(G8_SB(0, 0), cB, voffB); G8_STAGE(G8_SB(0, 1), cB + hstepB, voffB); G8_STAGE_A(G8_SA(0, 0), 0, cA, false); G8_STAGE_A(G8_SA(0, 1), 1, cA, false);
    if (wr == 1) G8_BAR;
    G8_WAIT_V(2); G8_BAR;
    G8_STAGE(G8_SB(1, 0), cB + kstep, voffB); G8_STAGE_A(G8_SA(1, 0), 0, cA + kstep, false); G8_STAGE(G8_SB(1, 1), cB + hstepB + kstep, voffB);
    G8_WAIT_V(6); G8_BAR;
#pragma unroll 1
    for (;;) {
        const bool has_next = S.next(ui + 1, nxt);
        const char* nA = has_next ? nxt.a : cA; const char* nB = has_next ? nxt.b : cB;
        if constexpr (GATHER) { if (has_next) {
#pragma unroll
            for (int h = 0; h < 2; ++h)
#pragma unroll
                for (int i = 0; i < 2; ++i) gvN[h][i] = (h * 128 + Rr[i] < nxt.nv ? (unsigned)nxt.rows[h * 128 + Rr[i]] : 0u) * (unsigned)ldaB + (unsigned)Cc2[i]; } }
#pragma unroll 1
        for (int t = 0; t < nt; t += 2) {
            const bool last = (t == nt - 2);
            if (last && has_next) S.a_ready(nxt, tid);
            const char* a1 = cA + (size_t)(t + 1) * kstep;
            const char* a2 = last ? nA : cA + (size_t)(t + 2) * kstep; const char* b2 = last ? nB : cB + (size_t)(t + 2) * kstep;
            const char* a3 = a2 + kstep; const char* b3 = b2 + kstep;
            G8_LDB(B0, 0, 0); G8_LDB(B1, 0, 1); G8_SCHED; G8_LDA(At, 0, 0); G8_STAGE_A(G8_SA(1, 1), 1, a1, false);
            G8_WAIT_V(8); G8_WAIT_L(0); G8_BAR; G8_MMA(0, 0, At, B0); G8_MMA(0, 1, At, B1); G8_BAR; G8_SCHED;
            G8_LDA(At, 0, 1); G8_STAGE(G8_SB(0, 0), b2, voffB); G8_STAGE(G8_SB(0, 1), b2 + hstepB, voffB); G8_STAGE_A(G8_SA(0, 0), 0, a2, last);
            G8_WAIT_V(8); G8_WAIT_L(0); G8_BAR; G8_MMA(1, 0, At, B0); G8_MMA(1, 1, At, B1); G8_BAR; G8_SCHED;
            G8_LDB(B0, 1, 0); G8_LDB(B1, 1, 1); G8_SCHED; G8_LDA(At, 1, 0); G8_STAGE_A(G8_SA(0, 1), 1, a2, last);
            G8_WAIT_V(8); G8_WAIT_L(0); G8_BAR; G8_MMA(0, 0, At, B0); G8_MMA(0, 1, At, B1); G8_BAR; G8_SCHED;
            G8_LDA(At, 1, 1); G8_STAGE(G8_SB(1, 0), b3, voffB); G8_STAGE(G8_SB(1, 1), b3 + hstepB, voffB); G8_STAGE_A(G8_SA(1, 0), 0, a3, last);
            G8_WAIT_V(8); G8_WAIT_L(0); G8_BAR; G8_MMA(1, 0, At, B0); G8_MMA(1, 1, At, B1); G8_BAR; G8_SCHED;
        }
        if constexpr (FP8) asm volatile("s_nop 15\n\ts_nop 7" ::: "memory");
        if constexpr (ALIGN_EPI) { if (wr == 0) G8_BAR; }
        E(acc, cur, wr, wc, fr, fq);
        if (!has_next) break;
#pragma unroll
        for (int a = 0; a < 2; ++a)
#pragma unroll
            for (int b = 0; b < 2; ++b)
#pragma unroll
                for (int m = 0; m < 4; ++m)
#pragma unroll
                    for (int n = 0; n < 2; ++n) acc[a][b][m][n] = (f32x4){0.f, 0.f, 0.f, 0.f};
        if constexpr (has_acc_init<Epi>::value) E.acc_init(acc, nxt, wr, wc, fr, fq);
        cur = nxt; cA = nA; cB = nB; ++ui;
        if constexpr (GATHER) {
#pragma unroll
            for (int h = 0; h < 2; ++h)
#pragma unroll
                for (int i = 0; i < 2; ++i) gvC[h][i] = gvN[h][i]; }
        if constexpr (ALIGN_EPI) { if (wr == 1) G8_BAR; }
    }
    G8_WAIT_V(0);
    if constexpr (!ALIGN_EPI) { if (wr == 0) G8_BAR; }
    G8_BAR;
#undef G8_SA
#undef G8_SB
#undef G8_STAGE
#undef G8_STAGE_A
#undef G8_LDA
#undef G8_LDB
#undef G8_MMA
#undef G8_WAIT_V
#undef G8_WAIT_L
#undef G8_BAR
#undef G8_SCHED
}
}
namespace mk {
using namespace g8;
constexpr int NB = 8, NCTX = 256, NLAT = 2048, NTOK = NCTX + NLAT, T = NB * NTOK, D = 1024, L = 4, NE = 32;
constexpr int NWAVES = 8, NTHR = 512;
constexpr float EPS = 1e-6f;
constexpr int NROWT = T / 256;
constexpr int ZBW = 2304, ZB_AU = 0, ZB_AV = 256, ZB_MQ = 512, ZB_CB = 768, ZB_CC = 1024, ZB_CX = 1280, ZB_GQ = 1536, ZB_GK = 1792, ZB_GV = 1920, ZB_MKV = 2048, ZB_KPE = 2176;
constexpr int DIN = 2208;
constexpr int RING_BYTES = 131072, MISC_OFF = 153600, XSCR_OFF = MISC_OFF + 1024, LDS_BYTES = 163840 - 4096;
constexpr size_t MiB = 1u << 20;
constexpr size_t al(size_t x) { return (x + 255) / 256 * 256; }
constexpr size_t WS_CTL = 0, CTL_BYTES = 1 * MiB;
constexpr size_t WS_MOD = WS_CTL + CTL_BYTES, SZ_MOD = al((size_t)L * 9 * 6 * D * 4);
constexpr size_t WS_WIN = WS_MOD + SZ_MOD, SZ_WIN1 = (size_t)ZBW * D * 2;
constexpr size_t WS_WG = WS_WIN + L * SZ_WIN1, SZ_WG1 = (size_t)4096 * D * 2;
constexpr size_t WS_WB = WS_WG + L * SZ_WG1, SZ_WB1 = (size_t)4 * 1024 * 256 * 2;
constexpr size_t WS_WOUT = WS_WB + L * SZ_WB1, SZ_WOUT1 = (size_t)D * D * 2;
constexpr size_t WS_WUQ = WS_WOUT + L * SZ_WOUT1, SZ_WUQ1 = (size_t)512 * 256 * 2;
constexpr size_t WS_WUKV = WS_WUQ + L * SZ_WUQ1, SZ_WUKV1 = (size_t)512 * 256 * 2;
constexpr size_t WS_WSGU = WS_WUKV + L * SZ_WUKV1, SZ_WSGU1 = (size_t)4 * 128 * 128 * 2;
constexpr size_t WS_WGU = WS_WSGU + L * SZ_WSGU1, SZ_WGU1 = (size_t)NE * 512 * D * 2;
constexpr size_t WS_WDN = WS_WGU + L * SZ_WGU1, SZ_WDN1 = (size_t)NE * D * 256 * 2;
constexpr int P8 = 1152;
constexpr size_t WS_WG8 = WS_WDN + L * SZ_WDN1, SZ_WG81 = (size_t)4096 * P8;
constexpr size_t WS_HS = WS_WG8 + L * SZ_WG81, SZ_HS = (size_t)T * D * 2;
constexpr size_t WS_HN = WS_HS + SZ_HS, SZ_HN = (size_t)T * D * 2;
constexpr size_t WS_HN8 = WS_HN + SZ_HN, SZ_HN8 = (size_t)T * P8;
constexpr size_t WS_RSS = WS_HN8 + SZ_HN8, SZ_RSS = (size_t)T * 2 * 4 * 4;
constexpr int RTW_PITCH = 2064; constexpr size_t SZ_RTW1 = al((size_t)72 * RTW_PITCH);
constexpr size_t WS_RTW = WS_RSS + SZ_RSS;
constexpr size_t WS_ARENA = WS_RTW + L * SZ_RTW1;

#define GAS __attribute__((address_space(1)))
#define LAS __attribute__((address_space(3)))
typedef unsigned short bf16;
typedef unsigned v4u __attribute__((ext_vector_type(4)));
typedef unsigned v2u __attribute__((ext_vector_type(2)));
#define LDS_WAIT() asm volatile("s_waitcnt lgkmcnt(0)" ::: "memory")
#define VM_WAIT() asm volatile("s_waitcnt vmcnt(0)" ::: "memory")
__device__ __forceinline__ unsigned f2bf(float f) { unsigned u = __builtin_bit_cast(unsigned, f); return (u + 0x7fffu + ((u >> 16) & 1u)) >> 16; }
__device__ __forceinline__ unsigned pk2(float lo, float hi) { return f2bf(lo) | (f2bf(hi) << 16); }
__device__ __forceinline__ float bf2f(unsigned short h) { return __builtin_bit_cast(float, (unsigned)h << 16); }
__device__ __forceinline__ float bflo(unsigned w) { return __builtin_bit_cast(float, w << 16); }
__device__ __forceinline__ float bfhi(unsigned w) { return __builtin_bit_cast(float, w & 0xffff0000u); }
template <int CTRL> __device__ __forceinline__ float dppf(float v) { return __builtin_bit_cast(float, __builtin_amdgcn_update_dpp(0, __builtin_bit_cast(int, v), CTRL, 0xF, 0xF, true)); }
__device__ __forceinline__ unsigned opq(unsigned x) { asm volatile("" : "+v"(x)); return x; }
__device__ __forceinline__ float sum_x16(float v) { const unsigned a = __float_as_uint(v); auto rr = __builtin_amdgcn_permlane16_swap(a, opq(a), false, false); const unsigned r0 = rr[0], r1 = rr[1]; return __uint_as_float(r0) + __uint_as_float(r1); }
__device__ __forceinline__ float sum_x32(float v) { const unsigned a = __float_as_uint(v); auto rr = __builtin_amdgcn_permlane32_swap(a, opq(a), false, false); const unsigned r0 = rr[0], r1 = rr[1]; return __uint_as_float(r0) + __uint_as_float(r1); }
__device__ __forceinline__ float get_x16(float v, int lane) { const unsigned a = __float_as_uint(v); auto rr = __builtin_amdgcn_permlane16_swap(a, opq(a), false, false); const unsigned r0 = rr[0], r1 = rr[1]; return __uint_as_float((lane & 16) ? r0 : r1); }
__device__ __forceinline__ float get_x32(float v, int lane) { const unsigned a = __float_as_uint(v); auto rr = __builtin_amdgcn_permlane32_swap(a, opq(a), false, false); const unsigned r0 = rr[0], r1 = rr[1]; return __uint_as_float((lane & 32) ? r0 : r1); }
__device__ __forceinline__ float wave_sum(float v) {
  v += dppf<0xB1>(v);
  v += dppf<0x4E>(v);
  v += dppf<0x141>(v);
  v += dppf<0x140>(v);
  v = sum_x16(v);
  return sum_x32(v);
}
__device__ __forceinline__ float siluf(float x) { return x / (1.f + __expf(-x)); }
__device__ __forceinline__ float sigmoidf(float x) { return 1.f / (1.f + __expf(-x)); }
__device__ __forceinline__ float gelu_tanh(float x) { const float u = 0.7978845608028654f * (x + 0.044715f * x * x * x); const float e = __expf(2.f * u); return x - x * __builtin_amdgcn_rcpf(e + 1.f); }

#define XB_TMO      128
#define XB_XCNT(j)  (256  + 64 * (j))
#define XB_XSUB(j)  (1280 + 64 * (j))
#define XB_XGEN(j)  (2304 + 64 * (j))
#define XB_TOP      3328
#define XB_TOPGEN   3392
#define XCD_BAR_WORDS 3456
#define XB_SPIN_CAP (1u << 18)
__device__ __forceinline__ unsigned xb_ld(unsigned* p)              { return __hip_atomic_load(p, __ATOMIC_RELAXED, __HIP_MEMORY_SCOPE_AGENT); }
__device__ __forceinline__ unsigned xb_add(unsigned* p, unsigned v) { return __hip_atomic_fetch_add(p, v, __ATOMIC_RELAXED, __HIP_MEMORY_SCOPE_AGENT); }
__device__ __forceinline__ unsigned xb_xcc_id() { return (unsigned)__builtin_amdgcn_s_getreg((3 << 11) | 20) & 0xFu; }
#define XB_SPIN(cond, bar) do { unsigned _sp = 0; while (cond) { __builtin_amdgcn_s_sleep(1); \
    if ((++_sp & 255u) == 0u) { if (xb_ld(&(bar)[XB_TMO])) break; if (_sp > XB_SPIN_CAP) { atomicAdd(&(bar)[XB_TMO], 1u); break; } } } } while (0)
struct XcdBarrier { unsigned* bar; unsigned x; volatile LAS unsigned* st; };
__device__ __forceinline__ XcdBarrier xcd_barrier_post(unsigned* bar, volatile LAS unsigned* st, const bool leader) {
    XcdBarrier b; b.bar = bar; b.x = xb_xcc_id(); b.st = st;
    if (leader) (void)xb_add(&bar[XB_XCNT(b.x)], 1u);
    return b;
}
__device__ __forceinline__ void xcd_barrier_complete(unsigned* bar, unsigned x, unsigned& nloc, unsigned& nx) {
    const unsigned G = gridDim.x * gridDim.y * gridDim.z;
    unsigned sum, cnt, mine, sp = 0u;
    for (;;) {
        sum = 0u; cnt = 0u; mine = 0u;
#pragma unroll
        for (unsigned j = 0; j < 16; ++j) { const unsigned c = xb_ld(&bar[XB_XCNT(j)]); sum += c; cnt += (c > 0u) ? 1u : 0u; mine = (j == x) ? c : mine; }
        if (sum == G) break;
        __builtin_amdgcn_s_sleep(1);
        if ((++sp & 255u) == 0u) { if (xb_ld(&bar[XB_TMO])) break; if (sp > XB_SPIN_CAP) { atomicAdd(&bar[XB_TMO], 1u); break; } }
    }
    nloc = mine > 0u ? mine : 1u; nx = cnt > 0u ? cnt : 1u;
}
__device__ __forceinline__ void xcd_barrier(const XcdBarrier& b, const bool leader) {
    asm volatile("s_waitcnt vmcnt(0)" ::: "memory");
    __syncthreads();
    if (leader) {
        unsigned* bar = b.bar;
        __builtin_amdgcn_s_waitcnt(0);
        unsigned nloc = b.st[0], nx = b.st[1];
        if (nloc == 0u) { xcd_barrier_complete(bar, b.x, nloc, nx); b.st[0] = nloc; b.st[1] = nx; }
        const unsigned old = xb_add(&bar[XB_XSUB(b.x)], 1u);
        const unsigned gen = old / nloc;
        if (old + 1u == (gen + 1u) * nloc) {
            __builtin_amdgcn_fence(__ATOMIC_RELEASE, "agent");
            asm volatile("s_waitcnt vmcnt(0)" ::: "memory");
            const unsigned og = xb_add(&bar[XB_TOP], 1u);
            const unsigned tg = og / nx;
            if (og + 1u == (tg + 1u) * nx) {
#pragma unroll
                for (unsigned j = 0; j < 16; ++j) (void)xb_add(&bar[XB_XGEN(j)], 1u); }
        }
        XB_SPIN(xb_ld(&bar[XB_XGEN(b.x)]) == gen, bar);
        __builtin_amdgcn_fence(__ATOMIC_ACQUIRE, "agent");
        asm volatile("s_waitcnt vmcnt(0)" ::: "memory");
    }
    __syncthreads();
}

struct Args { const float* in[28]; float* out; unsigned char* ws; int phase, layer, flag, pad; };
struct Ctx {
  LAS unsigned char* lds; GAS unsigned char* ws; int tid, lane, wave, vcu, G;
};

__device__ __forceinline__ void refresh_ctx(Ctx& F, const Args& A) {
  unsigned char* w_ = A.ws; asm volatile("" : "+s"(w_)); F.ws = (GAS unsigned char*)w_;
  int wv_ = F.wave; asm volatile("" : "+s"(wv_)); F.wave = wv_; unsigned z_ = 0u; asm volatile("" : "+v"(z_)); const int l_ = (int)__builtin_amdgcn_mbcnt_hi(~0u, __builtin_amdgcn_mbcnt_lo(~0u, z_)); F.lane = l_; F.tid = wv_ * 64 + l_;
}
struct TileOrder {
  int nM, nN, nwg, G, c, skip, wgm;
  __device__ void init(int nM_, int nN_, int G_, int c_, int skip_ = 0, int wgm_ = 8) { nM = nM_; nN = nN_; nwg = nM * nN; G = G_; c = c_; skip = skip_; wgm = wgm_; }
  __device__ __forceinline__ bool tile(int i, int& pm, int& pn) const {
    const long Lx = (long)i * G + c; if (Lx >= nwg) return false;
    int wgid = (int)Lx; { const int q = nwg / 8, r = nwg % 8, xcd = wgid % 8, off = wgid / 8; wgid = (xcd < r ? xcd * (q + 1) : r * (q + 1) + (xcd - r) * q) + off; }
    const int WGM = wgm; const int nig = WGM * nN, gid = wgid / nig, fm = gid * WGM, gsz = (nM - fm) < WGM ? (nM - fm) : WGM;
    pm = fm + ((wgid % nig) % gsz); pn = (wgid % nig) / gsz; if (skip) pm += pm / 8 + 1; return true;
  }
};
struct PlainSched {
  TileOrder o; const char* A; const char* B; size_t aTile, bTile;
  __device__ __forceinline__ bool next(int i, Unit& u) const { int pm, pn; if (!o.tile(i, pm, pn)) return false; u.pm = pm; u.pn = pn; u.aux = 0; u.a = A + (size_t)pm * aTile; u.b = B + (size_t)pn * bTile; return true; }
  __device__ __forceinline__ void a_ready(const Unit&, int) const {}
};
constexpr int STG_PITCH = 528;
template <bool SC1> __device__ __forceinline__ void store_tile_rows(const f32x4 (&acc)[2][2][4][2], LAS unsigned char* stg, bf16* O, int obytes, int ldc, int row_base, int col_base, int wr, int wc, int fr, int fq) {
  const int tid = (wr * 4 + wc) * 64 + fq * 16 + fr;
  const __amdgpu_buffer_rsrc_t rs = __builtin_amdgcn_make_buffer_rsrc(O, 0, obytes, 0x00020000);
  LAS unsigned char* wp = stg + (wr * 16 + fr) * STG_PITCH + (wc * 32 + fq * 8) * 2; const LAS unsigned char* rp = stg + (tid >> 5) * STG_PITCH + (tid & 31) * 16;
#pragma unroll
  for (int ai = 0; ai < 2; ++ai)
#pragma unroll
    for (int m = 0; m < 4; ++m) {
#pragma unroll
      for (int bj = 0; bj < 2; ++bj) { const f32x4 v0 = acc[ai][bj][m][0], v1 = acc[ai][bj][m][1];
        v4u w; w.x = cvt_pk_bf16(v0[0], v0[1]); w.y = cvt_pk_bf16(v0[2], v0[3]); w.z = cvt_pk_bf16(v1[0], v1[1]); w.w = cvt_pk_bf16(v1[2], v1[3]);
        *(LAS v4u*)(wp + bj * 256) = w; }
      asm volatile("s_waitcnt lgkmcnt(0)" ::: "memory"); __builtin_amdgcn_s_barrier(); asm volatile("" ::: "memory");
#pragma unroll
      for (int ps = 0; ps < 2; ++ps) { const int rl = ps * 16 + (tid >> 5); const v4u w = *(const LAS v4u*)(rp + ps * 16 * STG_PITCH);
        const int off = ((row_base + ai * 128 + (rl >> 4) * 64 + m * 16 + (rl & 15)) * ldc + col_base + (tid & 31) * 8) * 2;
        __builtin_amdgcn_raw_buffer_store_b128(w, rs, off, 0, SC1 ? 16 : 2); }
      asm volatile("s_waitcnt lgkmcnt(0)" ::: "memory"); __builtin_amdgcn_s_barrier(); asm volatile("" ::: "memory"); }
}
struct EpiStoreBf16 {
  static constexpr bool PERM = true;
  bf16* O; int ldc; int obytes; LAS unsigned char* stg;
  __device__ __forceinline__ void operator()(const f32x4 (&acc)[2][2][4][2], const Unit& u, int wr, int wc, int fr, int fq) const {
    store_tile_rows<false>(acc, stg, O, obytes, ldc, u.pm * 256, u.pn * 256, wr, wc, fr, fq);
  }
};

__device__ __forceinline__ int zmap(int n) {
  if (n < 768) return n;
  if (n < 896) return ZB_MKV + (n - 768);
  if (n < 928) return ZB_KPE + (n - 896);
  if (n < 1184) return ZB_CB + (n - 928);
  if (n < 1440) return ZB_CC + (n - 1184);
  if (n < 1696) return ZB_CX + (n - 1440);
  if (n < 1952) return ZB_GQ + (n - 1696);
  if (n < 2080) return ZB_GK + (n - 1952);
  return ZB_GV + (n - 2080);
}
__device__ __forceinline__ int gmap(int i, int c) { const int jp = c >> 6, cl = c & 63, wc = cl >> 4, h = (cl >> 3) & 1, n = (cl >> 2) & 1, e = cl & 3, bj = i >> 1, fq = 2 * h + (i & 1); return 256 * jp + 128 * bj + 32 * wc + 16 * n + 4 * fq + e; }
__device__ __forceinline__ int uqmap(int n) { const int h = n / 96, dd = n % 96; if (dd < 64) return 64 * h + dd; const int d = dd - 64; return 256 + 32 * h + 8 * ((d >> 2) & 3) + 4 * (d >> 4) + (d & 3); }
__device__ __forceinline__ int gumap(int n) { const int up = n >> 8, j = n & 255; return 256 * (j >> 7) + 128 * up + (j & 127); }

struct PrepItem { const float* W; bf16* dst; const float* kscale; int ldw, N, ldd, k0, n0, mt, mp; };
__device__ __forceinline__ int prep_map(int mt, int mp, int n) { return mt == 0 ? n : mt == 1 ? zmap(n) : mt == 2 ? gmap(mp, n) : mt == 3 ? uqmap(n) : gumap(n); }
__device__ __forceinline__ PrepItem prep_decode(const Args& A, unsigned char* ws, int it) {
  constexpr int I_IN = 16 * 9, I_G = 4 * 16 * 4, I_B = 4 * 4 * 4, I_O = 16 * 4, I_UQ = 4 * 2, I_UKV = 2 * 2, I_GU = NE * 16 * 2, I_DN = NE * 4 * 4;
  constexpr int I_L = I_IN + I_G + I_B + I_O + I_UQ + I_UKV + I_GU + I_DN;
  PrepItem p; const int l = it / I_L; int r = it % I_L; p.kscale = nullptr; p.mt = 0; p.mp = 0;
  if (r < I_IN) { const int kb = r / 9, nb = r % 9; p.W = A.in[6] + (size_t)l * D * DIN; p.ldw = DIN; p.N = DIN; p.dst = (bf16*)(ws + WS_WIN + l * SZ_WIN1); p.ldd = D; p.k0 = kb * 64; p.n0 = nb * 256; p.mt = 1; return p; } r -= I_IN;
  if (r < I_G) { const int i = r / 64, rr = r % 64, kb = rr / 4, nb = rr % 4; p.W = A.in[17] + ((size_t)l * 4 + i) * D * D; p.ldw = D; p.N = D; p.dst = (bf16*)(ws + WS_WG8 + l * SZ_WG81); p.ldd = P8; p.k0 = kb * 64; p.n0 = nb * 256; p.mt = 2; p.mp = i; return p; } r -= I_G;
  if (r < I_B) { const int i = r / 16, rr = r % 16, kb = rr / 4, nb = rr % 4; p.W = A.in[19] + ((size_t)l * 4 + i) * 256 * D; p.ldw = D; p.N = D; p.dst = (bf16*)(ws + WS_WB + l * SZ_WB1) + (size_t)i * 1024 * 256; p.ldd = 256; p.k0 = kb * 64; p.n0 = nb * 256; return p; } r -= I_B;
  if (r < I_O) { const int kb = r / 4, nb = r % 4; p.W = A.in[20] + (size_t)l * D * D; p.ldw = D; p.N = D; p.dst = (bf16*)(ws + WS_WOUT + l * SZ_WOUT1); p.ldd = D; p.k0 = kb * 64; p.n0 = nb * 256; return p; } r -= I_O;
  if (r < I_UQ) { const int kb = r / 2, nb = r % 2; p.W = A.in[11] + (size_t)l * 256 * 384; p.ldw = 384; p.N = 384; p.dst = (bf16*)(ws + WS_WUQ + l * SZ_WUQ1); p.ldd = 256; p.kscale = A.in[10] + l * 256; p.k0 = kb * 64; p.n0 = nb * 256; p.mt = 3; return p; } r -= I_UQ;
  if (r < I_UKV) { const int kb = r / 2, nb = r % 2; p.W = A.in[13] + (size_t)l * 128 * 512; p.ldw = 512; p.N = 512; p.dst = (bf16*)(ws + WS_WUKV + l * SZ_WUKV1); p.ldd = 256; p.kscale = A.in[12] + l * 128; p.k0 = kb * 64; p.n0 = nb * 256; return p; } r -= I_UKV;
  if (r < I_GU) { const int e = r / 32, rr = r % 32, kb = rr / 2, nb = rr % 2; p.W = A.in[25] + ((size_t)l * NE + e) * D * 512; p.ldw = 512; p.N = 512; p.dst = (bf16*)(ws + WS_WGU + l * SZ_WGU1) + (size_t)e * 512 * D; p.ldd = D; p.k0 = kb * 64; p.n0 = nb * 256; p.mt = 4; return p; } r -= I_GU;
  { const int e = r / 16, rr = r % 16, kb = rr / 4, nb = rr % 4; p.W = A.in[26] + ((size_t)l * NE + e) * 256 * D; p.ldw = D; p.N = D; p.dst = (bf16*)(ws + WS_WDN + l * SZ_WDN1) + (size_t)e * D * 256; p.ldd = 256; p.k0 = kb * 64; p.n0 = nb * 256; return p; }
}
__device__ __forceinline__ void prep_load(const PrepItem& p, int tid, float4 (&v)[8]) {
#pragma unroll
  for (int i = 0; i < 8; ++i) { const int idx = tid + i * NTHR, kk = idx >> 6, c4 = (idx & 63) * 4; v[i] = make_float4(0.f, 0.f, 0.f, 0.f);
    if (p.n0 + c4 < p.N) v[i] = *(const float4*)(p.W + (size_t)(p.k0 + kk) * p.ldw + p.n0 + c4); }
}
__device__ __forceinline__ void phase_prep(Ctx& F, const Args& A) {
  const int lane = F.lane;
  const float* w_sgu = A.in[8];
  { const float* c = A.in[1]; const float* c_ctx = A.in[3]; const float* w_ada = A.in[4]; const float* b_ada = A.in[5]; float* mod = (float*)(F.ws + WS_MOD);
    LAS float* sil = (LAS float*)F.lds; LAS float* red = sil + 9 * D;
    if (F.vcu < L * 96) {
      for (int i = F.tid; i < 9 * D; i += NTHR) { const int r = i / D, k = i % D; sil[i] = siluf(r < 8 ? c[r * D + k] : c_ctx[k]); }
      __syncthreads();
      for (int it = F.vcu; it < L * 96; it += F.G) { const int l = it / 96, n = (it % 96) * 64 + lane; float acc[9];
#pragma unroll
        for (int r = 0; r < 9; ++r) acc[r] = 0.f;
        const float* w = w_ada + (size_t)l * D * 6 * D + n;
#pragma unroll 1
        for (int k0 = 0; k0 < 128; k0 += 32) { float wv32[32];
#pragma unroll
          for (int u = 0; u < 32; ++u) wv32[u] = w[(size_t)(F.wave * 128 + k0 + u) * 6 * D];
#pragma unroll
          for (int u = 0; u < 32; ++u) { const int k = F.wave * 128 + k0 + u; const float wv = wv32[u];
#pragma unroll
            for (int r = 0; r < 9; ++r) acc[r] += sil[r * D + k] * wv; } }
        __syncthreads();
#pragma unroll
        for (int r = 0; r < 9; ++r) red[(F.wave * 9 + r) * 64 + lane] = acc[r];
        __syncthreads();
        if (F.wave == 0) { const float bv = b_ada[l * 6 * D + n];
#pragma unroll
          for (int r = 0; r < 9; ++r) { float s = 0.f;
#pragma unroll
            for (int w8 = 0; w8 < 8; ++w8) s += red[(w8 * 9 + r) * 64 + lane];
            mod[((size_t)l * 9 + r) * 6 * D + n] = s + bv; } }
      }
      __syncthreads(); } }
  constexpr int I_LT = 16 * 9 + 4 * 16 * 4 + 4 * 4 * 4 + 16 * 4 + 4 * 2 + 2 * 2 + NE * 16 * 2 + NE * 4 * 4;
  { LAS float* scr = (LAS float*)F.lds; const int tid = F.tid;
    constexpr int NIT = L * I_LT, XR = 30;
    const bool split = (F.G == 256); const int vcu = F.vcu, G = F.G;
    auto item_of = [&](int j) -> int { int t; if (!split) t = vcu + j * G; else if (j < XR) t = j * 256 + vcu; else t = vcu < 128 ? NIT : XR * 256 + (j - XR) * 128 + (vcu - 128); return t < NIT ? t : NIT; };
    int jr = 0; int it = item_of(0); float4 v[8]; PrepItem cur;
    if (it < L * I_LT) { cur = prep_decode(A, (unsigned char*)F.ws, it); prep_load(cur, tid, v); }
    while (it < L * I_LT) {
#pragma unroll
      for (int i = 0; i < 8; ++i) { const int idx = tid + i * NTHR, kk = idx >> 6, c4 = (idx & 63) * 4; float4 x = v[i];
        if (cur.kscale) { const float s = cur.kscale[cur.k0 + kk]; x.x *= s; x.y *= s; x.z *= s; x.w *= s; }
        *(LAS f32x4*)(scr + kk * 260 + (c4 ^ (((kk >> 3) & 7) << 2))) = (f32x4){x.x, x.y, x.z, x.w}; }
      const int nit = item_of(++jr); PrepItem nxt = cur;
      if (nit < L * I_LT) { nxt = prep_decode(A, (unsigned char*)F.ws, nit); prep_load(nxt, tid, v); }
      __syncthreads();
#pragma unroll
      for (int i = 0; i < 4; ++i) { const int idx = tid + i * NTHR, n = idx >> 3, c = idx & 7; const LAS float* s = scr + (8 * c) * 260 + (n ^ (c << 2));
        if (cur.n0 + n < cur.N) {
          if (cur.mt == 2) { int w0 = 0, w1 = 0;
            w0 = __builtin_amdgcn_cvt_pk_fp8_f32(32.f * s[0 * 260], 32.f * s[1 * 260], w0, false); w0 = __builtin_amdgcn_cvt_pk_fp8_f32(32.f * s[2 * 260], 32.f * s[3 * 260], w0, true);
            w1 = __builtin_amdgcn_cvt_pk_fp8_f32(32.f * s[4 * 260], 32.f * s[5 * 260], w1, false); w1 = __builtin_amdgcn_cvt_pk_fp8_f32(32.f * s[6 * 260], 32.f * s[7 * 260], w1, true);
            v2u o; o.x = (unsigned)w0; o.y = (unsigned)w1; *(v2u*)((unsigned char*)cur.dst + (size_t)prep_map(cur.mt, cur.mp, cur.n0 + n) * cur.ldd + cur.k0 + 8 * c) = o; }
          else { v4u o; o.x = pk2(s[0 * 260], s[1 * 260]); o.y = pk2(s[2 * 260], s[3 * 260]); o.z = pk2(s[4 * 260], s[5 * 260]); o.w = pk2(s[6 * 260], s[7 * 260]);
            *(v4u*)(cur.dst + (size_t)prep_map(cur.mt, cur.mp, cur.n0 + n) * cur.ldd + cur.k0 + 8 * c) = o; } } }
      __syncthreads();
      cur = nxt; it = nit;
    }
  }
  const size_t gt = (size_t)F.vcu * NTHR + F.tid, NGT = (size_t)F.G * NTHR;
  for (size_t i = gt; i < (size_t)L * 36 * 1024; i += NGT) { const int l = (int)(i / (36 * 1024)), j = (int)(i / 1024) % 36, kk = (int)(i % 1024);
    const float w = j < 4 ? A.in[21][(size_t)l * D * 4 + kk * 4 + j] : A.in[23][(size_t)l * D * 32 + kk * 32 + (j - 4)];
    const unsigned h = f2bf(w); const unsigned lo = f2bf(w - __uint_as_float(h << 16));
    unsigned char* base = (unsigned char*)F.ws + WS_RTW + (size_t)l * SZ_RTW1 + (size_t)j * RTW_PITCH + kk * 2;
    *(unsigned short*)base = (unsigned short)h; *(unsigned short*)(base + 36 * RTW_PITCH) = (unsigned short)lo; }
  for (int l = 0; l < L; ++l) {
    v4u z4 = {0u, 0u, 0u, 0u};
    { v4u* p = (v4u*)(F.ws + WS_WIN + l * SZ_WIN1 + (size_t)DIN * D * 2); for (size_t i = gt; i < (size_t)(ZBW - DIN) * D * 2 / 16; i += NGT) p[i] = z4; }
    { v4u* p = (v4u*)(F.ws + WS_WUQ + l * SZ_WUQ1 + (size_t)384 * 256 * 2); for (size_t i = gt; i < (size_t)128 * 256 * 2 / 16; i += NGT) p[i] = z4; }
    { for (size_t i = gt; i < (size_t)512 * 16; i += NGT) { const size_t row = i / 16, c = i % 16; *(v4u*)(F.ws + WS_WUKV + l * SZ_WUKV1 + row * 512 + 256 + c * 16) = z4; } }
    { const float* s = w_sgu + (size_t)l * 4 * 128 * 128; bf16* d = (bf16*)(F.ws + WS_WSGU + l * SZ_WSGU1); for (size_t i = gt; i < (size_t)4 * 128 * 128 / 2; i += NGT) ((unsigned*)d)[i] = pk2(s[2 * i], s[2 * i + 1]); }
  }
}
}
namespace mk {
constexpr int CW_CNT = 8192, CW_PANEL = 32768, CW_TILE = 65536, CW_BAR_TMO = 16384 + 128;
constexpr size_t SZ_ZB_BYTES = (size_t)T * ZBW * 2;
struct EpiZ {
  static constexpr bool PERM = true;
  bf16* O; float* rss; int mode; LAS unsigned char* stg;
  __device__ __forceinline__ void operator()(const f32x4 (&acc)[2][2][4][2], const Unit& u, int wr, int wc, int fr, int fq) const {
    if (mode) return;
    const int row0 = u.pm * 256 + wr * 64 + fr;
    store_tile_rows<false>(acc, stg, O, (int)SZ_ZB_BYTES, ZBW, u.pm * 256, u.pn * 256, wr, wc, fr, fq);
    if (u.pn == 2 || u.pn == 8) { const int which = u.pn == 2 ? 0 : 1;
#pragma unroll
      for (int ai = 0; ai < 2; ++ai)
#pragma unroll
        for (int m = 0; m < 4; ++m) { float s = 0.f;
#pragma unroll
          for (int n = 0; n < 2; ++n) { const f32x4 a0 = acc[ai][0][m][n]; s += a0[0] * a0[0] + a0[1] * a0[1] + a0[2] * a0[2] + a0[3] * a0[3];
            if (which == 0) { const f32x4 a1 = acc[ai][1][m][n]; s += a1[0] * a1[0] + a1[1] * a1[1] + a1[2] * a1[2] + a1[3] * a1[3]; } }
          s = sum_x16(s); s = sum_x32(s);
          if (fq == 0) rss[((size_t)(row0 + ai * 128 + m * 16) * 2 + which) * 4 + wc] = s; } }
  }
};
__device__ __forceinline__ void phase_zgemm(Ctx& F, const Args& A, int l, int mode = 0) {
  PlainSched S; S.o.init(NROWT, ZBW / 256, F.G, (int)blockIdx.x, 0, 9); S.A = (const char*)(F.ws + WS_HN); S.B = (const char*)(F.ws + WS_WIN + l * SZ_WIN1); S.aTile = (size_t)256 * D * 2; S.bTile = (size_t)256 * D * 2;
  EpiZ E{(bf16*)(F.ws + WS_ARENA), (float*)(F.ws + WS_RSS), mode, F.lds + RING_BYTES};
  gemm_phase<EpiZ, PlainSched, true>(F.lds, F.tid, D * 2, D * 2, D, S, E);
}
constexpr size_t WS_ZB = WS_ARENA, SZ_ZB = (size_t)T * ZBW * 2;
constexpr size_t WS_Y = WS_ZB + SZ_ZB, SZ_Y = (size_t)T * D * 2;
constexpr size_t WS_Z4 = WS_Y + SZ_Y, SZ_Z4 = (size_t)T * 4096 * 2;
constexpr size_t WS_MG = WS_Z4 + SZ_Z4, SZ_MG = (size_t)T * D * 2;
constexpr size_t WS_END1 = WS_MG + SZ_MG;
struct BranchSched {
  TileOrder o; const char* Y; const char* WB;
  __device__ __forceinline__ bool next(int i, Unit& u) const { int pm, pn; if (!o.tile(i, pm, pn)) return false; u.pm = pm; u.pn = pn; u.aux = 0; const int br = pn >> 2;
    u.a = Y + (size_t)pm * 256 * D * 2 + br * 512; u.b = WB + (size_t)br * 1024 * 512 + (size_t)(pn & 3) * 256 * 512; return true; }
  __device__ __forceinline__ void a_ready(const Unit&, int) const {}
};
constexpr int CW_BRC = 98304;
__device__ __forceinline__ bool wait_counter(const unsigned* cnt, unsigned need, unsigned* tmo, int tid) {
  if (tid < 64) { unsigned sp = 0;
    while ((unsigned)__builtin_amdgcn_readfirstlane((int)__hip_atomic_load(cnt, __ATOMIC_RELAXED, __HIP_MEMORY_SCOPE_AGENT)) < need) { __builtin_amdgcn_s_sleep(5);
      if ((++sp & 255u) == 0u) { if (__hip_atomic_load(tmo, __ATOMIC_RELAXED, __HIP_MEMORY_SCOPE_AGENT)) break; if (sp > (1u << 18)) { atomicAdd(tmo, 1u); break; } } }
    __builtin_amdgcn_fence(__ATOMIC_ACQUIRE, "agent");
    asm volatile("s_waitcnt vmcnt(0)" ::: "memory"); }
  asm volatile("" ::: "memory"); __builtin_amdgcn_s_barrier(); asm volatile("" ::: "memory"); return true;
}
struct BranchSched2 {
  int x, j; bool skip; const char* Y; const char* WB;
  __device__ __forceinline__ bool next(int i, Unit& u) const { int w;
    if (i < 4) w = 32 * i + j;
    else if (skip || j < 20) return false;
    else if (i == 4) w = j >= 28 ? 136 + 2 * (j - 28) : j >= 24 ? 128 + (j - 24) : 132 + (j - 20);
    else if (i == 5 && j >= 28) w = 137 + 2 * (j - 28); else return false;
    u.pn = w & 15; u.pm = 9 * x + (skip ? 1 : 0) + (w >> 4); u.aux = 0; u.rows = nullptr; const int br = u.pn >> 2;
    u.a = Y + (size_t)u.pm * 256 * D * 2 + br * 512; u.b = WB + (size_t)br * 1024 * 512 + (size_t)(u.pn & 3) * 256 * 512; return true; }
  __device__ __forceinline__ void a_ready(const Unit&, int) const {}
};
struct EpiZ4 {
  static constexpr bool PERM = true;
  bf16* O; unsigned* cnt; LAS unsigned char* stg;
  __device__ __forceinline__ void operator()(const f32x4 (&acc)[2][2][4][2], const Unit& u, int wr, int wc, int fr, int fq) const {
    store_tile_rows<true>(acc, stg, O, (int)SZ_Z4, 4096, u.pm * 256, u.pn * 256, wr, wc, fr, fq);
    if (cnt) { asm volatile("s_waitcnt vmcnt(0)" ::: "memory"); if (fr == 0 && fq == 0) __hip_atomic_fetch_add(cnt + (u.pm * 4 + (u.pn & 3)) * 64, 1u, __ATOMIC_RELAXED, __HIP_MEMORY_SCOPE_AGENT); }
  }
};
__device__ __forceinline__ void phase_branch(Ctx& F, const Args& A, int l, bool skipctx = false) {
  if (F.G == 256) { BranchSched2 S; S.x = (int)blockIdx.x & 7; S.j = (int)blockIdx.x >> 3; S.skip = skipctx; S.Y = (const char*)(F.ws + WS_Y); S.WB = (const char*)(F.ws + WS_WB + l * SZ_WB1);
    EpiZ4 E{(bf16*)(F.ws + WS_Z4), (unsigned*)(F.ws + WS_CTL) + CW_BRC + l * (72 * 4 * 64), F.lds + RING_BYTES};
    gemm_phase<EpiZ4, BranchSched2, true>(F.lds, F.tid, D * 2, 512, 256, S, E); return; }
  BranchSched S; S.o.init(skipctx ? NB * 8 : NROWT, 16, F.G, (int)blockIdx.x, skipctx ? 1 : 0, skipctx ? 8 : 9); S.Y = (const char*)(F.ws + WS_Y); S.WB = (const char*)(F.ws + WS_WB + l * SZ_WB1);
  EpiStoreBf16 E{(bf16*)(F.ws + WS_Z4), 4096, (int)SZ_Z4, F.lds + RING_BYTES};
  gemm_phase<EpiStoreBf16, BranchSched, true>(F.lds, F.tid, D * 2, 512, 256, S, E);
}
template <int MODE> struct EpiMergeT {
  static constexpr bool PERM = false;
  const bf16* Z4; const float* bg; bf16* M; unsigned* panel; LAS unsigned char* stg;
  static constexpr float L2E = 1.4426950408889634f;
  __device__ __forceinline__ void acc_init(f32x4 (&acc)[2][2][4][2], const Unit& u, int wr, int wc, int fr, int fq) const {
    if (MODE == 5) return;
    const int pq = fq & 1, c0 = u.pn * 64 + wc * 16 + (fq >> 1) * 8;
#pragma unroll
    for (int bj = 0; bj < 2; ++bj)
#pragma unroll
      for (int n = 0; n < 2; ++n) { const f32x4 b32 = *(const f32x4*)(bg + (2 * bj + pq) * D + c0 + 4 * n) * 32.f;
#pragma unroll
        for (int ai = 0; ai < 2; ++ai)
#pragma unroll
          for (int m = 0; m < 4; ++m) acc[ai][bj][m][n] = b32; }
  }
  __device__ __forceinline__ void operator()(const f32x4 (&acc)[2][2][4][2], const Unit& u, int wr, int wc, int fr, int fq) const {
    if (MODE >= 4) return;
    const int pq = fq & 1, c0 = u.pn * 64 + wc * 16 + (fq >> 1) * 8;
    const GAS bf16* Zg = (const GAS bf16*)Z4 + pq * D + c0;
    const __amdgpu_buffer_rsrc_t rs = __builtin_amdgcn_make_buffer_rsrc(M, 0, (int)SZ_MG, 0x00020000);
    const int tid = (wr * 4 + wc) * 64 + fq * 16 + fr;
    v4u zz[2][4][2];
#pragma unroll
    for (int ai = 0; ai < 2; ++ai)
#pragma unroll
      for (int m = 0; m < 4; ++m) { const size_t r = (size_t)u.pm * 256 + ai * 128 + wr * 64 + m * 16 + fr;
#pragma unroll
        for (int bj = 0; bj < 2; ++bj) { if (MODE == 1) zz[ai][m][bj] = (v4u){0x3f803f80u + (unsigned)fr, 0x3f803f80u, 0x3f803f80u, 0x3f803f80u}; else zz[ai][m][bj] = *(const GAS v4u*)(Zg + r * 4096 + 2 * bj * D); } }
#pragma unroll
    for (int ai = 0; ai < 2; ++ai) {
#pragma unroll
      for (int m = 0; m < 4; ++m) { f32x2 sa = {0.f, 0.f}, sb = sa, sc = sa, sd = sa;
#pragma unroll
        for (int bj = 0; bj < 2; ++bj) { const v4u z2 = zz[ai][m][bj]; const f32x4 t0 = acc[ai][bj][m][0] * (L2E / 32.f), t1 = acc[ai][bj][m][1] * (L2E / 32.f);
#define SIG2(S, TA, TB, ZW) do { const f32x2 d_ = (f32x2){__builtin_amdgcn_exp2f(-(TA)), __builtin_amdgcn_exp2f(-(TB))} + 1.f; const f32x2 r_ = {__builtin_amdgcn_rcpf(d_[0]), __builtin_amdgcn_rcpf(d_[1])}; \
            S += (f32x2){bflo(ZW), bfhi(ZW)} * r_; } while (0)
          SIG2(sa, t0[0], t0[1], z2.x); SIG2(sb, t0[2], t0[3], z2.y); SIG2(sc, t1[0], t1[1], z2.z); SIG2(sd, t1[2], t1[3], z2.w);
#undef SIG2
        }
        const f32x4 s0 = {sa[0], sa[1], sb[0], sb[1]}, s1 = {sc[0], sc[1], sd[0], sd[1]};
        float t[4];
#pragma unroll
        for (int e = 0; e < 4; ++e) { const float lo = s0[e], hi = s1[e]; auto rr = __builtin_amdgcn_permlane16_swap(__float_as_uint(lo), __float_as_uint(hi), false, false); const unsigned r0 = rr[0], r1 = rr[1]; t[e] = __uint_as_float(r0) + __uint_as_float(r1); }
        v2u o2; o2.x = cvt_pk_bf16(t[0], t[1]); o2.y = cvt_pk_bf16(t[2], t[3]);
        *(LAS v2u*)(stg + (wr * 64 + m * 16 + fr) * 144 + (wc * 16 + (fq >> 1) * 8 + 4 * pq) * 2) = o2; }
      asm volatile("s_waitcnt lgkmcnt(0)" ::: "memory"); __builtin_amdgcn_s_barrier(); asm volatile("" ::: "memory");
#pragma unroll
      for (int ps = 0; ps < 2; ++ps) { const int row = ps * 64 + (tid >> 3), ch = tid & 7; const v4u w = *(const LAS v4u*)(stg + row * 144 + ch * 16);
        if (MODE != 2 || w.x == 0x12345678u) __builtin_amdgcn_raw_buffer_store_b128(w, rs, (int)(((size_t)u.pm * 256 + ai * 128 + row) * D + u.pn * 64) * 2 + ch * 16, 0, 16); }
      asm volatile("s_waitcnt lgkmcnt(0)" ::: "memory"); __builtin_amdgcn_s_barrier(); asm volatile("" ::: "memory"); }
    if (panel) { asm volatile("s_waitcnt vmcnt(0)" ::: "memory"); if (fr == 0 && fq == 0) __hip_atomic_fetch_add(panel + 64 * u.pm, 1u, __ATOMIC_RELAXED, __HIP_MEMORY_SCOPE_AGENT); }
  }
};
using EpiMerge = EpiMergeT<0>;
struct GateSched {
  int x, j; bool skip; const char* A; const char* B; const unsigned* brc; unsigned* tmo;
  __device__ __forceinline__ bool next(int i, Unit& u) const { int w;
    if (skip) { if (i >= 4) return false; w = 32 * i + j; }
    else if (j < 20) { if (i >= 5) return false; w = (i == 4 ? 124 : 32 * i) + j; }
    else if (j < 28) { const int k = j - 20; if (i < 3) w = 20 + 32 * i + k; else if (i == 3 && k < 4) w = 116 + k; else return false; }
    else { const int k = j - 28; if (i < 3) w = 28 + 32 * i + k; else if (i == 3) w = 120 + k; else return false; }
    u.pn = w & 15; u.pm = 9 * x + (skip ? 1 : 0) + (w >> 4); u.aux = 0; u.rows = nullptr; u.a = A + (size_t)u.pm * 256 * P8; u.b = B + (size_t)u.pn * 256 * P8; return true; }
  __device__ __forceinline__ void a_ready(const Unit& u, int tid) const { if (brc) wait_counter(brc + (u.pm * 4 + (u.pn >> 2)) * 64, 32u, tmo, tid); }
};
template <int MODE = 0> __device__ __forceinline__ void phase_gate(Ctx& F, const Args& A, int l, bool skipctx = false, int cbase = CW_PANEL) {
  if (F.G == 256) { GateSched S; S.x = (int)blockIdx.x & 7; S.j = (int)blockIdx.x >> 3; S.skip = skipctx; S.A = (const char*)(F.ws + WS_HN8); S.B = (const char*)(F.ws + WS_WG8 + l * SZ_WG81); S.brc = cbase == CW_PANEL ? (const unsigned*)(F.ws + WS_CTL) + CW_BRC + l * (72 * 4 * 64) : nullptr; S.tmo = (unsigned*)(F.ws + WS_CTL) + CW_BAR_TMO;
    EpiMergeT<MODE> E{(const bf16*)(F.ws + WS_Z4), A.in[18] + (size_t)l * 4 * D, (bf16*)(F.ws + WS_MG), (unsigned*)(F.ws + WS_CTL) + cbase + l * (72 * 64), F.lds + RING_BYTES};
    gemm_phase<EpiMergeT<MODE>, GateSched, true, false, true>(F.lds, F.tid, P8, P8, D / 2, S, E); return; }
  PlainSched S; S.o.init(skipctx ? NB * 8 : NROWT, 16, F.G, (int)blockIdx.x, skipctx ? 1 : 0, skipctx ? 8 : 9); S.A = (const char*)(F.ws + WS_HN8); S.B = (const char*)(F.ws + WS_WG8 + l * SZ_WG81); S.aTile = (size_t)256 * P8; S.bTile = (size_t)256 * P8;
  EpiMergeT<MODE> E{(const bf16*)(F.ws + WS_Z4), A.in[18] + (size_t)l * 4 * D, (bf16*)(F.ws + WS_MG), F.G == 256 ? (unsigned*)(F.ws + WS_CTL) + CW_PANEL + l * (72 * 64) : nullptr};
  gemm_phase<EpiMergeT<MODE>, PlainSched, true, false, true>(F.lds, F.tid, P8, P8, D / 2, S, E);
}
struct EpiResid {
  static constexpr bool PERM = true;
  bf16* hs; const float* mod; float gs;
  __device__ __forceinline__ void operator()(const f32x4 (&acc)[2][2][4][2], const Unit& u, int wr, int wc, int fr, int fq) const {
    const int b = u.pm / 9, rm = (u.pm % 9 == 0) ? 8 : b; const float* gv = mod + (size_t)rm * 6 * D + 2 * D;
    const int col0 = u.pn * 256 + wc * 32 + fq * 8;
    GAS bf16* hg = (GAS bf16*)hs;
#pragma unroll
    for (int bj = 0; bj < 2; ++bj) { v4u w[2][4]; const int c = col0 + bj * 128;
      const f32x4 g0 = *(const f32x4*)(gv + c) * gs, g1 = *(const f32x4*)(gv + c + 4) * gs;
#pragma unroll
      for (int ai = 0; ai < 2; ++ai)
#pragma unroll
        for (int m = 0; m < 4; ++m) w[ai][m] = *(const GAS v4u*)(hg + ((size_t)u.pm * 256 + ai * 128 + wr * 64 + m * 16 + fr) * D + c);
#pragma unroll
      for (int ai = 0; ai < 2; ++ai)
#pragma unroll
        for (int m = 0; m < 4; ++m) { const v4u ww = w[ai][m]; const f32x4 h0 = {bflo(ww.x), bfhi(ww.x), bflo(ww.y), bfhi(ww.y)}, h1 = {bflo(ww.z), bfhi(ww.z), bflo(ww.w), bfhi(ww.w)};
          const f32x4 o0 = h0 + g0 * acc[ai][bj][m][0], o1 = h1 + g1 * acc[ai][bj][m][1];
          v4u ow; ow.x = cvt_pk_bf16(o0[0], o0[1]); ow.y = cvt_pk_bf16(o0[2], o0[3]); ow.z = cvt_pk_bf16(o1[0], o1[1]); ow.w = cvt_pk_bf16(o1[2], o1[3]);
          *(GAS v4u*)(hg + ((size_t)u.pm * 256 + ai * 128 + wr * 64 + m * 16 + fr) * D + c) = ow; } }
  }
};
struct OutSched {
  int c; const char* A; const char* B; unsigned* panel; unsigned* tmo; bool counted; bool skip;
  __device__ __forceinline__ bool next(int i, Unit& u) const { const int x = c & 7, j = c >> 3; int o;
    if (skip) { if (i > 0) return false; o = j; }
    else if (j >= 24 && j < 28) { if (i > 1) return false; o = 2 * (j - 24) + i; }
    else if (i > 0) return false; else if (j >= 28) o = 12 + (j - 28); else if (j >= 20) o = 8 + (j - 20); else o = 16 + j;
    u.pm = 9 * x + (skip ? 1 : 0) + (o >> 2); u.pn = o & 3;
    u.aux = 0; u.rows = nullptr; u.a = A + (size_t)u.pm * 256 * D * 2; u.b = B + (size_t)u.pn * 256 * D * 2; return true; }
  __device__ __forceinline__ void a_ready(const Unit& u, int tid) const {
    if (!counted) return;
    if (tid < 64) { unsigned sp = 0;
      while ((unsigned)__builtin_amdgcn_readfirstlane((int)__hip_atomic_load(panel + 64 * u.pm, __ATOMIC_RELAXED, __HIP_MEMORY_SCOPE_AGENT)) < 128u) { __builtin_amdgcn_s_sleep(5);
        if ((++sp & 255u) == 0u) { if (__hip_atomic_load(tmo, __ATOMIC_RELAXED, __HIP_MEMORY_SCOPE_AGENT)) break; if (sp > (1u << 18)) { atomicAdd(tmo, 1u); break; } } }
      __builtin_amdgcn_fence(__ATOMIC_ACQUIRE, "agent");
      asm volatile("s_waitcnt vmcnt(0)" ::: "memory"); }
    asm volatile("" ::: "memory"); __builtin_amdgcn_s_barrier(); asm volatile("" ::: "memory");
  }
};
__device__ __forceinline__ void phase_out(Ctx& F, const Args& A, int l, float gs = 1.f, bool counted = false, bool skipctx = false, int cbase = CW_PANEL) {
  EpiResid E{(bf16*)(F.ws + WS_HS), (const float*)(F.ws + WS_MOD) + (size_t)l * 9 * 6 * D, gs};
  if (F.G == 256) { OutSched S; S.c = (int)blockIdx.x; S.A = (const char*)(F.ws + WS_MG); S.B = (const char*)(F.ws + WS_WOUT + l * SZ_WOUT1); S.panel = (unsigned*)(F.ws + WS_CTL) + cbase + l * (72 * 64); S.tmo = (unsigned*)(F.ws + WS_CTL) + CW_BAR_TMO; S.counted = counted; S.skip = skipctx;
    gemm_phase<EpiResid, OutSched, true>(F.lds, F.tid, D * 2, D * 2, D, S, E); }
  else { PlainSched S; S.o.init(skipctx ? NB * 8 : NROWT, 4, F.G, (int)blockIdx.x, skipctx ? 1 : 0); S.A = (const char*)(F.ws + WS_MG); S.B = (const char*)(F.ws + WS_WOUT + l * SZ_WOUT1); S.aTile = (size_t)256 * D * 2; S.bTile = (size_t)256 * D * 2;
    gemm_phase<EpiResid, PlainSched, true>(F.lds, F.tid, D * 2, D * 2, D, S, E); }
}
constexpr int CAP2 = 2 * T + NE * 256, NT_MOE = CAP2 / 256;
constexpr size_t WS_XG = WS_ARENA, SZ_XG = (size_t)CAP2 * D * 2;
constexpr size_t WS_HE = WS_XG + SZ_XG, SZ_HE = (size_t)CAP2 * 256 * 2;
constexpr size_t WS_FS = WS_HE + SZ_HE, SZ_FS = (size_t)CAP2 * D * 2;
static_assert(WS_FS + SZ_FS <= WS_END1, "moe arena fits in the mixer arena");
constexpr size_t WS_TOKE = WS_END1, WS_TOKW = WS_TOKE + (size_t)2 * T * 4, WS_TOKR = WS_TOKW + (size_t)2 * T * 4, WS_TOKS = WS_TOKR + (size_t)2 * T * 4, WS_END2 = WS_TOKS + (size_t)2 * T * 4;
constexpr size_t WS_SLOT = WS_END2;
constexpr size_t WS_CJ = WS_SLOT + (size_t)CAP2 * 4;
constexpr size_t WS_SLSP = WS_CJ + 8192;
constexpr size_t WS_END2B = WS_SLSP + (size_t)NE * T * 4;
__device__ __forceinline__ void phase_norm_router(Ctx& F, const Args& A, int l, bool skip_ctx, bool dry = false) {
  const int gw = F.vcu * NWAVES + F.wave, NGW = F.G * NWAVES, lane = F.lane;
  const bf16* hs = (const bf16*)(F.ws + WS_HS); bf16* hn = (bf16*)(F.ws + WS_HN); const float* mod = (const float*)(F.ws + WS_MOD) + (size_t)l * 9 * 6 * D;
  const float* wgr = A.in[21] + (size_t)l * D * 4; const float* bgr = A.in[22] + l * 4; const float* wer = A.in[23] + (size_t)l * D * 32; const float* ber = A.in[24] + l * 32;
  int* tok_e = (int*)(F.ws + WS_TOKE); float* tok_w = (float*)(F.ws + WS_TOKW); int* tok_r = (int*)(F.ws + WS_TOKR);
  unsigned* counts = (unsigned*)(F.ws + WS_CTL) + CW_CNT + l * 64;
  if (dry) { tok_e = (int*)A.out; tok_w = A.out + (1 << 20); tok_r = (int*)A.out + (2 << 20); counts += 32; }
  constexpr int WPB = 2064;
  LAS unsigned char* Wh = F.lds; LAS unsigned char* Wl = F.lds + 36 * WPB; const float* cj = (const float*)(F.ws + WS_CJ) + l * (9 * 36); LAS unsigned* lcnt = (LAS unsigned*)(F.lds + 72 * WPB); LAS unsigned* lbase = lcnt + 32; LAS unsigned* rowctr = lbase + 32;
  __syncthreads();
  { const v4u* src = (const v4u*)(F.ws + WS_RTW + (size_t)l * SZ_RTW1); v4u w[19];
#pragma unroll
    for (int it = 0; it < 19; ++it) { const int i = F.tid + NTHR * it; if (i < 72 * RTW_PITCH / 16) w[it] = src[i]; }
#pragma unroll
    for (int it = 0; it < 19; ++it) { const int i = F.tid + NTHR * it; if (i < 72 * RTW_PITCH / 16) *(LAS v4u*)(F.lds + (size_t)i * 16) = w[it]; } }
  if (F.tid < 32) lcnt[F.tid] = 0u;
  if (F.tid == 32) rowctr[0] = 0u;
  __syncthreads();
  refresh_ctx(F, A);
  const int NR = skip_ctx ? NB * NLAT : T;
  const int lane2 = F.lane; const int g16 = F.wave * F.G + F.vcu, NG = NR / 16; const int fr = lane2 & 15, fq = lane2 >> 4;
  int myE0 = -1, myE1 = -1, mym = 0, myR0 = 0, myR1 = 0; int* slsp = (int*)(F.ws + WS_SLSP); if (dry) slsp = (int*)A.out + (3 << 20);
  if (g16 < NG) {
    const int r0 = g16 * 16 + fr; const int m = skip_ctx ? (r0 / NLAT) * NTOK + NCTX + (r0 % NLAT) : r0; const int b = m / NTOK, t = m % NTOK, r = t < NCTX ? 8 : b; mym = m;
    const bf16* xrow = hs + (size_t)m * D + 16 * fq; const float* scr = mod + (size_t)r * 6 * D + 4 * D + 16 * fq;
    const int j2 = fr < 4 ? 32 + fr : 35;
    const LAS unsigned char* ah0 = Wh + fr * WPB + 32 * fq; const LAS unsigned char* ah1 = Wh + (16 + fr) * WPB + 32 * fq; const LAS unsigned char* ah2 = Wh + j2 * WPB + 32 * fq;
    const LAS unsigned char* al0 = Wl + fr * WPB + 32 * fq; const LAS unsigned char* al1 = Wl + (16 + fr) * WPB + 32 * fq; const LAS unsigned char* al2 = Wl + j2 * WPB + 32 * fq;
    f32x4 acc0 = {0.f, 0.f, 0.f, 0.f}, acc1 = acc0, acc2 = acc0; float ss = 0.f;
    uint4 nx0 = *(const uint4*)xrow, nx1 = *(const uint4*)(xrow + 8); float4 ns[4];
#pragma unroll
    for (int q = 0; q < 4; ++q) ns[q] = *(const float4*)(scr + 4 * q);
#pragma unroll 2
    for (int g = 0; g < 16; ++g) { const uint4 xw0 = nx0, xw1 = nx1; float4 cs[4];
#pragma unroll
      for (int q = 0; q < 4; ++q) cs[q] = ns[q];
      { const int gn = g < 15 ? g + 1 : 15; nx0 = *(const uint4*)(xrow + 64 * gn); nx1 = *(const uint4*)(xrow + 64 * gn + 8);
#pragma unroll
        for (int q = 0; q < 4; ++q) ns[q] = *(const float4*)(scr + 64 * gn + 4 * q); }
      float xa[16] = {bflo(xw0.x), bfhi(xw0.x), bflo(xw0.y), bfhi(xw0.y), bflo(xw0.z), bfhi(xw0.z), bflo(xw0.w), bfhi(xw0.w), bflo(xw1.x), bfhi(xw1.x), bflo(xw1.y), bfhi(xw1.y), bflo(xw1.z), bfhi(xw1.z), bflo(xw1.w), bfhi(xw1.w)};
#pragma unroll
      for (int q = 0; q < 4; ++q) { const float4 s4 = cs[q];
        ss += (xa[4 * q] * xa[4 * q] + xa[4 * q + 1] * xa[4 * q + 1]) + (xa[4 * q + 2] * xa[4 * q + 2] + xa[4 * q + 3] * xa[4 * q + 3]);
        xa[4 * q] *= 1.f + s4.x; xa[4 * q + 1] *= 1.f + s4.y; xa[4 * q + 2] *= 1.f + s4.z; xa[4 * q + 3] *= 1.f + s4.w; }
#pragma unroll
      for (int s = 0; s < 2; ++s) {
        v4u xh, xl;
#pragma unroll
        for (int e2 = 0; e2 < 4; ++e2) { const float a = xa[8 * s + 2 * e2], b2 = xa[8 * s + 2 * e2 + 1]; const unsigned h = cvt_pk_bf16(a, b2); const unsigned lo = cvt_pk_bf16(a - bflo(h), b2 - bfhi(h)); xh[e2] = h; xl[e2] = lo; }
        const bf16x8 bh = __builtin_bit_cast(bf16x8, xh), bl = __builtin_bit_cast(bf16x8, xl);
        const bf16x8 h0 = *(const LAS bf16x8*)(ah0 + 128 * g + 16 * s), h1 = *(const LAS bf16x8*)(ah1 + 128 * g + 16 * s), h2 = *(const LAS bf16x8*)(ah2 + 128 * g + 16 * s);
        const bf16x8 l0 = *(const LAS bf16x8*)(al0 + 128 * g + 16 * s), l1 = *(const LAS bf16x8*)(al1 + 128 * g + 16 * s), l2 = *(const LAS bf16x8*)(al2 + 128 * g + 16 * s);
        acc0 = __builtin_amdgcn_mfma_f32_16x16x32_bf16(h0, bh, acc0, 0, 0, 0); acc1 = __builtin_amdgcn_mfma_f32_16x16x32_bf16(h1, bh, acc1, 0, 0, 0); acc2 = __builtin_amdgcn_mfma_f32_16x16x32_bf16(h2, bh, acc2, 0, 0, 0);
        acc0 = __builtin_amdgcn_mfma_f32_16x16x32_bf16(l0, bh, acc0, 0, 0, 0); acc1 = __builtin_amdgcn_mfma_f32_16x16x32_bf16(l1, bh, acc1, 0, 0, 0); acc2 = __builtin_amdgcn_mfma_f32_16x16x32_bf16(l2, bh, acc2, 0, 0, 0);
        acc0 = __builtin_amdgcn_mfma_f32_16x16x32_bf16(h0, bl, acc0, 0, 0, 0); acc1 = __builtin_amdgcn_mfma_f32_16x16x32_bf16(h1, bl, acc1, 0, 0, 0); acc2 = __builtin_amdgcn_mfma_f32_16x16x32_bf16(h2, bl, acc2, 0, 0, 0); } }
    ss = sum_x16(ss); ss = sum_x32(ss);
    const float rinv = rsqrtf(ss * (1.f / D) + EPS);
    float lg[36];
#pragma unroll
    for (int e = 0; e < 4; ++e) { lg[e] = acc0[e]; lg[16 + e] = acc1[e]; lg[32 + e] = acc2[e]; }
#pragma unroll
    for (int q = 1; q < 4; ++q)
#pragma unroll
      for (int e = 0; e < 4; ++e) { const float a0 = acc0[e], a1 = acc1[e];
        lg[4 * q + e] = __int_as_float(__builtin_amdgcn_ds_bpermute((fr + 16 * q) << 2, __float_as_int(a0))); lg[16 + 4 * q + e] = __int_as_float(__builtin_amdgcn_ds_bpermute((fr + 16 * q) << 2, __float_as_int(a1))); }
    if (fq == 0) {
      const float* cr = cj + r * 36;
      float mxg = -1e30f; int g = 0; float gl[4];
#pragma unroll
      for (int j = 0; j < 4; ++j) { gl[j] = rinv * lg[j] + cr[j]; if (gl[j] > mxg) { mxg = gl[j]; g = j; } }
      float sg = 0.f;
#pragma unroll
      for (int j = 0; j < 4; ++j) sg += __expf(gl[j] - mxg);
      const float pg = 1.f / sg;
      float v0 = -1e30f, v1 = -1e30f; int e0 = 0, e1 = 0;
#pragma unroll
      for (int j = 0; j < 8; ++j) { float le = 0.f;
#pragma unroll
        for (int gg = 0; gg < 4; ++gg) if (gg == g) le = lg[4 + gg * 8 + j];
        le = rinv * le + cr[4 + g * 8 + j];
        if (le > v0) { v1 = v0; e1 = e0; v0 = le; e0 = j; } else if (le > v1) { v1 = le; e1 = j; } }
      const float p1 = __expf(v1 - v0); const float inv = pg / (1.f + p1);
      myE0 = g * 8 + e0; myE1 = g * 8 + e1;
      tok_e[2 * m] = myE0; tok_e[2 * m + 1] = myE1; tok_w[2 * m] = inv; tok_w[2 * m + 1] = p1 * inv;
      myR0 = (int)__hip_atomic_fetch_add(&lcnt[myE0], 1u, __ATOMIC_RELAXED, __HIP_MEMORY_SCOPE_WORKGROUP); myR1 = (int)__hip_atomic_fetch_add(&lcnt[myE1], 1u, __ATOMIC_RELAXED, __HIP_MEMORY_SCOPE_WORKGROUP);
    }
  }
  { const int NR2 = skip_ctx ? NB * NLAT : T; const int rpb = NR2 / F.G;
    for (;;) { unsigned q = 0; if (lane2 == 0) q = __hip_atomic_fetch_add(rowctr, 1u, __ATOMIC_RELAXED, __HIP_MEMORY_SCOPE_WORKGROUP); q = (unsigned)__builtin_amdgcn_readfirstlane((int)q); if ((int)q >= rpb) break;
      const int r0 = F.vcu * NWAVES + (int)(q & 7) + (int)(q >> 3) * NGW; const int m = skip_ctx ? (r0 / NLAT) * NTOK + NCTX + (r0 % NLAT) : r0; const int b = m / NTOK, t = m % NTOK, r = t < NCTX ? 8 : b;
      const float4* sh = (const float4*)(mod + (size_t)r * 6 * D + 3 * D); const float4* sc = sh + D / 4; const v2u* xr = (const v2u*)(hs + (size_t)m * D); float4 v[4]; float ss = 0.f;
      float4 sca[4], sha[4];
#pragma unroll
      for (int j = 0; j < 4; ++j) { sca[j] = sc[lane2 + 64 * j]; sha[j] = sh[lane2 + 64 * j]; }
#pragma unroll
      for (int j = 0; j < 4; ++j) { const v2u w = xr[lane2 + 64 * j]; v[j] = make_float4(bflo(w.x), bfhi(w.x), bflo(w.y), bfhi(w.y)); ss += v[j].x * v[j].x + v[j].y * v[j].y + v[j].z * v[j].z + v[j].w * v[j].w; }
      const float rinv = rsqrtf(wave_sum(ss) * (1.f / D) + EPS);
#pragma unroll
      for (int j = 0; j < 4; ++j) { const float4 a = sca[j], s4 = sha[j];
        v2u o; o.x = pk2(v[j].x * rinv * (1.f + a.x) + s4.x, v[j].y * rinv * (1.f + a.y) + s4.y); o.y = pk2(v[j].z * rinv * (1.f + a.z) + s4.z, v[j].w * rinv * (1.f + a.w) + s4.w);
        ((v2u*)(hn + (size_t)m * D))[lane2 + 64 * j] = o; } } }
  if (skip_ctx) { int neg1 = -1; asm volatile("" : "+v"(neg1)); for (int m = gw; m < T; m += NGW) if ((m % NTOK) < NCTX && lane < 2) tok_e[2 * m + lane] = neg1; }
  __syncthreads();
  if (F.tid < 32) { const unsigned c = lcnt[F.tid]; lbase[F.tid] = c ? atomicAdd(&counts[F.tid], c) : 0u; }
  __syncthreads();
  if (myE0 >= 0) { const int r0 = myR0 + (int)lbase[myE0], r1 = myR1 + (int)lbase[myE1]; tok_r[2 * mym] = r0; tok_r[2 * mym + 1] = r1; slsp[myE0 * T + r0] = mym; slsp[myE1 * T + r1] = mym; }
  __syncthreads();
}
__device__ __forceinline__ void moe_tables(Ctx& F, const Args& A, int l) {
  LAS int* ps = (LAS int*)(F.lds + XSCR_OFF); LAS int* te = ps + 64; LAS int* cn = ps + 256;
  const unsigned* counts = (const unsigned*)(F.ws + WS_CTL) + CW_CNT + l * 64;
  __syncthreads();
  if (F.tid < NE) cn[F.tid] = (int)__hip_atomic_load(counts + F.tid, __ATOMIC_RELAXED, __HIP_MEMORY_SCOPE_AGENT);
  __syncthreads();
  if (F.tid == 0) { int a = 0; for (int o = 0; o < NE; ++o) { const int e = (o >> 2) + 8 * (o & 3); ps[e] = a; a += (cn[e] + 255) / 256 * 256; } ps[NE] = a; }
  __syncthreads();
  for (int i = F.tid; i < NT_MOE; i += NTHR) { int e = -1;
    for (int j = 0; j < NE; ++j) if (i * 256 >= ps[j] && i * 256 < ps[j] + (cn[j] + 255) / 256 * 256) e = j;
    if (e >= 0) { const int off = i * 256 - ps[e]; int nv = cn[e] - off; nv = nv > 256 ? 256 : nv; e |= ((nv - 1) << 5) | ((off >> 8) << 13); }
    te[i] = e; }
  __syncthreads();
}
struct MoeSched {
  int G, c, npn, ntile; const char* A; const char* W; size_t aTile, wExp, wTile; const LAS int* te; const int* slot_tok; const unsigned* hec; unsigned* tmo; bool nogather;
  int Tx, n2; const LAS int* gq;
  __device__ __forceinline__ void group_init(const LAS int* ps, int tid) { const int x = c & 7; LAS int* g = (LAS int*)ps + 320; Tx = 0;
#pragma unroll
    for (int q = 0; q < 4; ++q) { const int e = x + 8 * q; const int n = (ps[256 + e] + 255) >> 8; if (tid == 0) g[q] = (ps[e] >> 8) | (n << 16); Tx += n; }
    const int Ug = 2 * Tx, R = (Ug + 31) / 32; n2 = R >= 2 ? Ug - 32 * (R - 1) : 0; if (n2 >= 32) n2 = 0; gq = g; __syncthreads(); }
  __device__ __forceinline__ bool next(int i, Unit& u) const { int rt, pn;
    if (G == 256) { const int j = c >> 3; int s;
      if (!hec) s = j + 32 * i;
      else { const int nf = 32 - n2; if (j >= n2) { const int f = j - n2; s = i == 0 ? f : i == 1 ? nf + f : 2 * nf + (i - 2) * 32 + f; } else s = 2 * nf + i * 32 + nf + j; }
      if (s >= npn * Tx) return false;
      int g = gq[0];
#pragma unroll
      for (int k = 1; k < 4; ++k) { const int n0 = npn * (g >> 16); if (s >= n0) { s -= n0; g = gq[k]; } else break; }
      const int n = g >> 16; pn = s / n; rt = (g & 0xffff) + s % n; }
    else { const int Lx = i * G + c; if (Lx >= ntile * npn) return false; rt = Lx / npn; pn = Lx % npn; }
    const int w = te[rt], e = w & 31;
    u.pm = rt; u.pn = pn; u.aux = e; u.a = A + (size_t)rt * aTile; u.b = W + (size_t)e * wExp + (size_t)pn * wTile; u.rows = slot_tok + e * T + (w >> 13) * 256; u.nv = nogather ? 0 : ((w >> 5) & 255) + 1; return true; }
  __device__ __forceinline__ void a_ready(const Unit& u, int tid) const { if (hec) wait_counter(hec + u.pm * 16, 16u, tmo, tid); }
};
constexpr int CW_HEC = 200000;
struct EpiSwiGLU {
  static constexpr bool PERM = true;
  bf16* H; unsigned* cnt;
  __device__ __forceinline__ void operator()(const f32x4 (&acc)[2][2][4][2], const Unit& u, int wr, int wc, int fr, int fq) const {
    const __amdgpu_buffer_rsrc_t rs = __builtin_amdgcn_make_buffer_rsrc(H, 0, (int)SZ_HE, 0x00020000);
#pragma unroll
    for (int ai = 0; ai < 2; ++ai)
#pragma unroll
      for (int m = 0; m < 4; ++m) { const int r = u.pm * 256 + ai * 128 + wr * 64 + m * 16 + fr; float h[8];
#pragma unroll
        for (int n = 0; n < 2; ++n)
#pragma unroll
          for (int e = 0; e < 4; ++e) { const float g = acc[ai][0][m][n][e]; h[4 * n + e] = g * __builtin_amdgcn_rcpf(1.f + __expf(-g)) * acc[ai][1][m][n][e]; }
        v4u w; w.x = cvt_pk_bf16(h[0], h[1]); w.y = cvt_pk_bf16(h[2], h[3]); w.z = cvt_pk_bf16(h[4], h[5]); w.w = cvt_pk_bf16(h[6], h[7]);
        __builtin_amdgcn_raw_buffer_store_b128(w, rs, (r * 256 + u.pn * 128 + wc * 32 + fq * 8) * 2, 0, 16); }
    if (cnt) { asm volatile("s_waitcnt vmcnt(0)" ::: "memory"); if (fr == 0 && fq == 0) __hip_atomic_fetch_add(cnt + u.pm * 16, 1u, __ATOMIC_RELAXED, __HIP_MEMORY_SCOPE_AGENT); }
  }
};
__device__ __forceinline__ void phase_moe_gu(Ctx& F, const Args& A, int l, int probe = 0) {
  moe_tables(F, A, l);
  const LAS int* ps = (const LAS int*)(F.lds + XSCR_OFF);
  MoeSched S; S.G = F.G; S.c = (int)blockIdx.x; S.npn = 2; S.ntile = ps[NE] / 256; S.A = (const char*)(F.ws + WS_HN); S.slot_tok = (const int*)(F.ws + WS_SLSP); S.W = (const char*)(F.ws + WS_WGU + l * SZ_WGU1); S.aTile = 0; S.wExp = (size_t)512 * D * 2; S.wTile = (size_t)256 * D * 2; S.te = ps + 64; S.hec = nullptr; S.tmo = nullptr; S.nogather = probe == 2; S.group_init(ps, F.tid);
  EpiSwiGLU E{(bf16*)(F.ws + WS_HE), (F.G == 256 && !probe) ? (unsigned*)(F.ws + WS_CTL) + CW_HEC + l * 4096 : nullptr};
  gemm_phase<EpiSwiGLU, MoeSched, true, true>(F.lds, F.tid, D * 2, D * 2, D, S, E);
}
__device__ __forceinline__ void phase_moe_dn(Ctx& F, const Args& A, int l) {
  const LAS int* ps = (const LAS int*)(F.lds + XSCR_OFF);
  MoeSched S; S.G = F.G; S.c = (int)blockIdx.x; S.npn = 4; S.ntile = ps[NE] / 256; S.slot_tok = (const int*)(F.ws + WS_SLSP); S.A = (const char*)(F.ws + WS_HE); S.W = (const char*)(F.ws + WS_WDN + l * SZ_WDN1); S.aTile = (size_t)256 * 256 * 2; S.wExp = (size_t)D * 256 * 2; S.wTile = (size_t)256 * 256 * 2; S.te = ps + 64; S.hec = F.G == 256 ? (const unsigned*)(F.ws + WS_CTL) + CW_HEC + l * 4096 : nullptr; S.tmo = (unsigned*)(F.ws + WS_CTL) + CW_BAR_TMO; S.nogather = false; S.group_init(ps, F.tid);
  EpiStoreBf16 E{(bf16*)(F.ws + WS_FS), D, (int)SZ_FS, F.lds + RING_BYTES};
  gemm_phase<EpiStoreBf16, MoeSched, true>(F.lds, F.tid, 512, 512, 256, S, E);
}
__device__ __forceinline__ void phase_moe_combine(Ctx& F, const Args& A, int l) {
  const int gw = F.vcu * NWAVES + F.wave, NGW = F.G * NWAVES, lane = F.lane;
  float* hs = (float*)(F.ws + WS_HS); const float* mod = (const float*)(F.ws + WS_MOD) + (size_t)l * 9 * 6 * D;
  const int* tok_s = (const int*)(F.ws + WS_TOKS); const float* tok_w = (const float*)(F.ws + WS_TOKW); const bf16* fs = (const bf16*)(F.ws + WS_FS);
  for (int m = gw; m < T; m += NGW) { const int s0 = tok_s[2 * m], s1 = tok_s[2 * m + 1]; if (s0 < 0) continue;
    const int b = m / NTOK, t = m % NTOK, r = t < NCTX ? 8 : b; const float w0 = tok_w[2 * m], w1 = tok_w[2 * m + 1];
    const float4* g5 = (const float4*)(mod + (size_t)r * 6 * D + 5 * D);
#pragma unroll
    for (int j = 0; j < 4; ++j) { const int c4 = lane + 64 * j; const v2u a = ((const v2u*)(fs + (size_t)s0 * D))[c4], bq = ((const v2u*)(fs + (size_t)s1 * D))[c4]; const float4 g = g5[c4];
      float4 h = ((float4*)(hs + (size_t)m * D))[c4];
      h.x += g.x * (w0 * bflo(a.x) + w1 * bflo(bq.x)); h.y += g.y * (w0 * bfhi(a.x) + w1 * bfhi(bq.x)); h.z += g.z * (w0 * bflo(a.y) + w1 * bflo(bq.y)); h.w += g.w * (w0 * bfhi(a.y) + w1 * bfhi(bq.y));
      ((float4*)(hs + (size_t)m * D))[c4] = h; } }
}
}
namespace mk {
constexpr int NKT = NTOK / 64;
constexpr size_t WS_QM = WS_END2B, SZ_QM = (size_t)NB * 4 * NTOK * 96 * 2;
constexpr size_t WS_QD = WS_QM + SZ_QM, SZ_QD = (size_t)NB * 4 * NTOK * 64 * 2;
constexpr size_t WS_KM = WS_QD + SZ_QD, SZ_KM = (size_t)NB * 4 * NKT * 12288;
constexpr size_t WS_KD = WS_KM + SZ_KM, SZ_KD = (size_t)NB * 2 * NKT * 8192;
constexpr size_t WS_VM = WS_KD + SZ_KD, SZ_VM = (size_t)NB * 4 * NKT * 8192;
constexpr size_t WS_VD = WS_VM + SZ_VM, SZ_VD = (size_t)NB * 2 * NKT * 8192;
constexpr size_t WS_END3 = WS_VD + SZ_VD;
constexpr float QSCALE_M = 0.10206207261596577f * 1.4426950408889634f, QSCALE_D = 0.125f * 1.4426950408889634f;

template <int NCB> __device__ __forceinline__ int v_st(int k, int c) { const int kk = (k & ~0xC) | ((k & 4) << 1) | ((k & 8) >> 1); return ((kk >> 3) * NCB + (c >> 5)) * 512 + ((kk & 7) * 32 + (c & 31)) * 2; }
__device__ __forceinline__ int v_rd_base(int lane) { return ((lane & 3) << 3) | (((lane >> 2) & 3) << 6) | (((lane >> 4) & 1) << 5) | (((lane >> 5) & 1) << 8); }
template <int NCB> constexpr int v_rd_off(int d0, int ks, int half) { return d0 * 512 + ks * (2 * NCB * 512) + half * (NCB * 512); }
typedef short s16x4 __attribute__((ext_vector_type(4)));
typedef float f32x16 __attribute__((ext_vector_type(16)));
template <int OFF> __device__ __forceinline__ s16x4 tr_read(int vb) { s16x4 r; asm volatile("ds_read_b64_tr_b16 %0, %1 offset:%2" : "=&v"(r) : "v"(vb), "i"(OFF) : "memory"); return r; }
__device__ __forceinline__ int crow(int r, int hi) { return (r & 3) + 8 * (r >> 2) + 4 * hi; }
__device__ __forceinline__ int krow(int k) { return (k & ~0xC) | ((k & 4) << 1) | ((k & 8) >> 1); }
#define SBAR() __builtin_amdgcn_sched_barrier(0)

template <int ROT> __device__ __forceinline__ void rope_cs(int t, int i, float& cs, float& sn) {
  constexpr int NF = ROT / 4;
  if (t < NCTX) { cs = 1.f; sn = 0.f; return; }
  const int tl = t - NCTX; const float pos = (i < NF) ? (float)(tl >> 6) : (float)(tl & 63); const int fi = i % NF;
  const float fr = exp2f(-(float)fi * (13.287712379549449f / (float)NF));
  float rev = pos * fr * 0.15915494309189535f; rev = rev - floorf(rev);
  cs = __builtin_amdgcn_cosf(rev); sn = __builtin_amdgcn_sinf(rev);
}

__device__ __forceinline__ void phase_b_rows(Ctx& F, const Args& A, int l) {
  const int gw = F.vcu * NWAVES + F.wave, NGW = F.G * NWAVES, lane = F.lane;
  const bf16* zb = (const bf16*)(F.ws + WS_ZB); bf16* Y = (bf16*)(F.ws + WS_Y);
  const float* gq_gain = A.in[15] + l * 64; const float* gk_gain = A.in[16] + l * 64; const float* w_conv = A.in[14] + l * 3 * 256;
  const float gq = gq_gain[lane], gk = gk_gain[lane];
  float wcv[3][4];
#pragma unroll
  for (int j = 0; j < 3; ++j)
#pragma unroll
    for (int e = 0; e < 4; ++e) wcv[j][e] = w_conv[j * 256 + 4 * lane + e];
  constexpr int RB = 3;
  for (int m0 = gw; m0 < T; m0 += RB * NGW) {
    int mr[RB]; bool ok[RB];
#pragma unroll
    for (int i = 0; i < RB; ++i) { const int mi = m0 + i * NGW; ok[i] = mi < T; mr[i] = ok[i] ? mi : m0; }
    bf16 kpe[RB], gqv[RB][4], gkv[RB][2], gvv[RB][2]; v2u cc[RB][3], cx[RB][3], cb[RB]; float cmask[RB][3];
#pragma unroll
    for (int i = 0; i < RB; ++i) { const int m = mr[i], t = m % NTOK; const bf16* zr = zb + (size_t)m * ZBW;
      kpe[i] = zr[ZB_KPE + (lane & 31)];
#pragma unroll
      for (int h = 0; h < 4; ++h) gqv[i][h] = zr[ZB_GQ + h * 64 + lane];
#pragma unroll
      for (int h = 0; h < 2; ++h) { gkv[i][h] = zr[ZB_GK + h * 64 + lane]; gvv[i][h] = zr[ZB_GV + h * 64 + lane]; }
      const int lo = t < NCTX ? 0 : NCTX, hi = t < NCTX ? NCTX : NTOK;
#pragma unroll
      for (int j = 0; j < 3; ++j) { const int tt = t + j - 1; const bool in = tt >= lo && tt < hi; cmask[i][j] = in ? 1.f : 0.f; const bf16* z2 = zb + (size_t)(in ? m + j - 1 : m) * ZBW;
        cc[i][j] = *(const v2u*)(z2 + ZB_CC + 4 * lane); cx[i][j] = *(const v2u*)(z2 + ZB_CX + 4 * lane); }
      cb[i] = *(const v2u*)(zr + ZB_CB + 4 * lane); }
#pragma unroll
    for (int i = 0; i < RB; ++i) { const int m = mr[i]; const int b = m / NTOK, t = m % NTOK, tile = t >> 6, rr = t & 63; const bool okr = ok[i];
      { const float xv = bf2f(kpe[i]); const float xp = get_x16(xv, lane); float cs, sn; rope_cs<32>(t, lane & 15, cs, sn);
        const float o = (lane & 16) ? (xp * sn + xv * cs) : (xv * cs - xp * sn); const bf16 ob = (bf16)f2bf(o);
        if (lane < 32 && okr) {
#pragma unroll
          for (int h = 0; h < 4; ++h) ((bf16*)(F.ws + WS_KM + ((size_t)(b * 4 + h) * NKT + tile) * 12288))[(8 + (lane >> 3)) * 512 + krow(rr) * 8 + (lane & 7)] = ob; } }
      float cs64, sn64; rope_cs<64>(t, lane & 31, cs64, sn64);
#pragma unroll
      for (int h = 0; h < 4; ++h) { const float x0 = bf2f(gqv[i][h]); const float rinv = rsqrtf(wave_sum(x0 * x0) * (1.f / 64.f) + EPS); const float xv = x0 * rinv * gq;
        const float xp = get_x32(xv, lane); const float o = ((lane & 32) ? (xp * sn64 + xv * cs64) : (xv * cs64 - xp * sn64)) * QSCALE_D;
        if (okr) ((bf16*)(F.ws + WS_QD))[((size_t)(b * 4 + h) * NTOK + t) * 64 + lane] = (bf16)f2bf(o); }
#pragma unroll
      for (int h = 0; h < 2; ++h) { const float x0 = bf2f(gkv[i][h]); const float rinv = rsqrtf(wave_sum(x0 * x0) * (1.f / 64.f) + EPS); const float xv = x0 * rinv * gk;
        const float xp = get_x32(xv, lane); const float o = (lane & 32) ? (xp * sn64 + xv * cs64) : (xv * cs64 - xp * sn64);
        if (okr) { ((bf16*)(F.ws + WS_KD + ((size_t)(b * 2 + h) * NKT + tile) * 8192))[(lane >> 3) * 512 + krow(rr) * 8 + (lane & 7)] = (bf16)f2bf(o);
          *(bf16*)(F.ws + WS_VD + ((size_t)(b * 2 + h) * NKT + tile) * 8192 + v_st<2>(rr, lane)) = gvv[i][h]; } }
      { float a[4] = {0.f, 0.f, 0.f, 0.f};
#pragma unroll
        for (int j = 0; j < 3; ++j) { const float mk_ = cmask[i][j]; const v2u c1 = cc[i][j], c2 = cx[i][j];
          a[0] += mk_ * wcv[j][0] * bflo(c1.x) * bflo(c2.x); a[1] += mk_ * wcv[j][1] * bfhi(c1.x) * bfhi(c2.x); a[2] += mk_ * wcv[j][2] * bflo(c1.y) * bflo(c2.y); a[3] += mk_ * wcv[j][3] * bfhi(c1.y) * bfhi(c2.y); }
        v2u o; o.x = pk2(bflo(cb[i].x) * a[0], bfhi(cb[i].x) * a[1]); o.y = pk2(bflo(cb[i].y) * a[2], bfhi(cb[i].y) * a[3]);
        if (okr) *(v2u*)(Y + (size_t)m * D + 512 + 4 * lane) = o; } }
  }
}
template <int NWID> __device__ __forceinline__ float seg_rinv(const bf16* seg, int fq) {
  float ss = 0.f;
#pragma unroll
  for (int i = 0; i < NWID / 32; ++i) { const v4u w = *(const v4u*)(seg + fq * (NWID / 4) + i * 8);
    ss += bflo(w.x) * bflo(w.x) + bfhi(w.x) * bfhi(w.x) + bflo(w.y) * bflo(w.y) + bfhi(w.y) * bfhi(w.y) + bflo(w.z) * bflo(w.z) + bfhi(w.z) * bfhi(w.z) + bflo(w.w) * bflo(w.w) + bfhi(w.w) * bfhi(w.w); }
  ss = sum_x16(ss); ss = sum_x32(ss);
  return rsqrtf(ss * (1.f / NWID) + EPS);
}
struct EpiQm {
  static constexpr bool PERM = true;
  const float* rss; bf16* QM;
  __device__ __forceinline__ void operator()(const f32x4 (&acc)[2][2][4][2], const Unit& u, int wr, int wc, int fr, int fq) const {
    float scv[2][4];
    { f32x4 p4v[2][4];
#pragma unroll
      for (int ai = 0; ai < 2; ++ai)
#pragma unroll
        for (int m = 0; m < 4; ++m) p4v[ai][m] = *(const f32x4*)(rss + (size_t)(u.pm * 256 + ai * 128 + wr * 64 + m * 16 + fr) * 8);
#pragma unroll
      for (int ai = 0; ai < 2; ++ai)
#pragma unroll
        for (int m = 0; m < 4; ++m) scv[ai][m] = rsqrtf(((p4v[ai][m][0] + p4v[ai][m][1]) + (p4v[ai][m][2] + p4v[ai][m][3])) * (1.f / 256.f) + EPS) * QSCALE_M; }
    if (u.pn == 0) {
#pragma unroll
      for (int ai = 0; ai < 2; ++ai)
#pragma unroll
        for (int m = 0; m < 4; ++m) { const int r = u.pm * 256 + ai * 128 + wr * 64 + m * 16 + fr; const int b = r / NTOK, t = r % NTOK;
          const float sc = scv[ai][m];
#pragma unroll
          for (int bj = 0; bj < 2; ++bj) { const int h = 2 * bj + (wc >> 1), d = 32 * (wc & 1) + 8 * fq; const f32x4 v0 = acc[ai][bj][m][0] * sc, v1 = acc[ai][bj][m][1] * sc;
            v4u w; w.x = cvt_pk_bf16(v0[0], v0[1]); w.y = cvt_pk_bf16(v0[2], v0[3]); w.z = cvt_pk_bf16(v1[0], v1[1]); w.w = cvt_pk_bf16(v1[2], v1[3]);
            *(v4u*)(QM + ((size_t)(b * 4 + h) * NTOK + t) * 96 + d) = w; } }
    } else {
#pragma unroll
      for (int ai = 0; ai < 2; ++ai)
#pragma unroll
        for (int m = 0; m < 4; ++m) { const int r = u.pm * 256 + ai * 128 + wr * 64 + m * 16 + fr; const int b = r / NTOK, t = r % NTOK;
          const float sc = scv[ai][m];
          const int h = wc; const f32x4 x1 = acc[ai][0][m][0] * sc, x2 = acc[ai][0][m][1] * sc; float o1[4], o2[4];
#pragma unroll
          for (int e = 0; e < 4; ++e) { float cs, sn; rope_cs<32>(t, 4 * fq + e, cs, sn); o1[e] = x1[e] * cs - x2[e] * sn; o2[e] = x1[e] * sn + x2[e] * cs; }
          bf16* q = QM + ((size_t)(b * 4 + h) * NTOK + t) * 96 + 64 + 4 * fq;
          v2u w1; w1.x = cvt_pk_bf16(o1[0], o1[1]); w1.y = cvt_pk_bf16(o1[2], o1[3]); *(v2u*)q = w1;
          v2u w2; w2.x = cvt_pk_bf16(o2[0], o2[1]); w2.y = cvt_pk_bf16(o2[2], o2[3]); *(v2u*)(q + 16) = w2; }
    }
  }
};
struct EpiKVm {
  static constexpr bool PERM = true;
  const float* rss; unsigned char* ws;
  __device__ __forceinline__ void operator()(const f32x4 (&acc)[2][2][4][2], const Unit& u, int wr, int wc, int fr, int fq) const {
    float scv[2][4];
    { f32x4 p4v[2][4];
#pragma unroll
      for (int ai = 0; ai < 2; ++ai)
#pragma unroll
        for (int m = 0; m < 4; ++m) p4v[ai][m] = *(const f32x4*)(rss + (size_t)(u.pm * 256 + ai * 128 + wr * 64 + m * 16 + fr) * 8 + 4);
#pragma unroll
      for (int ai = 0; ai < 2; ++ai)
#pragma unroll
        for (int m = 0; m < 4; ++m) scv[ai][m] = rsqrtf(((p4v[ai][m][0] + p4v[ai][m][1]) + (p4v[ai][m][2] + p4v[ai][m][3])) * (1.f / 128.f) + EPS); }
    const bool isk = __builtin_amdgcn_readfirstlane(wc) < 2;
    const size_t tileB = isk ? 12288 : 8192; unsigned char* base = ws + (isk ? WS_KM : WS_VM);
#pragma unroll
    for (int ai = 0; ai < 2; ++ai)
#pragma unroll
      for (int m = 0; m < 4; ++m) { const int r = u.pm * 256 + ai * 128 + wr * 64 + m * 16 + fr; const int b = r / NTOK, t = r % NTOK, tile = t >> 6, rr = t & 63;
        const float sc = scv[ai][m];
        const int inoff = isk ? (4 * wc + fq) * 1024 + krow(rr) * 16 : v_st<2>(rr, 32 * (wc - 2) + 8 * fq);
#pragma unroll
        for (int bj = 0; bj < 2; ++bj) { const int h = 2 * u.pn + bj; const f32x4 v0 = acc[ai][bj][m][0] * sc, v1 = acc[ai][bj][m][1] * sc;
          v4u w; w.x = cvt_pk_bf16(v0[0], v0[1]); w.y = cvt_pk_bf16(v0[2], v0[3]); w.z = cvt_pk_bf16(v1[0], v1[1]); w.w = cvt_pk_bf16(v1[2], v1[3]);
          *(v4u*)(base + ((size_t)(b * 4 + h) * NKT + tile) * tileB + inoff) = w; } }
  }
};
struct SliceSched {
  TileOrder o; const char* A; const char* B;
  __device__ __forceinline__ bool next(int i, Unit& u) const { int pm, pn; if (!o.tile(i, pm, pn)) return false; u.pm = pm; u.pn = pn; u.aux = 0; u.a = A + (size_t)pm * 256 * ZBW * 2; u.b = B + (size_t)pn * 256 * 512; return true; }
  __device__ __forceinline__ void a_ready(const Unit&, int) const {}
};
__device__ __forceinline__ void phase_b_chunkmix(Ctx& F, const Args& A, int l, const int widx, const int nw) {
  const int lane = F.lane, wave = F.wave, r32 = lane & 31, hi = lane >> 5;
  const bf16* zb = (const bf16*)(F.ws + WS_ZB); bf16* Y = (bf16*)(F.ws + WS_Y); const bf16* wsg = (const bf16*)(F.ws + WS_WSGU + l * SZ_WSGU1);
  const float* sgu_gain = A.in[7] + l * 256; const float* b_s = A.in[9] + l * 4 * 128;
  const float g0 = sgu_gain[4 * lane], g1 = sgu_gain[4 * lane + 1], g2 = sgu_gain[4 * lane + 2], g3 = sgu_gain[4 * lane + 3];
  LAS unsigned char* img = F.lds;
  const int g = wave >> 1, ph = wave & 1;
  for (int ch = widx; ch < T / 128; ch += nw) {
    const int m0 = ch * 128;
    __syncthreads();
    v2u avr[16];
#pragma unroll
    for (int i = 0; i < 16; ++i) avr[i] = *(const v2u*)(zb + (size_t)(m0 + wave + NWAVES * i) * ZBW + ZB_AV + 4 * lane);
#pragma unroll
    for (int i = 0; i < 16; ++i) { const int q = wave + NWAVES * i; const v2u w = avr[i];
      const float a0 = gelu_tanh(bflo(w.x)), a1 = gelu_tanh(bfhi(w.x)), a2 = gelu_tanh(bflo(w.y)), a3 = gelu_tanh(bfhi(w.y));
      const float rinv = rsqrtf(wave_sum(a0 * a0 + a1 * a1 + a2 * a2 + a3 * a3) * (1.f / 256.f) + EPS);
      v2u o; o.x = pk2(a0 * rinv * g0, a1 * rinv * g1); o.y = pk2(a2 * rinv * g2, a3 * rinv * g3);
      *(LAS v2u*)(img + v_st<8>(q, 4 * lane)) = o; }
    __syncthreads();
    f32x16 acc[2][2];
#pragma unroll
    for (int a = 0; a < 2; ++a)
#pragma unroll
      for (int c = 0; c < 2; ++c) acc[a][c] = f32x16{};
    const int vb = (int)(uintptr_t)img + v_rd_base(lane) + (2 * g) * 512;
    const bf16* wrow = wsg + ((size_t)g * 128 + 64 * ph + r32) * 128 + 8 * hi;
#define CM_STEP(KS) do { const bf16x8 a0 = *(const bf16x8*)(wrow + 16 * (KS)), a1 = *(const bf16x8*)(wrow + 32 * 128 + 16 * (KS)); \
      const s16x4 l0 = tr_read<v_rd_off<8>(0, KS, 0)>(vb), h0 = tr_read<v_rd_off<8>(0, KS, 1)>(vb), l1 = tr_read<v_rd_off<8>(1, KS, 0)>(vb), h1 = tr_read<v_rd_off<8>(1, KS, 1)>(vb); \
      asm volatile("s_waitcnt lgkmcnt(0)" ::: "memory"); SBAR(); \
      const bf16x8 b0 = (bf16x8){l0[0], l0[1], l0[2], l0[3], h0[0], h0[1], h0[2], h0[3]}, b1 = (bf16x8){l1[0], l1[1], l1[2], l1[3], h1[0], h1[1], h1[2], h1[3]}; \
      acc[0][0] = __builtin_amdgcn_mfma_f32_32x32x16_bf16(a0, b0, acc[0][0], 0, 0, 0); acc[0][1] = __builtin_amdgcn_mfma_f32_32x32x16_bf16(a0, b1, acc[0][1], 0, 0, 0); \
      acc[1][0] = __builtin_amdgcn_mfma_f32_32x32x16_bf16(a1, b0, acc[1][0], 0, 0, 0); acc[1][1] = __builtin_amdgcn_mfma_f32_32x32x16_bf16(a1, b1, acc[1][1], 0, 0, 0); } while (0)
    CM_STEP(0); CM_STEP(1); CM_STEP(2); CM_STEP(3); CM_STEP(4); CM_STEP(5); CM_STEP(6); CM_STEP(7);
#undef CM_STEP
#pragma unroll
    for (int pt = 0; pt < 2; ++pt) { bf16 auv[16][2]; float bsv[16];
#pragma unroll
      for (int r = 0; r < 16; ++r) { const int p = 64 * ph + 32 * pt + crow(r, hi); bsv[r] = b_s[g * 128 + p];
#pragma unroll
        for (int cb = 0; cb < 2; ++cb) auv[r][cb] = zb[(size_t)(m0 + p) * ZBW + ZB_AU + 64 * g + 32 * cb + r32]; }
#pragma unroll
      for (int r = 0; r < 16; ++r) { const int p = 64 * ph + 32 * pt + crow(r, hi);
#pragma unroll
        for (int cb = 0; cb < 2; ++cb) { const int c = 64 * g + 32 * cb + r32; const float au = gelu_tanh(bf2f(auv[r][cb]));
          Y[(size_t)(m0 + p) * D + c] = (bf16)f2bf(au * (acc[pt][cb][r] + bsv[r])); } } }
  }
  __syncthreads();
}
constexpr float ATT_THR = 8.f;
template <bool FIRST> __device__ __forceinline__ void att_partialSM(f32x16& p0, f32x16& p1, float& m_reg, float& alpha, f32x16& nm) {
  float mx0 = fmaxf(fmaxf(p0[0], p0[1]), p0[2]), mx1 = fmaxf(fmaxf(p0[8], p0[9]), p0[10]), mx2 = fmaxf(fmaxf(p1[0], p1[1]), p1[2]), mx3 = fmaxf(fmaxf(p1[8], p1[9]), p1[10]);
  mx0 = fmaxf(fmaxf(mx0, p0[3]), p0[4]); mx1 = fmaxf(fmaxf(mx1, p0[11]), p0[12]); mx2 = fmaxf(fmaxf(mx2, p1[3]), p1[4]); mx3 = fmaxf(fmaxf(mx3, p1[11]), p1[12]);
  mx0 = fmaxf(fmaxf(mx0, p0[5]), p0[6]); mx1 = fmaxf(fmaxf(mx1, p0[13]), p0[14]); mx2 = fmaxf(fmaxf(mx2, p1[5]), p1[6]); mx3 = fmaxf(fmaxf(mx3, p1[13]), p1[14]);
  mx0 = fmaxf(fmaxf(mx0, p0[7]), p0[15]); mx2 = fmaxf(fmaxf(mx2, p1[7]), p1[15]);
  float pmax = fmaxf(fmaxf(mx0, mx1), fmaxf(mx2, mx3));
  { auto rr = __builtin_amdgcn_permlane32_swap(__float_as_uint(pmax), opq(__float_as_uint(pmax)), false, false); const unsigned r0 = rr[0], r1 = rr[1]; pmax = fmaxf(__uint_as_float(r0), __uint_as_float(r1)); }
  if (FIRST) { m_reg = pmax; alpha = 1.f;
#pragma unroll
    for (int r = 0; r < 16; ++r) { p0[r] -= pmax; p1[r] -= pmax; nm[r] = -pmax; } }
  else if (__builtin_expect(__all(pmax <= ATT_THR), 1)) { alpha = 1.f; }
  else { const float d = fmaxf(pmax, 0.f); alpha = __builtin_amdgcn_exp2f(-d); m_reg += d; const float nmv = -m_reg;
#pragma unroll
    for (int r = 0; r < 16; ++r) { p0[r] -= d; p1[r] -= d; nm[r] = nmv; } }
#pragma unroll
  for (int r = 0; r < 16; ++r) p0[r] = __builtin_amdgcn_exp2f(p0[r]);
}
__device__ __forceinline__ void att_finishSM(f32x16& p0, f32x16& p1, float alpha, float& l_reg, bf16x8& pa0, bf16x8& pa1, bf16x8& pa2, bf16x8& pa3) {
#pragma unroll
  for (int r = 0; r < 16; ++r) p1[r] = __builtin_amdgcn_exp2f(p1[r]);
  f32x2 sa = {p0[0], p0[1]}, sb = {p0[2], p0[3]}, sc = {p1[0], p1[1]}, sd = {p1[2], p1[3]};
#pragma unroll
  for (int r = 4; r < 16; r += 4) { sa += (f32x2){p0[r], p0[r + 1]}; sb += (f32x2){p0[r + 2], p0[r + 3]}; sc += (f32x2){p1[r], p1[r + 1]}; sd += (f32x2){p1[r + 2], p1[r + 3]}; }
  const f32x2 ps2 = (sa + sb) + (sc + sd);
  float ps = ps2[0] + ps2[1];
  { auto rr = __builtin_amdgcn_permlane32_swap(__float_as_uint(ps), opq(__float_as_uint(ps)), false, false); const unsigned r0 = rr[0], r1 = rr[1]; ps = __uint_as_float(r0) + __uint_as_float(r1); }
  l_reg = l_reg * alpha + ps;
#define PK4(P, BASE, OUT) do { v4u w = {cvt_pk_bf16(P[BASE + 0], P[BASE + 1]), cvt_pk_bf16(P[BASE + 2], P[BASE + 3]), cvt_pk_bf16(P[BASE + 4], P[BASE + 5]), cvt_pk_bf16(P[BASE + 6], P[BASE + 7])}; \
    OUT = __builtin_bit_cast(bf16x8, w); } while (0)
  PK4(p0, 0, pa0); PK4(p0, 8, pa1); PK4(p1, 0, pa2); PK4(p1, 8, pa3);
#undef PK4
}
template <int DK> __device__ __forceinline__ void att_qkt(f32x16& p0, f32x16& p1, const LAS unsigned char* Ks, const bf16x8* qr, int r32, int hi, const f32x16& nm) {
#pragma unroll
  for (int d0 = 0; d0 < DK / 16; ++d0) { const LAS unsigned char* kb = Ks + (2 * d0 + hi) * 1024 + r32 * 16;
    const bf16x8 b0 = *(const LAS bf16x8*)kb, b1 = *(const LAS bf16x8*)(kb + 512);
    if (d0 == 0) { p0 = __builtin_amdgcn_mfma_f32_32x32x16_bf16(b0, qr[d0], nm, 0, 0, 0); p1 = __builtin_amdgcn_mfma_f32_32x32x16_bf16(b1, qr[d0], nm, 0, 0, 0); }
    else { p0 = __builtin_amdgcn_mfma_f32_32x32x16_bf16(b0, qr[d0], p0, 0, 0, 0); p1 = __builtin_amdgcn_mfma_f32_32x32x16_bf16(b1, qr[d0], p1, 0, 0, 0); } }
}
template <int D0> __device__ __forceinline__ void att_pv_one(f32x16& od, int vb, bf16x8 pa0, bf16x8 pa1, bf16x8 pa2, bf16x8 pa3) {
  const s16x4 l0 = tr_read<v_rd_off<2>(D0, 0, 0)>(vb), h0 = tr_read<v_rd_off<2>(D0, 0, 1)>(vb), l1 = tr_read<v_rd_off<2>(D0, 1, 0)>(vb), h1 = tr_read<v_rd_off<2>(D0, 1, 1)>(vb);
  const s16x4 l2 = tr_read<v_rd_off<2>(D0, 2, 0)>(vb), h2 = tr_read<v_rd_off<2>(D0, 2, 1)>(vb), l3 = tr_read<v_rd_off<2>(D0, 3, 0)>(vb), h3 = tr_read<v_rd_off<2>(D0, 3, 1)>(vb);
  asm volatile("s_waitcnt lgkmcnt(0)" ::: "memory"); SBAR();
#define PK(Lx, Hx) (bf16x8){Lx[0], Lx[1], Lx[2], Lx[3], Hx[0], Hx[1], Hx[2], Hx[3]}
  od = __builtin_amdgcn_mfma_f32_32x32x16_bf16(pa0, PK(l0, h0), od, 0, 0, 0);
  od = __builtin_amdgcn_mfma_f32_32x32x16_bf16(pa1, PK(l1, h1), od, 0, 0, 0);
  od = __builtin_amdgcn_mfma_f32_32x32x16_bf16(pa2, PK(l2, h2), od, 0, 0, 0);
  od = __builtin_amdgcn_mfma_f32_32x32x16_bf16(pa3, PK(l3, h3), od, 0, 0, 0);
#undef PK
}
template <int DK>
__device__ __forceinline__ void attn_unit(LAS unsigned char* lds, const int tid, const bf16* __restrict__ Qb, const unsigned char* __restrict__ Kt, const unsigned char* __restrict__ Vt, const int NT, bf16* Ob) {
  constexpr int KB = DK * 128, ND = DK / 16;
  const int wid = __builtin_amdgcn_readfirstlane(tid >> 6), lane = tid & 63, r32 = lane & 31, hi = lane >> 5;
  LAS unsigned char* Vl = lds; LAS unsigned char* Kl = lds + 16384; LAS float* wsf = (LAS float*)(lds + 16384 + 2 * KB) + wid * 64; LAS float* li_l = wsf; LAS float* al_l = wsf + 32;
  LAS bf16* stg = (LAS bf16*)(lds + 16384 + 2 * KB + 2048) + wid * 2048;
  float m_reg = 0.f, l_reg = 0.f; f32x16 o[2] = {f32x16{}, f32x16{}}; f32x16 nm = f32x16{}; bf16x8 qr[ND];
  const bf16* Qw = Qb + (size_t)(wid * 32 + r32) * DK + hi * 8;
#pragma unroll
  for (int d0 = 0; d0 < ND; ++d0) qr[d0] = *(const bf16x8*)(Qw + d0 * 16);
  const bool has2 = (DK == 96) && (wid < 4);
  const int vb0 = (int)(uintptr_t)Vl + v_rd_base(lane);
  struct { v4u k0, k1, v; } sr_[2];
#define SLOAD(i, tl) do { const unsigned char* kp_ = Kt + (size_t)(tl) * KB + tid * 16; sr_[i].k0 = *(const v4u*)kp_; if (has2) sr_[i].k1 = *(const v4u*)(kp_ + 8192); sr_[i].v = *(const v4u*)(Vt + (size_t)(tl) * 8192 + tid * 16); } while (0)
#define SWRITE(b, i) do { *(LAS v4u*)(Kl + (b) * KB + tid * 16) = sr_[i].k0; if (has2) *(LAS v4u*)(Kl + (b) * KB + 8192 + tid * 16) = sr_[i].k1; *(LAS v4u*)(Vl + (b) * 8192 + tid * 16) = sr_[i].v; } while (0)
#define RESC(a) do { if (__any((a) < 1.f)) { if (hi == 0) al_l[r32] = (a); asm volatile("s_waitcnt lgkmcnt(0)" ::: "memory"); \
    _Pragma("unroll") for (int d = 0; d < 2; ++d) _Pragma("unroll") for (int r = 0; r < 16; ++r) o[d][r] *= al_l[crow(r, hi)]; } } while (0)
  f32x16 pA0, pA1, pB0, pB1; float alA, alB; bf16x8 pa0, pa1, pa2, pa3;
  SLOAD(0, 0); SWRITE(0, 0); __syncthreads();
  att_qkt<DK>(pA0, pA1, Kl, qr, r32, hi, nm); att_partialSM<true>(pA0, pA1, m_reg, alA, nm);
  SLOAD(1, 1); SLOAD(0, 2);
  SWRITE(1, 1); __syncthreads();
#pragma unroll 1
  for (int j = 1; j + 1 < NT; j += 2) {
    SBAR(); att_qkt<DK>(pB0, pB1, Kl + KB, qr, r32, hi, nm);
    att_finishSM(pA0, pA1, alA, l_reg, pa0, pa1, pa2, pa3); SBAR();
    SLOAD(1, j + 2); SBAR();
    att_pv_one<0>(o[0], vb0, pa0, pa1, pa2, pa3); att_pv_one<1>(o[1], vb0, pa0, pa1, pa2, pa3); att_partialSM<false>(pB0, pB1, m_reg, alB, nm);
    __syncthreads(); SWRITE(0, 0);
    RESC(alB); __syncthreads();
    SBAR(); att_qkt<DK>(pA0, pA1, Kl, qr, r32, hi, nm);
    att_finishSM(pB0, pB1, alB, l_reg, pa0, pa1, pa2, pa3); SBAR();
    if (j + 3 < NT) SLOAD(0, j + 3); SBAR();
    att_pv_one<0>(o[0], vb0 + 8192, pa0, pa1, pa2, pa3); att_pv_one<1>(o[1], vb0 + 8192, pa0, pa1, pa2, pa3); att_partialSM<false>(pA0, pA1, m_reg, alA, nm);
    __syncthreads(); SWRITE(1, 1);
    RESC(alA); __syncthreads();
  }
  SBAR(); att_qkt<DK>(pB0, pB1, Kl + KB, qr, r32, hi, nm);
  att_finishSM(pA0, pA1, alA, l_reg, pa0, pa1, pa2, pa3); SBAR();
  att_pv_one<0>(o[0], vb0, pa0, pa1, pa2, pa3); att_pv_one<1>(o[1], vb0, pa0, pa1, pa2, pa3); att_partialSM<false>(pB0, pB1, m_reg, alB, nm);
  __syncthreads(); RESC(alB);
  att_finishSM(pB0, pB1, alB, l_reg, pa0, pa1, pa2, pa3); SBAR();
  att_pv_one<0>(o[0], vb0 + 8192, pa0, pa1, pa2, pa3); att_pv_one<1>(o[1], vb0 + 8192, pa0, pa1, pa2, pa3);
  if (hi == 0) li_l[r32] = l_reg; asm volatile("s_waitcnt lgkmcnt(0)" ::: "memory");
#pragma unroll
  for (int r = 0; r < 16; ++r) { const float rl = __builtin_amdgcn_rcpf(li_l[crow(r, hi)]); const int orow = crow(r, hi);
    stg[orow * 64 + r32] = (bf16)f2bf(o[0][r] * rl); stg[orow * 64 + 32 + r32] = (bf16)f2bf(o[1][r] * rl); }
  asm volatile("s_waitcnt lgkmcnt(0)" ::: "memory");
#pragma unroll
  for (int i = 0; i < 4; ++i) { const int row = i * 8 + (lane >> 3), ch = lane & 7; const v4u v = *(const LAS v4u*)(stg + row * 64 + ch * 8); *(v4u*)(Ob + (size_t)(wid * 32 + row) * D + ch * 8) = v; }
#undef SLOAD
#undef SWRITE
#undef RESC
}
template <int DK>
__device__ __forceinline__ void attn_unit2(LAS unsigned char* lds, const int tid, const bf16* __restrict__ Qb, const unsigned char* __restrict__ Kt, const unsigned char* __restrict__ Vt, const int NT, bf16* Ob) {
  constexpr int KB = DK * 128, ND = DK / 16, NKC = KB / 4096;
  const int wid = __builtin_amdgcn_readfirstlane(tid >> 6), half = wid >> 2, w4 = wid & 3, lane = tid & 63, r32 = lane & 31, hi = lane >> 5, tl = tid & 255;
  LAS unsigned char* Vl = lds + half * 20480; LAS unsigned char* Kl = Vl + 8192;
  LAS float* wsf = (LAS float*)(lds + 40960) + wid * 64; LAS float* li_l = wsf; LAS float* al_l = wsf + 32;
  LAS bf16* stg = (LAS bf16*)(lds + 43008) + wid * 2048;
  float m_reg = 0.f, l_reg = 0.f, alpha = 1.f; f32x16 o[2] = {f32x16{}, f32x16{}}; f32x16 nm = f32x16{}; bf16x8 qr[ND];
  const int qrow = half * 128 + w4 * 32;
  const bf16* Qw = Qb + (size_t)(qrow + r32) * DK + hi * 8;
#pragma unroll
  for (int d0 = 0; d0 < ND; ++d0) qr[d0] = *(const bf16x8*)(Qw + d0 * 16);
  const int vb0 = (int)(uintptr_t)Vl + v_rd_base(lane);
  v4u skA[NKC], svA[2], skB[NKC], svB[2];
#define TLOAD(SK, SV, t) do { if ((t) + 1 < NT) { _Pragma("unroll") for (int c = 0; c < NKC; ++c) SK[c] = *(const v4u*)(Kt + (size_t)((t) + 1) * KB + c * 4096 + tl * 16); } \
    if ((t) < NT) { _Pragma("unroll") for (int c = 0; c < 2; ++c) SV[c] = *(const v4u*)(Vt + (size_t)(t) * 8192 + c * 4096 + tl * 16); } } while (0)
#define TWRITE(SK, SV, t) do { if ((t) + 1 < NT) { _Pragma("unroll") for (int c = 0; c < NKC; ++c) *(LAS v4u*)(Kl + c * 4096 + tl * 16) = SK[c]; } \
    _Pragma("unroll") for (int c = 0; c < 2; ++c) *(LAS v4u*)(Vl + c * 4096 + tl * 16) = SV[c]; } while (0)
#define RESC(a) do { if (__any((a) < 1.f)) { if (hi == 0) al_l[r32] = (a); asm volatile("s_waitcnt lgkmcnt(0)" ::: "memory"); \
    _Pragma("unroll") for (int d = 0; d < 2; ++d) _Pragma("unroll") for (int r = 0; r < 16; ++r) o[d][r] *= al_l[crow(r, hi)]; } } while (0)
#define XSEG(i) do { SBAR(); att_qkt<DK>(p0, p1, Kl, qr, r32, hi, nm); SBAR(); att_pv_one<0>(o[0], vb0, pa0, pa1, pa2, pa3); att_pv_one<1>(o[1], vb0, pa0, pa1, pa2, pa3); } while (0)
#define YSEG() do { att_partialSM<false>(p0, p1, m_reg, alpha, nm); att_finishSM(p0, p1, alpha, l_reg, pa0, pa1, pa2, pa3); RESC(alpha); } while (0)
  f32x16 p0, p1; bf16x8 pa0, pa1, pa2, pa3;
  if (half == 1) __syncthreads();
  { _Pragma("unroll") for (int c = 0; c < NKC; ++c) skB[c] = *(const v4u*)(Kt + c * 4096 + tl * 16);
    TLOAD(skA, svA, 0);
    _Pragma("unroll") for (int c = 0; c < NKC; ++c) *(LAS v4u*)(Kl + c * 4096 + tl * 16) = skB[c]; }
  __syncthreads();
  TLOAD(skB, svB, 1);
  att_qkt<DK>(p0, p1, Kl, qr, r32, hi, nm);
  __syncthreads();
  att_partialSM<true>(p0, p1, m_reg, alpha, nm); att_finishSM(p0, p1, alpha, l_reg, pa0, pa1, pa2, pa3);
  TWRITE(skA, svA, 0);
  __syncthreads();
#pragma unroll 1
  for (int i = 1; i < NT; i += 2) {
    TLOAD(skA, svA, i + 1);
    XSEG(i);
    __syncthreads();
    YSEG(); TWRITE(skB, svB, i);
    __syncthreads();
    if (i + 1 < NT) {
      TLOAD(skB, svB, i + 2);
      XSEG(i + 1);
      __syncthreads();
      YSEG(); TWRITE(skA, svA, i + 1);
      __syncthreads();
    }
  }
  att_pv_one<0>(o[0], vb0, pa0, pa1, pa2, pa3); att_pv_one<1>(o[1], vb0, pa0, pa1, pa2, pa3);
  if (half == 0) __syncthreads();
  if (hi == 0) li_l[r32] = l_reg; asm volatile("s_waitcnt lgkmcnt(0)" ::: "memory");
#pragma unroll
  for (int r = 0; r < 16; ++r) { const float rl = __builtin_amdgcn_rcpf(li_l[crow(r, hi)]); const int orow = crow(r, hi);
    stg[orow * 64 + r32] = (bf16)f2bf(o[0][r] * rl); stg[orow * 64 + 32 + r32] = (bf16)f2bf(o[1][r] * rl); }
  asm volatile("s_waitcnt lgkmcnt(0)" ::: "memory");
#pragma unroll
  for (int i = 0; i < 4; ++i) { const int row = i * 8 + (lane >> 3), ch = lane & 7; const v4u v = *(const LAS v4u*)(stg + row * 64 + ch * 8); *(v4u*)(Ob + (size_t)(qrow + row) * D + ch * 8) = v; }
#undef TLOAD
#undef TWRITE
#undef RESC
#undef XSEG
#undef YSEG
}
__device__ __forceinline__ void phase_attn(Ctx& F, const Args& A, bool skipctx = false) {
  for (int i = 0;; ++i) {
    const int Lx = i * F.G + (int)blockIdx.x; if (Lx >= (skipctx ? 512 : 576)) break;
    int kind, b, h, qb;
    if (Lx < 512) { kind = Lx >> 8; const int rem = Lx & 255; b = rem & 7; const int idx = rem >> 3; h = idx >> 3; qb = 1 + (idx & 7); }
    else { const int ll = Lx - 512; b = ll & 7; const int j = ll >> 3; kind = j >> 2; h = j & 3; qb = 0; }
    const int NT = qb == 0 ? 4 : NKT;
    bf16* Ob = (bf16*)(F.ws + WS_Y) + (size_t)(b * NTOK + qb * 256) * D + (kind == 0 ? 256 : 768) + h * 64;
    if (kind == 0) attn_unit<96>(F.lds, F.tid, (const bf16*)(F.ws + WS_QM) + ((size_t)(b * 4 + h) * NTOK + qb * 256) * 96, (const unsigned char*)(F.ws + WS_KM + (size_t)(b * 4 + h) * NKT * 12288), (const unsigned char*)(F.ws + WS_VM + (size_t)(b * 4 + h) * NKT * 8192), NT, Ob);
    else attn_unit<64>(F.lds, F.tid, (const bf16*)(F.ws + WS_QD) + ((size_t)(b * 4 + h) * NTOK + qb * 256) * 64, (const unsigned char*)(F.ws + WS_KD + (size_t)(b * 2 + (h >> 1)) * NKT * 8192), (const unsigned char*)(F.ws + WS_VD + (size_t)(b * 2 + (h >> 1)) * NKT * 8192), NT, Ob);
  }
  __syncthreads();
}
__device__ __forceinline__ void phase_b(Ctx& F, const Args& A, int l) {
  phase_b_rows(F, A, l);
  refresh_ctx(F, A);
  const bool split = F.G == 256; const int c = (int)blockIdx.x;
  if (split) {
    if (c < 144) { phase_b_chunkmix(F, A, l, c, 144); refresh_ctx(F, A); }
    const int cq = c >= 144 ? c - 144 : (c < 32 ? 112 + c : -1), ckv = c >= 144 ? c - 144 : (c >= 32 && c < 64 ? 80 + c : -1);
    if (cq >= 0) { SliceSched S; S.o.init(NROWT, 2, 144, cq); S.A = (const char*)(F.ws + WS_ZB) + ZB_MQ * 2; S.B = (const char*)(F.ws + WS_WUQ + l * SZ_WUQ1);
      EpiQm E{(const float*)(F.ws + WS_RSS), (bf16*)(F.ws + WS_QM)}; gemm_phase<EpiQm, SliceSched, true>(F.lds, F.tid, ZBW * 2, 512, 256, S, E); }
    refresh_ctx(F, A);
    if (ckv >= 0) { SliceSched S; S.o.init(NROWT, 2, 144, ckv); S.A = (const char*)(F.ws + WS_ZB) + ZB_MKV * 2; S.B = (const char*)(F.ws + WS_WUKV + l * SZ_WUKV1);
      EpiKVm E{(const float*)(F.ws + WS_RSS), (unsigned char*)F.ws}; gemm_phase<EpiKVm, SliceSched, true>(F.lds, F.tid, ZBW * 2, 512, 256, S, E); }
    refresh_ctx(F, A);
  } else {
    { SliceSched S; S.o.init(NROWT, 2, F.G, c); S.A = (const char*)(F.ws + WS_ZB) + ZB_MQ * 2; S.B = (const char*)(F.ws + WS_WUQ + l * SZ_WUQ1);
      EpiQm E{(const float*)(F.ws + WS_RSS), (bf16*)(F.ws + WS_QM)}; gemm_phase<EpiQm, SliceSched, true>(F.lds, F.tid, ZBW * 2, 512, 256, S, E); }
    refresh_ctx(F, A);
    { SliceSched S; S.o.init(NROWT, 2, F.G, c); S.A = (const char*)(F.ws + WS_ZB) + ZB_MKV * 2; S.B = (const char*)(F.ws + WS_WUKV + l * SZ_WUKV1);
      EpiKVm E{(const float*)(F.ws + WS_RSS), (unsigned char*)F.ws}; gemm_phase<EpiKVm, SliceSched, true>(F.lds, F.tid, ZBW * 2, 512, 256, S, E); }
    refresh_ctx(F, A);
    phase_b_chunkmix(F, A, l, c, F.G);
  }
}
}
namespace mk {
__device__ __forceinline__ void phase_norm_mod(Ctx& F, const Args& A, int l, bool dry = false) {
  const int gw = F.vcu * NWAVES + F.wave, NGW = F.G * NWAVES, lane = F.lane;
  if (F.vcu < 9 && !dry) {
    const int r = F.vcu; const float* sh = (const float*)(F.ws + WS_MOD) + (size_t)l * 9 * 6 * D + (size_t)r * 6 * D + 3 * D;
    const float* wgr = A.in[21] + (size_t)l * D * 4; const float* bgr = A.in[22] + l * 4; const float* wer = A.in[23] + (size_t)l * D * 32; const float* ber = A.in[24] + l * 32;
    for (int j = F.wave; j < 36; j += NWAVES) { float s = 0.f;
#pragma unroll 4
      for (int i = 0; i < 16; ++i) { const int k = lane + 64 * i; s += sh[k] * (j < 4 ? wgr[k * 4 + j] : wer[k * 32 + (j - 4)]); }
      s = wave_sum(s); if (lane == 0) ((float*)(F.ws + WS_CJ))[l * (9 * 36) + r * 36 + j] = s + (j < 4 ? bgr[j] : ber[j - 4]); } }
  bf16* hs = (bf16*)(F.ws + WS_HS); bf16* hn = (bf16*)(F.ws + WS_HN); const float* mod = (const float*)(F.ws + WS_MOD) + (size_t)l * 9 * 6 * D;
  const int* tok_e = (const int*)(F.ws + WS_TOKE); const int* tok_r = (const int*)(F.ws + WS_TOKR); const float* tok_w = (const float*)(F.ws + WS_TOKW); const bf16* fs = (const bf16*)(F.ws + WS_FS);
  const LAS int* ps = (const LAS int*)(F.lds + XSCR_OFF);
  int ne0 = 0, ne1 = 0, nr0 = 0, nr1 = 0; float nw0 = 0.f, nw1 = 0.f;
  if (l > 0 && !dry && gw < T) { ne0 = tok_e[2 * gw]; ne1 = tok_e[2 * gw + 1]; nr0 = tok_r[2 * gw]; nr1 = tok_r[2 * gw + 1]; nw0 = tok_w[2 * gw]; nw1 = tok_w[2 * gw + 1]; }
  for (int m = gw; m < T; m += NGW) {
    const int ce0 = ne0, ce1 = ne1, cr0 = nr0, cr1 = nr1; const float cw0 = nw0, cw1 = nw1;
    if (l > 0 && !dry && m + NGW < T) { const int mn = m + NGW; ne0 = tok_e[2 * mn]; ne1 = tok_e[2 * mn + 1]; nr0 = tok_r[2 * mn]; nr1 = tok_r[2 * mn + 1]; nw0 = tok_w[2 * mn]; nw1 = tok_w[2 * mn + 1]; }
    const int b = m / NTOK, t = m % NTOK, r = t < NCTX ? 8 : b;
    const float4* xr = t < NCTX ? (const float4*)(A.in[2] + ((size_t)b * NCTX + t) * D) : (const float4*)(A.in[0] + ((size_t)b * NLAT + (t - NCTX)) * D); const v2u* hr = (const v2u*)(hs + (size_t)m * D);
    const float4* sh = (const float4*)(mod + (size_t)r * 6 * D); const float4* sc = sh + D / 4;
    float4 v[4]; float ss = 0.f;
    float4 sca[4], sha[4];
#pragma unroll
    for (int j = 0; j < 4; ++j) { sca[j] = sc[lane + 64 * j]; sha[j] = sh[lane + 64 * j]; }
    if (l == 0 && !dry) {
#pragma unroll
      for (int j = 0; j < 4; ++j) v[j] = xr[lane + 64 * j]; }
    else {
#pragma unroll
      for (int j = 0; j < 4; ++j) { const v2u w = hr[lane + 64 * j]; v[j] = make_float4(bflo(w.x), bfhi(w.x), bflo(w.y), bfhi(w.y)); } }
    if (l > 0 && !dry) { const int s0 = ps[ce0] + cr0, s1 = ps[ce1] + cr1; const float w0 = cw0, w1 = cw1; const float4* g5 = (const float4*)(mod - (size_t)9 * 6 * D + (size_t)r * 6 * D + 5 * D);
#pragma unroll
      for (int j = 0; j < 4; ++j) { const int c4 = lane + 64 * j; const v2u a = ((const v2u*)(fs + (size_t)s0 * D))[c4], bq = ((const v2u*)(fs + (size_t)s1 * D))[c4]; const float4 g = g5[c4];
        v[j].x += g.x * (w0 * bflo(a.x) + w1 * bflo(bq.x)); v[j].y += g.y * (w0 * bfhi(a.x) + w1 * bfhi(bq.x)); v[j].z += g.z * (w0 * bflo(a.y) + w1 * bflo(bq.y)); v[j].w += g.w * (w0 * bfhi(a.y) + w1 * bfhi(bq.y)); } }
#pragma unroll
    for (int j = 0; j < 4; ++j) { v2u w; w.x = pk2(v[j].x, v[j].y); w.y = pk2(v[j].z, v[j].w); ((v2u*)(hs + (size_t)m * D))[lane + 64 * j] = w;
      v[j] = make_float4(bflo(w.x), bfhi(w.x), bflo(w.y), bfhi(w.y)); ss += v[j].x * v[j].x + v[j].y * v[j].y + v[j].z * v[j].z + v[j].w * v[j].w; }
    const float rinv = rsqrtf(wave_sum(ss) * (1.f / D) + EPS);
#pragma unroll
    for (int j = 0; j < 4; ++j) { const float4 a = sca[j], s4 = sha[j];
      v2u o; o.x = pk2(v[j].x * rinv * (1.f + a.x) + s4.x, v[j].y * rinv * (1.f + a.y) + s4.y); o.y = pk2(v[j].z * rinv * (1.f + a.z) + s4.z, v[j].w * rinv * (1.f + a.w) + s4.w);
      ((v2u*)(hn + (size_t)m * D))[lane + 64 * j] = o;
      { const float h0 = v[j].x * rinv * (1.f + a.x) + s4.x, h1 = v[j].y * rinv * (1.f + a.y) + s4.y, h2 = v[j].z * rinv * (1.f + a.z) + s4.z, h3 = v[j].w * rinv * (1.f + a.w) + s4.w;
        int w8 = 0; w8 = __builtin_amdgcn_cvt_pk_fp8_f32(h0, h1, w8, false); w8 = __builtin_amdgcn_cvt_pk_fp8_f32(h2, h3, w8, true); ((int*)(F.ws + WS_HN8 + (size_t)m * P8))[lane + 64 * j] = w8; } }
  }
}
__device__ __forceinline__ void phase_final(Ctx& F, const Args& A) {
  const int gw = F.vcu * NWAVES + F.wave, NGW = F.G * NWAVES, lane = F.lane;
  const bf16* hs = (const bf16*)(F.ws + WS_HS); const float* mod = (const float*)(F.ws + WS_MOD) + (size_t)(L - 1) * 9 * 6 * D; const float4* fg = (const float4*)A.in[27];
  const int* tok_e = (const int*)(F.ws + WS_TOKE); const int* tok_r = (const int*)(F.ws + WS_TOKR); const float* tok_w = (const float*)(F.ws + WS_TOKW); const bf16* fs = (const bf16*)(F.ws + WS_FS);
  const LAS int* ps = (const LAS int*)(F.lds + XSCR_OFF);
  float4 fgv[4];
#pragma unroll
  for (int j = 0; j < 4; ++j) fgv[j] = fg[lane + 64 * j];
  int ne0 = 0, ne1 = 0, nr0 = 0, nr1 = 0; float nw0 = 0.f, nw1 = 0.f;
  if (gw < NB * NLAT) { const size_t mq = (size_t)(gw / NLAT) * NTOK + NCTX + gw % NLAT; ne0 = tok_e[2 * mq]; ne1 = tok_e[2 * mq + 1]; nr0 = tok_r[2 * mq]; nr1 = tok_r[2 * mq + 1]; nw0 = tok_w[2 * mq]; nw1 = tok_w[2 * mq + 1]; }
  for (int rI = gw; rI < NB * NLAT; rI += NGW) {
    const int b = rI / NLAT, tl = rI % NLAT; const size_t m = (size_t)b * NTOK + NCTX + tl;
    const int ce0 = ne0, ce1 = ne1, cr0 = nr0, cr1 = nr1; const float cw0 = nw0, cw1 = nw1;
    if (rI + NGW < NB * NLAT) { const int rn = rI + NGW; const size_t mq = (size_t)(rn / NLAT) * NTOK + NCTX + rn % NLAT; ne0 = tok_e[2 * mq]; ne1 = tok_e[2 * mq + 1]; nr0 = tok_r[2 * mq]; nr1 = tok_r[2 * mq + 1]; nw0 = tok_w[2 * mq]; nw1 = tok_w[2 * mq + 1]; }
    const v2u* xr = (const v2u*)(hs + m * D); float4 v[4]; float ss = 0.f;
    const int s0 = ps[ce0] + cr0, s1 = ps[ce1] + cr1; const float w0 = cw0, w1 = cw1; const float4* g5 = (const float4*)(mod + (size_t)b * 6 * D + 5 * D);
#pragma unroll
    for (int j = 0; j < 4; ++j) { const int c4 = lane + 64 * j; { const v2u w = xr[c4]; v[j] = make_float4(bflo(w.x), bfhi(w.x), bflo(w.y), bfhi(w.y)); } const v2u a = ((const v2u*)(fs + (size_t)s0 * D))[c4], bq = ((const v2u*)(fs + (size_t)s1 * D))[c4]; const float4 g = g5[c4];
      v[j].x += g.x * (w0 * bflo(a.x) + w1 * bflo(bq.x)); v[j].y += g.y * (w0 * bfhi(a.x) + w1 * bfhi(bq.x)); v[j].z += g.z * (w0 * bflo(a.y) + w1 * bflo(bq.y)); v[j].w += g.w * (w0 * bfhi(a.y) + w1 * bfhi(bq.y));
      ss += v[j].x * v[j].x + v[j].y * v[j].y + v[j].z * v[j].z + v[j].w * v[j].w; }
    const float rinv = rsqrtf(wave_sum(ss) * (1.f / D) + EPS);
#pragma unroll
    for (int j = 0; j < 4; ++j) { const float4 g = fgv[j]; float4 o; o.x = v[j].x * rinv * g.x; o.y = v[j].y * rinv * g.y; o.z = v[j].z * rinv * g.z; o.w = v[j].w * rinv * g.w; ((float4*)(A.out + (size_t)rI * D))[lane + 64 * j] = o; }
  }
}
constexpr int CW_BAR = 16384;
__global__ void __launch_bounds__(NTHR, 2) mk_kernel(Args a) {
  extern __shared__ __attribute__((aligned(16))) unsigned char lds_raw[];
  Ctx F; F.lds = (LAS unsigned char*)lds_raw; F.ws = (GAS unsigned char*)a.ws;
  { const int t0 = threadIdx.x; F.wave = __builtin_amdgcn_readfirstlane(t0 >> 6); }
  F.lane = (int)__builtin_amdgcn_mbcnt_hi(~0u, __builtin_amdgcn_mbcnt_lo(~0u, 0u)); F.tid = F.wave * 64 + F.lane;
  F.G = gridDim.x; { const int bx = blockIdx.x; F.vcu = (F.G % 8 == 0) ? (bx % 8) * (F.G / 8) + bx / 8 : bx; }
  volatile LAS unsigned* st = (volatile LAS unsigned*)(F.lds + MISC_OFF);
  if (F.tid < 4) st[F.tid] = 0u;
  __syncthreads();
  XcdBarrier bar = xcd_barrier_post((unsigned*)(F.ws + WS_CTL) + CW_BAR, st, F.tid == 0);
#define GRID_BAR() do { { unsigned char* w_ = a.ws; asm volatile("" : "+s"(w_)); unsigned x_ = bar.x; asm volatile("" : "+s"(x_)); bar.x = x_; bar.bar = (unsigned*)(w_ + WS_CTL) + CW_BAR; xcd_barrier(bar, F.tid == 0); F.ws = (GAS unsigned char*)w_; } \
    int wv_ = F.wave; asm volatile("" : "+s"(wv_)); F.wave = wv_; unsigned z_ = 0u; asm volatile("" : "+v"(z_)); const int l_ = (int)__builtin_amdgcn_mbcnt_hi(~0u, __builtin_amdgcn_mbcnt_lo(~0u, z_)); F.lane = l_; F.tid = wv_ * 64 + l_; } while (0)
#ifndef DUP
#define DUP 0
#endif
#ifndef GPM
#define GPM 0
#endif
  phase_prep(F, a); GRID_BAR();
  if (DUP & 256) { phase_prep(F, a); GRID_BAR(); }
#pragma unroll 1
  for (int l = 0; l < L; ++l) {
    phase_norm_mod(F, a, l); GRID_BAR();
    phase_zgemm(F, a, l); GRID_BAR();
    if (DUP & 1) { phase_zgemm(F, a, l, GPM); GRID_BAR(); }
    phase_b(F, a, l); GRID_BAR();
    if (DUP & 2) { phase_b(F, a, l); GRID_BAR(); }
    if (DUP & 8192) { phase_b_rows(F, a, l); GRID_BAR(); }
    if (DUP & 16384) { const int c = (int)blockIdx.x; if (c < 144) phase_b_chunkmix(F, a, l, c, 144); GRID_BAR(); }
    const bool lastl = l == L - 1;
    phase_attn(F, a, lastl); GRID_BAR();
    if (DUP & 4) { phase_attn(F, a, lastl); GRID_BAR(); }
    phase_branch(F, a, l, lastl);
    if (F.G == 256) refresh_ctx(F, a); else GRID_BAR();
    phase_gate(F, a, l, lastl);
    if (F.G == 256) refresh_ctx(F, a); else GRID_BAR();
    phase_out(F, a, l, 1.f, F.G == 256, lastl); GRID_BAR();
    if (DUP & 16) { phase_branch(F, a, l, lastl); GRID_BAR(); }
    if (DUP & 8) { phase_branch(F, a, l, lastl); refresh_ctx(F, a); phase_gate(F, a, l, lastl, CW_TILE); refresh_ctx(F, a); phase_out(F, a, l, 0.f, true, lastl, CW_TILE); GRID_BAR(); }
    phase_norm_router(F, a, l, l == L - 1); GRID_BAR();
    phase_moe_gu(F, a, l);
    if (F.G == 256) refresh_ctx(F, a); else GRID_BAR();
    phase_moe_dn(F, a, l); GRID_BAR();
    if (DUP & 1024) { phase_norm_mod(F, a, l, true); GRID_BAR(); }
    if (DUP & 32768) { phase_moe_gu(F, a, l, 1 + GPM); GRID_BAR(); }
    if (DUP & 32) { phase_moe_gu(F, a, l); refresh_ctx(F, a); phase_moe_dn(F, a, l); GRID_BAR(); }
    if (DUP & 2048) { phase_out(F, a, l, 0.f, false); GRID_BAR(); }
    if (DUP & 128) { phase_gate<GPM>(F, a, l, lastl, CW_TILE); GRID_BAR(); }
    if (DUP & 64) { phase_gate(F, a, l, lastl, CW_TILE); refresh_ctx(F, a); phase_out(F, a, l, 0.f, true, lastl, CW_TILE); GRID_BAR(); }
    if (DUP & 4096) { phase_norm_router(F, a, l, l == L - 1, true); GRID_BAR(); }
    if (DUP & 512) { GRID_BAR(); GRID_BAR(); GRID_BAR(); GRID_BAR(); GRID_BAR(); GRID_BAR(); GRID_BAR(); GRID_BAR(); GRID_BAR(); GRID_BAR(); }
  }
  phase_final(F, a);
}
}

extern "C" void kernel_launch(void* const* d_in, const int* in_sizes, int n_in, void* d_out, int out_size, void* d_ws, size_t ws_size, hipStream_t stream) {
  using namespace mk;
  static int grid = 0;
  if (grid == 0) {
    int dev = 0, cus = 0, per_cu = 0;
    hipGetDevice(&dev); hipDeviceGetAttribute(&cus, hipDeviceAttributeMultiprocessorCount, dev);
    hipFuncSetAttribute((const void*)mk_kernel, hipFuncAttributeMaxDynamicSharedMemorySize, LDS_BYTES);
    hipOccupancyMaxActiveBlocksPerMultiprocessor(&per_cu, (const void*)mk_kernel, NTHR, LDS_BYTES);
    grid = per_cu >= 1 ? cus : -1;
  }
  if (grid < 0 || WS_END3 > ws_size) { fprintf(stderr, "kernel_launch: cannot run (grid %d, ws need %zu have %zu)\n", grid, (size_t)WS_END3, ws_size); (void)hipMemsetAsync(d_out, 0xFF, (size_t)out_size * 4, stream); return; }
  Args a{}; for (int i = 0; i < 28; ++i) a.in[i] = (const float*)d_in[i]; a.out = (float*)d_out; a.ws = (unsigned char*)d_ws;
  (void)hipMemsetAsync(d_ws, 0, CTL_BYTES, stream);
  void* args[] = {&a};
  hipError_t e = hipLaunchCooperativeKernel((const void*)mk_kernel, dim3(grid), dim3(NTHR), args, LDS_BYTES, stream);
  if (e != hipSuccess) fprintf(stderr, "kernel_launch: cooperative launch failed: %s (grid %d)\n", hipGetErrorString(e), grid);
}
```
